# Optimizing an MI355X kernel written in HIP

```python
import jax, jax.numpy as jnp
from jax import lax
import numpy as np

D_MODEL = 2048
BATCH = 2
SEQ = 16384
DEPTH = 2

GRID_W = 64
CTX_LEN = 256

RWKV_HEADS = 16
RWKV_HEAD = 64
RWKV_WIDTH = RWKV_HEADS * RWKV_HEAD
DECAY_LORA = 64
AAA_LORA = 64
GATE_LORA = 160
GN_EPS = 64e-5
ATT_Q_HEADS = 16
ATT_KV_HEADS = 4
ATT_HEAD = 64
ATT_GROUP = ATT_Q_HEADS // ATT_KV_HEADS
ATT_WIDTH = ATT_Q_HEADS * ATT_HEAD
ATT_KV_WIDTH = ATT_KV_HEADS * ATT_HEAD
ATT_SCALE = ATT_HEAD ** -0.5
WINDOW = 128
BLOCK = 128
ROPE_THETA = 10000.0
RWKV_COLS = 3 * RWKV_WIDTH + 2 * DECAY_LORA + 2 * AAA_LORA + GATE_LORA
IN_COLS = RWKV_COLS + ATT_WIDTH + 2 * ATT_KV_WIDTH
MIX_WIDTH = RWKV_WIDTH + ATT_WIDTH
POOL_WINDOWS = (2, 4, 8, 16)
POOL_GROUP = D_MODEL // 4
N_EXPERTS = 16
CAPACITY_FACTOR = 2
EXPERT_FF = D_MODEL // 2
NORM_EPS = 1e-6
N_EVEN = (DEPTH + 1) // 2
N_ODD = DEPTH // 2

kernel_name = "hybrid_rwkv7_swa_pool_ecmoe_diffusion"


def rms_norm(x, gain):
    x32 = x.astype(jnp.float32)
    y = x32 * lax.rsqrt(jnp.mean(x32 * x32, axis=-1, keepdims=True) + NORM_EPS)
    return (y * gain.astype(jnp.float32)).astype(x.dtype)


def centred_shift(p):
    zero = jnp.zeros_like(p[:, :1])
    prev = jnp.concatenate([zero, p[:, :-1]], axis=1)
    nxt = jnp.concatenate([p[:, 1:], zero], axis=1)
    return 0.5 * (prev + nxt)


def axial_angles(length):
    rows = length // GRID_W
    row = jnp.repeat(jnp.arange(rows, dtype=jnp.float32), GRID_W)
    col = jnp.tile(jnp.arange(GRID_W, dtype=jnp.float32), rows)
    n_freq = ATT_HEAD // 4
    inv = ROPE_THETA ** (-jnp.arange(n_freq, dtype=jnp.float32) / n_freq)
    return row[:, None] * inv, col[:, None] * inv


def rotate_half(x, ang):
    x1, x2 = jnp.split(x, 2, axis=-1)
    cos = jnp.cos(ang)[None, :, None, :].astype(x.dtype)
    sin = jnp.sin(ang)[None, :, None, :].astype(x.dtype)
    return jnp.concatenate([x1 * cos - x2 * sin, x2 * cos + x1 * sin], axis=-1)


def rope_2d(x, ang_row, ang_col):
    xr, xc = jnp.split(x, 2, axis=-1)
    return jnp.concatenate([rotate_half(xr, ang_row), rotate_half(xc, ang_col)], axis=-1)


def split_heads(t):
    return t.reshape(t.shape[:-1] + (RWKV_HEADS, RWKV_HEAD))


def rwkv_inputs(p, mu):
    m = p + mu * (centred_shift(p) - p)
    sizes = [RWKV_WIDTH] * 3 + [DECAY_LORA] * 2 + [AAA_LORA] * 2 + [GATE_LORA]
    return jnp.split(m, np.cumsum(sizes)[:-1].tolist(), axis=-1)


def rwkv_prep(r, k, v, wd, ad, w0, w2, a0, a2, k_k, k_a):
    w_log = -jax.nn.softplus(-(w0 + jnp.tanh(wd) @ w2).astype(jnp.float32)) - 0.5
    decay = jnp.exp(-jnp.exp(w_log))
    a = jax.nn.sigmoid((a0 + ad @ a2).astype(jnp.float32))
    k32 = k.astype(jnp.float32)
    kk = split_heads(k32 * k_k.astype(jnp.float32))
    kk = kk * lax.rsqrt(jnp.maximum(jnp.sum(kk * kk, axis=-1, keepdims=True), 1e-24))
    k_mod = k32 * (1.0 + (a - 1.0) * k_a.astype(jnp.float32))
    return (split_heads(r.astype(jnp.float32)), split_heads(decay), split_heads(k_mod),
            split_heads(v.astype(jnp.float32)), kk, split_heads(a))


def wkv_step(state, inp):
    r, w, k, v, kk, a = inp
    sa = jnp.einsum('bhvk,bhk->bhv', state, kk)
    state = (state * w[:, :, None, :] - sa[..., None] * (kk * a)[:, :, None, :]
             + v[..., None] * k[:, :, None, :])
    return state, jnp.einsum('bhvk,bhk->bhv', state, r)


def wkv_scan(inputs, state0, reverse):
    xs = tuple(jnp.swapaxes(t, 0, 1) for t in inputs)
    state, ys = lax.scan(wkv_step, state0, xs, reverse=reverse)
    return state, jnp.swapaxes(ys, 0, 1)


def rwkv_bonus(q, r_k_h):
    r, _, k, v, _, _ = q
    return jnp.sum(r * k * r_k_h, axis=-1, keepdims=True) * v


def rwkv_finish(y, bonus, gd, g2, ln_w, ln_b, dtype):
    b, t = y.shape[:2]
    mean = jnp.mean(y, axis=-1, keepdims=True)
    var = jnp.mean(jnp.square(y - mean), axis=-1, keepdims=True)
    yn = ((y - mean) * lax.rsqrt(var + GN_EPS)).reshape(b, t, RWKV_WIDTH)
    yn = yn * ln_w.astype(jnp.float32) + ln_b.astype(jnp.float32)
    g = (jax.nn.sigmoid(gd) @ g2).astype(jnp.float32)
    return ((yn + bonus.reshape(b, t, RWKV_WIDTH)) * g).astype(dtype)


def att_split(p):
    o = RWKV_COLS
    q = p[..., o:o + ATT_WIDTH]
    k = p[..., o + ATT_WIDTH:o + ATT_WIDTH + ATT_KV_WIDTH]
    v = p[..., o + ATT_WIDTH + ATT_KV_WIDTH:]
    sh = p.shape[:2]
    return (q.reshape(sh + (ATT_Q_HEADS, ATT_HEAD)), k.reshape(sh + (ATT_KV_HEADS, ATT_HEAD)),
            v.reshape(sh + (ATT_KV_HEADS, ATT_HEAD)))


def window_attention(q, k, v, kc, vc, sink):
    b, length = q.shape[:2]
    n_ctx = kc.shape[1]
    nb = length // BLOCK
    span = BLOCK + 2 * WINDOW
    qb = q.reshape(b, nb, BLOCK, ATT_KV_HEADS, ATT_GROUP, ATT_HEAD).swapaxes(0, 1)
    pad = ((0, 0), (WINDOW, WINDOW), (0, 0), (0, 0))
    kp = jnp.pad(k, pad)
    vp = jnp.pad(v, pad)
    sink_l = sink.reshape(ATT_KV_HEADS, ATT_GROUP)[None, :, :, None, None].astype(jnp.float32)

    def one_block(args):
        q_blk, n = args
        start = n * BLOCK
        kw = lax.dynamic_slice_in_dim(kp, start, span, axis=1)
        vw = lax.dynamic_slice_in_dim(vp, start, span, axis=1)
        s_c = jnp.einsum('bqkgd,bjkd->bkgqj', q_blk, kc, preferred_element_type=jnp.float32) * ATT_SCALE
        s_w = jnp.einsum('bqkgd,bjkd->bkgqj', q_blk, kw, preferred_element_type=jnp.float32) * ATT_SCALE
        qpos = start + jnp.arange(BLOCK)
        kpos = start - WINDOW + jnp.arange(span)
        ok = ((jnp.abs(qpos[:, None] - kpos[None, :]) <= WINDOW)
              & (kpos >= 0)[None, :] & (kpos < length)[None, :])
        s_w = jnp.where(ok, s_w, -jnp.inf)
        s_sink = jnp.broadcast_to(sink_l, s_c.shape[:-1] + (1,))
        p = jax.nn.softmax(jnp.concatenate([s_c, s_w, s_sink], axis=-1), axis=-1).astype(v.dtype)
        return (jnp.einsum('bkgqj,bjkd->bqkgd', p[..., :n_ctx], vc)
                + jnp.einsum('bkgqj,bjkd->bqkgd', p[..., n_ctx:n_ctx + span], vw))

    out = lax.map(one_block, (qb, jnp.arange(nb)))
    return out.swapaxes(0, 1).reshape(b, length, ATT_WIDTH)


def context_attention(qc, kc, vc, sink):
    b, n_ctx = qc.shape[:2]
    qg = qc.reshape(b, n_ctx, ATT_KV_HEADS, ATT_GROUP, ATT_HEAD)
    s = jnp.einsum('bqkgd,bjkd->bkgqj', qg, kc, preferred_element_type=jnp.float32) * ATT_SCALE
    sink_l = sink.reshape(ATT_KV_HEADS, ATT_GROUP)[None, :, :, None, None].astype(jnp.float32)
    s_sink = jnp.broadcast_to(sink_l, s.shape[:-1] + (1,))
    p = jax.nn.softmax(jnp.concatenate([s, s_sink], axis=-1), axis=-1)[..., :n_ctx].astype(vc.dtype)
    return jnp.einsum('bkgqj,bjkd->bqkgd', p, vc).reshape(b, n_ctx, ATT_WIDTH)


def even_mixer(hx, hc, w_in, mu, w_out, w0, w2, a0, a2, g2, k_k, k_a, r_k, ln_w, ln_b, sink,
               ang_row, ang_col, want_ctx):
    px = hx @ w_in
    pc = hc @ w_in
    rx = rwkv_inputs(px[..., :RWKV_COLS], mu)
    rc = rwkv_inputs(pc[..., :RWKV_COLS], mu)
    zero_state = jnp.zeros((hx.shape[0], RWKV_HEADS, RWKV_HEAD, RWKV_HEAD), jnp.float32)
    r_k_h = r_k.reshape(RWKV_HEADS, RWKV_HEAD).astype(jnp.float32)
    y_x, b_x, y_c, b_c = 0.0, 0.0, 0.0, 0.0
    for d in range(2):
        rev = d == 1
        qx = rwkv_prep(rx[0], rx[1], rx[2], rx[3 + d], rx[5 + d], w0[d], w2[d], a0[d], a2[d], k_k, k_a)
        qc = rwkv_prep(rc[0], rc[1], rc[2], rc[3 + d], rc[5 + d], w0[d], w2[d], a0[d], a2[d], k_k, k_a)
        state_c, yc_d = wkv_scan(qc, zero_state, rev)
        _, yx_d = wkv_scan(qx, state_c, rev)
        y_x = y_x + yx_d
        b_x = b_x + rwkv_bonus(qx, r_k_h)
        if want_ctx:
            y_c = y_c + yc_d
            b_c = b_c + rwkv_bonus(qc, r_k_h)
    rwkv_x = rwkv_finish(y_x, b_x, rx[7], g2, ln_w, ln_b, hx.dtype)

    q_x, k_x, v_x = att_split(px)
    q_c, k_c, v_c = att_split(pc)
    q_x = rope_2d(q_x, ang_row, ang_col)
    k_x = rope_2d(k_x, ang_row, ang_col)
    att_x = window_attention(q_x, k_x, v_x, k_c, v_c, sink)
    out_x = jnp.concatenate([rwkv_x, att_x], axis=-1) @ w_out
    if not want_ctx:
        return out_x, None
    rwkv_c = rwkv_finish(y_c, b_c, rc[7], g2, ln_w, ln_b, hc.dtype)
    att_c = context_attention(q_c, k_c, v_c, sink)
    return out_x, jnp.concatenate([rwkv_c, att_c], axis=-1) @ w_out


def pool_mixer(h, pool_w, pool_scale):
    b, t, d = h.shape
    h32 = h.astype(jnp.float32)
    cs = jnp.concatenate([jnp.zeros((b, 1, d), jnp.float32), jnp.cumsum(h32, axis=1)], axis=1)
    pos = jnp.arange(t)
    outs = []
    for g, w in enumerate(POOL_WINDOWS):
        sl = slice(g * POOL_GROUP, (g + 1) * POOL_GROUP)
        lo = jnp.clip(pos - w // 2, 0, t)
        hi = jnp.clip(pos + w // 2, 0, t)
        cnt = (hi - lo).astype(jnp.float32)[None, :, None]
        cs_g = cs[..., sl]
        mean = (cs_g[:, hi] - cs_g[:, lo]) / cnt
        outs.append((mean - h32[..., sl]).astype(h.dtype) @ pool_w[g])
    return jnp.concatenate(outs, axis=-1) * pool_scale


def expert_choice_ffn(h, router_w, w_gate, w_up, w_down):
    b, t, _ = h.shape
    cap = max(1, CAPACITY_FACTOR * t // N_EXPERTS)
    aff = jax.nn.softmax(jnp.einsum('btd,de->bte', h, router_w, preferred_element_type=jnp.float32), axis=-1)
    gate, idx = lax.top_k(jnp.swapaxes(aff, 1, 2), cap)
    b_idx = jnp.arange(b)[:, None, None]
    xs = h[b_idx, idx]
    hid = jax.nn.silu(jnp.einsum('becd,edf->becf', xs, w_gate)) * jnp.einsum('becd,edf->becf', xs, w_up)
    y = jnp.einsum('becf,efd->becd', hid, w_down) * gate[..., None].astype(h.dtype)
    return jnp.zeros_like(h).at[b_idx, idx].add(y)


def setup_inputs(seed: int = 0) -> dict:
    key = jax.random.key(seed)
    ks = iter(jax.random.split(key, 40))
    D = D_MODEL

    def nrm(shape, s):
        return jax.random.normal(next(ks), shape, jnp.float32) * s

    def unif(shape, lo, hi):
        return jax.random.uniform(next(ks), shape, jnp.float32, minval=lo, maxval=hi)

    return {
        "x": nrm((BATCH, SEQ, D), 1.0),
        "c": nrm((BATCH, D), 1.0),
        "ctx": nrm((BATCH, CTX_LEN, D), 1.0),
        "c_ctx": nrm((D,), 1.0),
        "ada_w": nrm((DEPTH, D, 6 * D), 0.5 * D ** -0.5),
        "ada_b": nrm((DEPTH, 6 * D), 0.02),
        "norm_mix": 1.0 + nrm((DEPTH, D), 0.01),
        "norm_ffn": 1.0 + nrm((DEPTH, D), 0.01),
        "w_in": nrm((N_EVEN, D, IN_COLS), D ** -0.5),
        "shift_mu": unif((N_EVEN, RWKV_COLS), 0.0, 1.0),
        "decay_w0": unif((N_EVEN, 2, RWKV_WIDTH), -5.0, 1.0),
        "decay_w2": nrm((N_EVEN, 2, DECAY_LORA, RWKV_WIDTH), 0.5 * DECAY_LORA ** -0.5),
        "iclr_a0": nrm((N_EVEN, 2, RWKV_WIDTH), 0.5),
        "iclr_a2": nrm((N_EVEN, 2, AAA_LORA, RWKV_WIDTH), 0.5 * AAA_LORA ** -0.5),
        "gate_g2": nrm((N_EVEN, GATE_LORA, RWKV_WIDTH), GATE_LORA ** -0.5),
        "k_k": 0.85 + nrm((N_EVEN, RWKV_WIDTH), 0.05),
        "k_a": 1.0 + nrm((N_EVEN, RWKV_WIDTH), 0.05),
        "r_k": nrm((N_EVEN, RWKV_WIDTH), 0.1),
        "ln_w": 1.0 + nrm((N_EVEN, RWKV_WIDTH), 0.05),
        "ln_b": nrm((N_EVEN, RWKV_WIDTH), 0.01),
        "sink": nrm((N_EVEN, ATT_Q_HEADS), 1.0),
        "w_out": nrm((N_EVEN, MIX_WIDTH, D), MIX_WIDTH ** -0.5),
        "pool_w": nrm((N_ODD, len(POOL_WINDOWS), POOL_GROUP, POOL_GROUP), POOL_GROUP ** -0.5),
        "pool_scale": 1.0 + nrm((N_ODD, D), 0.1),
        "router_w": nrm((DEPTH, D, N_EXPERTS), D ** -0.5),
        "exp_w_gate": nrm((DEPTH, N_EXPERTS, D, EXPERT_FF), D ** -0.5),
        "exp_w_up": nrm((DEPTH, N_EXPERTS, D, EXPERT_FF), D ** -0.5),
        "exp_w_down": nrm((DEPTH, N_EXPERTS, EXPERT_FF, D), EXPERT_FF ** -0.5),
        "norm_final": 1.0 + nrm((D,), 0.01),
    }


def reference(x, c, ctx, c_ctx, ada_w, ada_b, norm_mix, norm_ffn, w_in, shift_mu, decay_w0, decay_w2,
              iclr_a0, iclr_a2, gate_g2, k_k, k_a, r_k, ln_w, ln_b, sink, w_out, pool_w, pool_scale,
              router_w, exp_w_gate, exp_w_up, exp_w_down, norm_final):
    ang_row, ang_col = axial_angles(x.shape[1])
    for l in range(DEPTH):
        want_ctx = any(j % 2 == 0 for j in range(l + 1, DEPTH))
        sh_a, sc_a, gt_a, sh_f, sc_f, gt_f = jnp.split(
            (jax.nn.silu(c) @ ada_w[l] + ada_b[l])[:, None, :], 6, axis=-1)
        hx = rms_norm(x, norm_mix[l]) * (1.0 + sc_a) + sh_a
        if l % 2 == 0 or want_ctx:
            csh_a, csc_a, cgt_a, csh_f, csc_f, cgt_f = jnp.split(
                jax.nn.silu(c_ctx) @ ada_w[l] + ada_b[l], 6, axis=-1)
            hc = rms_norm(ctx, norm_mix[l]) * (1.0 + csc_a) + csh_a
        if l % 2 == 0:
            e = l // 2
            yx, yc = even_mixer(hx, hc, w_in[e], shift_mu[e], w_out[e], decay_w0[e], decay_w2[e],
                                iclr_a0[e], iclr_a2[e], gate_g2[e], k_k[e], k_a[e], r_k[e], ln_w[e],
                                ln_b[e], sink[e], ang_row, ang_col, want_ctx)
        else:
            o = l // 2
            yx = pool_mixer(hx, pool_w[o], pool_scale[o])
            yc = pool_mixer(hc, pool_w[o], pool_scale[o]) if want_ctx else None
        x = x + gt_a * yx
        x = x + gt_f * expert_choice_ffn(rms_norm(x, norm_ffn[l]) * (1.0 + sc_f) + sh_f,
                                         router_w[l], exp_w_gate[l], exp_w_up[l], exp_w_down[l])
        if want_ctx:
            ctx = ctx + cgt_a * yc
            ctx = ctx + cgt_f * expert_choice_ffn(rms_norm(ctx, norm_ffn[l]) * (1.0 + csc_f) + csh_f,
                                                  router_w[l], exp_w_gate[l], exp_w_up[l], exp_w_down[l])
    return rms_norm(x, norm_final)
```

```cpp
#include <hip/hip_runtime.h>
#include <cstdio>
#include <cstdint>

#ifndef MK_SPLIT
#define MK_SPLIT 0
#endif

#ifndef REP_MASK
#define REP_MASK 0u
#endif
namespace pg8 {
#define PG8_LAS __attribute__((address_space(3)))
typedef unsigned short bf16_t;
typedef short bf16x8 __attribute__((ext_vector_type(8)));
typedef float f32x4 __attribute__((ext_vector_type(4)));
typedef unsigned u32x4 __attribute__((ext_vector_type(4)));
constexpr int BM = 256, BK = 64, HALF = 128, HTB = HALF * BK * 2  , STAGE_BYTES = 8 * HTB, NXCD = 8, WGM = 8;

__host__ __device__ __forceinline__ int lds_byte(int r, int c) { const int st = (r >> 4) * 2 + (c >> 5), rr = r & 15, cc = c & 31, ob = rr * 64 + cc * 2; return st * 1024 + (ob ^ (((ob >> 9) & 1) << 5)); }
__host__ __device__ __forceinline__ void stage_rc(int b, int& R, int& C) { const int st = b / 1024, sb = b % 1024, swz = sb ^ (((sb >> 9) & 1) << 5); R = (st >> 1) * 16 + swz / 64; C = (st & 1) * 32 + (swz % 64) / 2; }
__host__ __device__ __forceinline__ int perm32(int rho) { const int n = rho >> 4, i = rho & 15; return 8 * (i >> 2) + 4 * n + (i & 3); }

struct Unit { int pm, pn; };
struct Gemm { const bf16_t* A; const bf16_t* Bt; int M, N, K; const int* rowmap; int rm_shift, rm_rows; };

struct StaticOrder {
    int nM, nN, nwg, G, c;
    __host__ __device__ void init(int M, int N, int G_, int c_) { nM = M / BM; nN = N / BM; nwg = nM * nN; G = G_; c = c_; }
    __host__ __device__ bool next(int i, Unit& u) const {
        const long L = (long)i * G + c; if (L >= nwg) return false;
        int wgid = (int)L; { const int q = nwg / NXCD, r = nwg % NXCD, xcd = wgid % NXCD, off = wgid / NXCD; wgid = (xcd < r ? xcd * (q + 1) : r * (q + 1) + (xcd - r) * q) + off; }
        const int nig = WGM * nN, gid = wgid / nig, fm = gid * WGM, gsz = (nM - fm) < WGM ? (nM - fm) : WGM;
        u.pm = fm + ((wgid % nig) % gsz); u.pn = (wgid % nig) / gsz; return true;
    }
    __device__ __forceinline__ void a_ready(const Unit&) const {}
    __device__ __forceinline__ void done(const Unit&) const {}
};

__device__ __forceinline__ unsigned cvt_pk_bf16(float lo, float hi) { unsigned r; asm volatile("v_cvt_pk_bf16_f32 %0, %1, %2" : "=v"(r) : "v"(lo), "v"(hi)); return r; }
typedef float f32x2 __attribute__((ext_vector_type(2)));

struct EpiStoreBf16 {
    static constexpr bool PERM = true, AFTER_DRAIN = false;
    bf16_t* O; int ldc;
    __device__ __forceinline__ void operator()(const f32x4 (&acc)[2][2][4][2], const Unit& u, int wr, int wc, int fr, int fq) const {
        const int row0 = u.pm * BM + wr * 64 + fr, col0 = u.pn * BM + wc * 32 + 8 * fq;
#pragma unroll
        for (int ai = 0; ai < 2; ++ai)
#pragma unroll
            for (int m = 0; m < 4; ++m) { bf16_t* rowp = O + (size_t)(row0 + ai * HALF + m * 16) * ldc + col0;
#pragma unroll
                for (int bj = 0; bj < 2; ++bj) { const f32x4 v0 = acc[ai][bj][m][0], v1 = acc[ai][bj][m][1];
                    u32x4 w; w.x = cvt_pk_bf16(v0[0], v0[1]); w.y = cvt_pk_bf16(v0[2], v0[3]); w.z = cvt_pk_bf16(v1[0], v1[1]); w.w = cvt_pk_bf16(v1[2], v1[3]);
                    *(u32x4*)(rowp + bj * HALF) = w; } }
    }
};
struct EpiResF32 {
    static constexpr bool PERM = false, AFTER_DRAIN = false;
    const float* res; float* out; int ldc; const float* gate0; const float* gate1; const float* scale; int rows_per_b; int pm_mask;
    __device__ __forceinline__ void operator()(const f32x4 (&acc)[2][2][4][2], const Unit& u, int wr, int wc, int fr, int fq) const {
        const int row0 = (u.pm & pm_mask) * BM + wr * 64 + fr, col0 = u.pn * BM + wc * 32 + 4 * fq;
        const float* gp = (row0 >= rows_per_b) ? gate1 : gate0;
        f32x4 gv[2][2];
#pragma unroll
        for (int bj = 0; bj < 2; ++bj)
#pragma unroll
            for (int n = 0; n < 2; ++n) { gv[bj][n] = *(const f32x4*)(gp + col0 + bj * HALF + 16 * n); if (scale) gv[bj][n] = gv[bj][n] * *(const f32x4*)(scale + col0 + bj * HALF + 16 * n); }
#pragma unroll
        for (int ai = 0; ai < 2; ++ai)
#pragma unroll
            for (int m = 0; m < 4; ++m) { const size_t ro = (size_t)(row0 + ai * HALF + m * 16) * ldc + col0;
#pragma unroll
                for (int bj = 0; bj < 2; ++bj)
#pragma unroll
                    for (int n = 0; n < 2; ++n) { const size_t o = ro + bj * HALF + 16 * n; const f32x4 r = *(const f32x4*)(res + o);
                        *(f32x4*)(out + o) = r + gv[bj][n] * acc[ai][bj][m][n]; } }
    }
};
template <bool RES_F32>
struct EpiResBf16 {
    static constexpr bool PERM = true, AFTER_DRAIN = false;
    const void* res; bf16_t* out; int ldc; const float* gate0; const float* gate1; const float* scale; int rows_per_b; int pm_mask;
    __device__ __forceinline__ void operator()(const f32x4 (&acc)[2][2][4][2], const Unit& u, int wr, int wc, int fr, int fq) const {
        const int row0 = (u.pm & pm_mask) * BM + wr * 64 + fr, col0 = u.pn * BM + wc * 32 + 8 * fq;
        const float* gp = (row0 >= rows_per_b) ? gate1 : gate0;
        f32x4 gv[2][2];
#pragma unroll
        for (int bj = 0; bj < 2; ++bj)
#pragma unroll
            for (int n = 0; n < 2; ++n) { gv[bj][n] = *(const f32x4*)(gp + col0 + bj * HALF + 4 * n); if (scale) gv[bj][n] = gv[bj][n] * *(const f32x4*)(scale + col0 + bj * HALF + 4 * n); }
#pragma unroll
        for (int ai = 0; ai < 2; ++ai) {
            f32x4 rf[4][2][2]; u32x4 rb[4][2];
#pragma unroll
            for (int m = 0; m < 4; ++m)
#pragma unroll
                for (int bj = 0; bj < 2; ++bj) { const size_t o = (size_t)(row0 + ai * HALF + m * 16) * ldc + col0 + bj * HALF;
                    if (RES_F32) { rf[m][bj][0] = *(const f32x4*)((const float*)res + o); rf[m][bj][1] = *(const f32x4*)((const float*)res + o + 4); }
                    else rb[m][bj] = *(const u32x4*)((const bf16_t*)res + o); }
#pragma unroll
            for (int m = 0; m < 4; ++m)
#pragma unroll
                for (int bj = 0; bj < 2; ++bj) { const size_t o = (size_t)(row0 + ai * HALF + m * 16) * ldc + col0 + bj * HALF; f32x4 r0, r1;
                    if (RES_F32) { r0 = rf[m][bj][0]; r1 = rf[m][bj][1]; }
                    else { const u32x4 w = rb[m][bj];
                        r0 = (f32x4){__builtin_bit_cast(float, w.x << 16), __builtin_bit_cast(float, w.x & 0xffff0000u), __builtin_bit_cast(float, w.y << 16), __builtin_bit_cast(float, w.y & 0xffff0000u)};
                        r1 = (f32x4){__builtin_bit_cast(float, w.z << 16), __builtin_bit_cast(float, w.z & 0xffff0000u), __builtin_bit_cast(float, w.w << 16), __builtin_bit_cast(float, w.w & 0xffff0000u)}; }
                    const f32x4 v0 = r0 + gv[bj][0] * acc[ai][bj][m][0], v1 = r1 + gv[bj][1] * acc[ai][bj][m][1];
                    u32x4 w; w.x = cvt_pk_bf16(v0[0], v0[1]); w.y = cvt_pk_bf16(v0[2], v0[3]); w.z = cvt_pk_bf16(v1[0], v1[1]); w.w = cvt_pk_bf16(v1[2], v1[3]);
                    *(u32x4*)(out + o) = w; } }
    }
};
struct EpiSwiglu {
    static constexpr bool PERM = true, AFTER_DRAIN = false;
    bf16_t* O; int ldc;
    __device__ __forceinline__ void operator()(const f32x4 (&acc)[2][2][4][2], const Unit& u, int wr, int wc, int fr, int fq) const {
        const int row0 = u.pm * BM + wr * 64 + fr, col0 = (u.pn & 7) * 128 + wc * 32 + 8 * fq;
#pragma unroll
        for (int ai = 0; ai < 2; ++ai)
#pragma unroll
            for (int m = 0; m < 4; ++m) { bf16_t* rowp = O + (size_t)(row0 + ai * HALF + m * 16) * ldc + col0; float h[8];
#pragma unroll
                for (int n = 0; n < 2; ++n) { const f32x4 g = acc[ai][0][m][n], up = acc[ai][1][m][n];
#pragma unroll
                    for (int i = 0; i < 4; ++i) h[4 * n + i] = g[i] * __builtin_amdgcn_rcpf(1.f + __expf(-g[i])) * up[i]; }
                u32x4 w; w.x = cvt_pk_bf16(h[0], h[1]); w.y = cvt_pk_bf16(h[2], h[3]); w.z = cvt_pk_bf16(h[4], h[5]); w.w = cvt_pk_bf16(h[6], h[7]);
                *(u32x4*)rowp = w; }
    }
};
struct EpiRowScaleBf16 {
    static constexpr bool PERM = true, AFTER_DRAIN = false;
    bf16_t* O; int ldc; const float* rs;
    __device__ __forceinline__ void operator()(const f32x4 (&acc)[2][2][4][2], const Unit& u, int wr, int wc, int fr, int fq) const {
        const int row0 = u.pm * BM + wr * 64 + fr, col0 = (u.pn & 7) * BM + wc * 32 + 8 * fq;
        float sc[2][4];
#pragma unroll
        for (int ai = 0; ai < 2; ++ai)
#pragma unroll
            for (int m = 0; m < 4; ++m) sc[ai][m] = rs[row0 + ai * HALF + m * 16];
#pragma unroll
        for (int ai = 0; ai < 2; ++ai)
#pragma unroll
            for (int m = 0; m < 4; ++m) { const int row = row0 + ai * HALF + m * 16; const float s = sc[ai][m]; bf16_t* rowp = O + (size_t)row * ldc + col0;
#pragma unroll
                for (int bj = 0; bj < 2; ++bj) { const f32x4 v0 = acc[ai][bj][m][0] * s, v1 = acc[ai][bj][m][1] * s;
                    u32x4 w; w.x = cvt_pk_bf16(v0[0], v0[1]); w.y = cvt_pk_bf16(v0[2], v0[3]); w.z = cvt_pk_bf16(v1[0], v1[1]); w.w = cvt_pk_bf16(v1[2], v1[3]);
                    *(u32x4*)(rowp + bj * HALF) = w; } }
    }
};
struct ExpertOrder {
    int G, c;
    __device__ __forceinline__ bool next(int i, Unit& u) const {
        const long L = (long)i * G + c; if (L >= 2048) return false;
        const int r256 = (int)(L >> 8), w = (int)(L & 255), x = w & 7, j = w >> 3, grp = 4 * r256 + (x >> 1), e = grp >> 1, b = grp & 1;
        u.pm = (b * 16 + e) * 8 + 4 * (x & 1) + (j & 3); u.pn = e * 8 + (j >> 2); return true;
    }
    __device__ __forceinline__ void a_ready(const Unit&) const {}
    __device__ __forceinline__ void done(const Unit&) const {}
};
struct PoolOrder {
    int G, c;
    __device__ __forceinline__ bool next(int i, Unit& u) const {
        const long L = (long)i * G + c; if (L >= 1024) return false;
        const int g = (int)(L >> 8), w = (int)(L & 255);
        u.pm = g * 128 + (w & 127); u.pn = g * 2 + (w >> 7); return true;
    }
    __device__ __forceinline__ void a_ready(const Unit&) const {}
    __device__ __forceinline__ void done(const Unit&) const {}
};

template <class Epi, class Sched, bool ALIGN_EPI = false, bool SP2 = false, bool GATHER = false>
__device__ __forceinline__ void gemm_phase(PG8_LAS unsigned char* lds, const Gemm g, const Sched& S, const Epi& E, const int tid) {
    const int wid = __builtin_amdgcn_readfirstlane(tid >> 6), lane = tid & 63, wr = wid >> 2, wc = wid & 3, fr = lane & 15, fq = lane >> 4;
    const int K = g.K, nt = K / BK;
    unsigned voffA[2], voffB[2];
    int RA[2], CA[2];
#pragma unroll
    for (int i = 0; i < 2; ++i) { int R, C; stage_rc(tid * 16 + i * 8192, R, C); const int Rb = Epi::PERM ? ((R & ~31) + perm32(R & 31)) : R;
        voffA[i] = (unsigned)(R * K + C) * 2u; voffB[i] = (unsigned)(Rb * K + C) * 2u; RA[i] = R; CA[i] = C; }
    static_assert(!GATHER || SP2, "GATHER is written for the SP2 loop");
    unsigned vc[2][2] = {{0u, 0u}, {0u, 0u}}, vn[2][2] = {{0u, 0u}, {0u, 0u}};
#define PG8_GOFF(dst, u) do { _Pragma("unroll") for (int h_ = 0; h_ < 2; ++h_) _Pragma("unroll") for (int i_ = 0; i_ < 2; ++i_) { const int r_ = (u).pm * BM + h_ * HALF + RA[i_]; \
        dst[h_][i_] = (unsigned)(((r_ >> g.rm_shift) * g.rm_rows + g.rowmap[r_]) * K + CA[i_]) * 2u; } } while (0)
    const size_t kstep = (size_t)(BK * 2);
    const size_t hstep = (size_t)HALF * K * 2;
    const size_t tstep = 2 * hstep;
    const size_t hstepA = GATHER ? (size_t)0 : hstep, tstepA = GATHER ? (size_t)0 : tstep;
    const unsigned ldsw = (unsigned)wid * 1024u;
    const int aoff = lds_byte(wr * 64 + fr, fq * 8), boff = lds_byte(wc * 32 + fr, fq * 8);
#define PG8_SA(b, h) (((b) * 2 + (h)) * HTB)
#define PG8_SB(b, h) ((4 + (b) * 2 + (h)) * HTB)
#define PG8_STAGE(bufoff, gbase, voff) do { _Pragma("unroll") for (int _i = 0; _i < 2; ++_i) \
        __builtin_amdgcn_global_load_lds((const unsigned*)((const char*)(gbase) + (voff)[_i]), (PG8_LAS unsigned*)(lds + (bufoff) + ldsw + _i * 8192), 16, 0, 0); } while (0)
#define PG8_STAGE_A(bufoff, gbase, half, nx) do { if constexpr (GATHER) { const unsigned vv_[2] = {(nx) ? vn[half][0] : vc[half][0], (nx) ? vn[half][1] : vc[half][1]}; PG8_STAGE(bufoff, gbase, vv_); } else { PG8_STAGE(bufoff, gbase, voffA); } } while (0)
#define PG8_LDA(dst, b, h) do { _Pragma("unroll") for (int m = 0; m < 4; ++m) _Pragma("unroll") for (int k = 0; k < 2; ++k) dst[m][k] = *(const PG8_LAS bf16x8*)(lds + PG8_SA(b, h) + aoff + m * 2048 + k * 1024); } while (0)
#define PG8_LDB(dst, b, h) do { _Pragma("unroll") for (int n = 0; n < 2; ++n) _Pragma("unroll") for (int k = 0; k < 2; ++k) dst[n][k] = *(const PG8_LAS bf16x8*)(lds + PG8_SB(b, h) + boff + n * 2048 + k * 1024); } while (0)
#define PG8_MMA(ai, bj, At, Bt) do { __builtin_amdgcn_s_setprio(1); _Pragma("unroll") for (int m = 0; m < 4; ++m) _Pragma("unroll") for (int n = 0; n < 2; ++n) _Pragma("unroll") for (int k = 0; k < 2; ++k) \
        acc[ai][bj][m][n] = __builtin_amdgcn_mfma_f32_16x16x32_bf16(Bt[n][k], At[m][k], acc[ai][bj][m][n], 0, 0, 0); __builtin_amdgcn_s_setprio(0); } while (0)
#define PG8_WAIT_V(n) asm volatile("s_waitcnt vmcnt(" #n ")" ::: "memory")
#define PG8_WAIT_L(n) asm volatile("s_waitcnt lgkmcnt(" #n ")" ::: "memory")
#define PG8_BAR __builtin_amdgcn_s_barrier()
#define PG8_SCHED __builtin_amdgcn_sched_barrier(0)
    Unit cur, nxt; int ui = 0;
    if (!S.next(0, cur)) return;
    f32x4 acc[2][2][4][2];
#pragma unroll
    for (int a = 0; a < 2; ++a)
#pragma unroll
        for (int b = 0; b < 2; ++b)
#pragma unroll
            for (int m = 0; m < 4; ++m)
#pragma unroll
                for (int n = 0; n < 2; ++n) acc[a][b][m][n] = (f32x4){0.f, 0.f, 0.f, 0.f};
    bf16x8 At[4][2], B0[2][2], B1[2][2];
    const char* cA = (const char*)g.A + (size_t)cur.pm * tstepA; const char* cB = (const char*)g.Bt + (size_t)cur.pn * tstep;
    if constexpr (GATHER) PG8_GOFF(vc, cur);
    S.a_ready(cur);
    if constexpr (SP2) {
        PG8_STAGE(PG8_SB(0, 0), cB, voffB); PG8_STAGE(PG8_SB(0, 1), cB + hstep, voffB); PG8_STAGE_A(PG8_SA(0, 0), cA, 0, false); PG8_STAGE_A(PG8_SA(0, 1), cA + hstepA, 1, false);
        if (wr == 1) PG8_BAR;
        PG8_WAIT_V(2); PG8_BAR;
        PG8_STAGE(PG8_SB(1, 0), cB + kstep, voffB); PG8_STAGE_A(PG8_SA(1, 0), cA + kstep, 0, false); PG8_STAGE(PG8_SB(1, 1), cB + hstep + kstep, voffB);
        PG8_WAIT_V(6); PG8_BAR;
    } else {
        PG8_STAGE(PG8_SB(0, 0), cB, voffB); PG8_STAGE(PG8_SA(0, 0), cA, voffA); PG8_STAGE(PG8_SB(0, 1), cB + hstep, voffB); PG8_STAGE(PG8_SA(0, 1), cA + hstep, voffA);
        if (wr == 1) PG8_BAR;
        PG8_WAIT_V(4); PG8_BAR;
        PG8_STAGE(PG8_SB(1, 0), cB + kstep, voffB); PG8_STAGE(PG8_SA(1, 0), cA + kstep, voffA); PG8_STAGE(PG8_SB(1, 1), cB + hstep + kstep, voffB);
        PG8_WAIT_V(6); PG8_BAR;
    }
    for (;;) {
        const bool has_next = S.next(ui + 1, nxt);
        const char* nA = has_next ? (const char*)g.A + (size_t)nxt.pm * tstepA : cA;
        if constexpr (GATHER) { if (has_next) PG8_GOFF(vn, nxt); else { vn[0][0] = vc[0][0]; vn[0][1] = vc[0][1]; vn[1][0] = vc[1][0]; vn[1][1] = vc[1][1]; } } const char* nB = has_next ? (const char*)g.Bt + (size_t)nxt.pn * tstep : cB;
        for (int t = 0; t < nt; t += 2) {
            const bool last = (t == nt - 2);
            const char* a1 = cA + (size_t)(t + 1) * kstep;
            const char* a2 = last ? nA : cA + (size_t)(t + 2) * kstep; const char* b2 = last ? nB : cB + (size_t)(t + 2) * kstep;
            const char* a3 = a2 + kstep; const char* b3 = b2 + kstep;
            if (last && has_next) S.a_ready(nxt);
            if constexpr (SP2) {
            PG8_LDB(B0, 0, 0); PG8_LDB(B1, 0, 1); PG8_SCHED; PG8_LDA(At, 0, 0); PG8_STAGE_A(PG8_SA(1, 1), a1 + hstepA, 1, false);
            PG8_WAIT_V(8); PG8_WAIT_L(0); PG8_BAR; PG8_MMA(0, 0, At, B0); PG8_MMA(0, 1, At, B1); PG8_BAR; PG8_SCHED;
            PG8_LDA(At, 0, 1); PG8_STAGE(PG8_SB(0, 0), b2, voffB); PG8_STAGE(PG8_SB(0, 1), b2 + hstep, voffB); PG8_STAGE_A(PG8_SA(0, 0), a2, 0, last);
            PG8_WAIT_V(8); PG8_WAIT_L(0); PG8_BAR; PG8_MMA(1, 0, At, B0); PG8_MMA(1, 1, At, B1); PG8_BAR; PG8_SCHED;
            PG8_LDB(B0, 1, 0); PG8_LDB(B1, 1, 1); PG8_SCHED; PG8_LDA(At, 1, 0); PG8_STAGE_A(PG8_SA(0, 1), a2 + hstepA, 1, last);
            PG8_WAIT_V(8); PG8_WAIT_L(0); PG8_BAR; PG8_MMA(0, 0, At, B0); PG8_MMA(0, 1, At, B1); PG8_BAR; PG8_SCHED;
            PG8_LDA(At, 1, 1); PG8_STAGE(PG8_SB(1, 0), b3, voffB); PG8_STAGE(PG8_SB(1, 1), b3 + hstep, voffB); PG8_STAGE_A(PG8_SA(1, 0), a3, 0, last);
            PG8_WAIT_V(8); PG8_WAIT_L(0); PG8_BAR; PG8_MMA(1, 0, At, B0); PG8_MMA(1, 1, At, B1); PG8_BAR; PG8_SCHED;
            } else {
            PG8_LDB(B0, 0, 0); PG8_SCHED; PG8_LDA(At, 0, 0); PG8_STAGE(PG8_SA(1, 1), a1 + hstep, voffA);
            PG8_WAIT_L(8); PG8_BAR; PG8_WAIT_L(0); PG8_MMA(0, 0, At, B0); PG8_BAR; PG8_SCHED;
            PG8_LDB(B1, 0, 1); PG8_STAGE(PG8_SB(0, 0), b2, voffB);
            PG8_BAR; PG8_WAIT_L(0); PG8_MMA(0, 1, At, B1); PG8_BAR;
            PG8_LDA(At, 0, 1); PG8_STAGE(PG8_SA(0, 0), a2, voffA);
            PG8_BAR; PG8_WAIT_L(0); PG8_MMA(1, 0, At, B0); PG8_BAR; PG8_SCHED;
            PG8_STAGE(PG8_SB(0, 1), b2 + hstep, voffB);
            PG8_WAIT_V(6); PG8_BAR; PG8_MMA(1, 1, At, B1); PG8_BAR;
            PG8_LDB(B0, 1, 0); PG8_SCHED; PG8_LDA(At, 1, 0); PG8_STAGE(PG8_SA(0, 1), a2 + hstep, voffA);
            PG8_WAIT_L(8); PG8_BAR; PG8_WAIT_L(0); PG8_MMA(0, 0, At, B0); PG8_BAR; PG8_SCHED;
            PG8_LDB(B1, 1, 1); PG8_STAGE(PG8_SB(1, 0), b3, voffB);
            PG8_BAR; PG8_WAIT_L(0); PG8_MMA(0, 1, At, B1); PG8_BAR;
            PG8_LDA(At, 1, 1); PG8_STAGE(PG8_SA(1, 0), a3, voffA);
            PG8_BAR; PG8_WAIT_L(0); PG8_MMA(1, 0, At, B0); PG8_BAR; PG8_SCHED;
            PG8_STAGE(PG8_SB(1, 1), b3 + hstep, voffB);
            PG8_WAIT_V(6); PG8_BAR; PG8_MMA(1, 1, At, B1); PG8_BAR;
            }
        }
        if constexpr (ALIGN_EPI) { if (wr == 0) PG8_BAR; }
        if constexpr (!Epi::AFTER_DRAIN) { E(acc, cur, wr, wc, fr, fq); S.done(cur); }
        if (!has_next) break;
#pragma unroll
        for (int a = 0; a < 2; ++a)
#pragma unroll
            for (int b = 0; b < 2; ++b)
#pragma unroll
                for (int m = 0; m < 4; ++m)
#pragma unroll
                    for (int n = 0; n < 2; ++n) acc[a][b][m][n] = (f32x4){0.f, 0.f, 0.f, 0.f};
        cur = nxt; cA = nA; cB = nB; ++ui;
        if constexpr (GATHER) { vc[0][0] = vn[0][0]; vc[0][1] = vn[0][1]; vc[1][0] = vn[1][0]; vc[1][1] = vn[1][1]; }
        if constexpr (ALIGN_EPI) { if (wr == 1) PG8_BAR; }
    }
    PG8_WAIT_V(0);
    if constexpr (!ALIGN_EPI) { if (wr == 0) PG8_BAR; }
    PG8_BAR;
    if constexpr (Epi::AFTER_DRAIN) { E.fused(acc, cur, wr, wc, fr, fq, lds, wid, lane); S.done(cur); }
#undef PG8_SA
#undef PG8_SB
#undef PG8_STAGE
#undef PG8_STAGE_A
#undef PG8_GOFF
#undef PG8_LDA
#undef PG8_LDB
#undef PG8_MMA
#undef PG8_WAIT_V
#undef PG8_WAIT_L
#undef PG8_BAR
#undef PG8_SCHED
}
}

constexpr int D = 2048, NB = 2, T = 16384, M = NB * T, CL = 256, MC = NB * CL, MT = M + MC;
constexpr int NH = 16, HD = 64, RWW = 1024;
constexpr int NPAD = 5120;
constexpr int C_R = 0, C_K = 1024, C_V = 2048, C_WD = 3072, C_AD = 3200, C_GD = 3328, C_Q = 3488, C_AK = 4512, C_AV = 4768, IN_COLS = 5024;
constexpr int NE = 16, CAP = 2048, FF = 1024, NSLOT = NB * NE * CAP;
constexpr float NORM_EPS = 1e-6f, GN_EPS = 64e-5f;
constexpr int NWAVES = 8, NTHR = 512;

constexpr size_t MiB = 1u << 20;
constexpr size_t WS_CTL = 0, CTL_ZERO_BYTES = 64 * 1024;
constexpr size_t WS_MOD = 1 * MiB;
constexpr size_t WS_ROPE = 1 * MiB + 512 * 1024;
constexpr size_t WS_G2T = 11 * MiB;
constexpr size_t WS_W2T = 11 * MiB + 384 * 1024, WS_A2T = 11 * MiB + 640 * 1024;
constexpr size_t WS_AFF = 2 * MiB;
constexpr size_t WS_IDX = 4 * MiB, WS_GATE = 4 * MiB + 512 * 1024;
constexpr size_t WS_SLOT = 5 * MiB;
constexpr size_t WS_BS = 7 * MiB;
constexpr size_t WS_WIN = 12 * MiB;
constexpr size_t WS_WOUT = 32 * MiB;
constexpr size_t WS_WPOOL = 40 * MiB;
constexpr size_t WS_WGU = 42 * MiB;
constexpr size_t WS_WD = 298 * MiB;
constexpr size_t WS_H = 426 * MiB;
constexpr size_t WS_PX = 556 * MiB;
constexpr size_t WS_MIX = 881 * MiB;
constexpr size_t WS_YD = 1009 * MiB;
constexpr size_t WS_END = 1265 * MiB;
static_assert(WS_WIN + (size_t)NPAD * D * 2 <= WS_WOUT && WS_WGU + (size_t)2 * 16 * 2048 * 2048 * 2 <= WS_WD && WS_WD + (size_t)2 * 16 * 2048 * 1024 * 2 <= WS_H, "ws map 1");
static_assert(WS_H + (size_t)MT * D * 2 <= WS_PX && WS_PX + (size_t)MT * NPAD * 2 <= WS_MIX && WS_MIX + (size_t)M * D * 2 <= WS_YD && WS_YD + (size_t)2 * M * RWW * 4 <= WS_END, "ws map 2");
constexpr int CW_BAR = 4096;

constexpr int RING_BYTES = 131072, LDSCTL_OFF = 147456, MISC_OFF = LDSCTL_OFF + 320, LDS_BYTES = 147456 + 512;

#define GAS __attribute__((address_space(1)))
#define LAS __attribute__((address_space(3)))
typedef unsigned short bf16;
typedef unsigned v4u __attribute__((ext_vector_type(4)));
typedef unsigned v2u __attribute__((ext_vector_type(2)));
typedef float f32x4 __attribute__((ext_vector_type(4)));
typedef float f32x2 __attribute__((ext_vector_type(2)));
typedef float f32x16 __attribute__((ext_vector_type(16)));
typedef short bf16x8 __attribute__((ext_vector_type(8)));
typedef short s16x4 __attribute__((ext_vector_type(4)));
#define LDS_WAIT() asm volatile("s_waitcnt lgkmcnt(0)" ::: "memory")

__device__ __forceinline__ unsigned f2bf(float f) { unsigned u = __builtin_bit_cast(unsigned, f); return (u + 0x7fffu + ((u >> 16) & 1u)) >> 16; }
typedef __bf16 bf16x2_t __attribute__((ext_vector_type(2)));
__device__ __forceinline__ unsigned pk2(float lo, float hi) { const f32x2 v = {lo, hi}; return __builtin_bit_cast(unsigned, __builtin_convertvector(v, bf16x2_t)); }
__device__ __forceinline__ float bf2f(unsigned short u) { return __builtin_bit_cast(float, (unsigned)u << 16); }
__device__ __forceinline__ float bflo(unsigned w) { return __builtin_bit_cast(float, w << 16); }
__device__ __forceinline__ float bfhi(unsigned w) { return __builtin_bit_cast(float, w & 0xffff0000u); }
__device__ __forceinline__ float wave_sum(float v) {
#pragma unroll
    for (int o = 1; o < 64; o <<= 1) v += __shfl_xor(v, o);
    return v;
}
__device__ __forceinline__ float rdlane(float v, int l) { return __builtin_bit_cast(float, __builtin_amdgcn_readlane(__builtin_bit_cast(int, v), l)); }

#define XB_TMO      128
#define XB_XCNT(j)  (256  + 64 * (j))
#define XB_XSUB(j)  (1280 + 64 * (j))
#define XB_XGEN(j)  (2304 + 64 * (j))
#define XB_TOP      3328
#define XB_TOPGEN   3392
#define XCD_BAR_WORDS 3456
#define XB_SPIN_CAP (1u << 23)

__device__ __forceinline__ unsigned xb_ld(unsigned* p)              { return __hip_atomic_load(p, __ATOMIC_RELAXED, __HIP_MEMORY_SCOPE_AGENT); }
__device__ __forceinline__ unsigned xb_add(unsigned* p, unsigned v) { return __hip_atomic_fetch_add(p, v, __ATOMIC_RELAXED, __HIP_MEMORY_SCOPE_AGENT); }
__device__ __forceinline__ unsigned xb_xcc_id() { return (unsigned)__builtin_amdgcn_s_getreg((3 << 11) | 20) & 0xFu; }
#define XB_SPIN(cond, bar) do { unsigned _sp = 0; while (cond) { __builtin_amdgcn_s_sleep(1); \
    if ((++_sp & 255u) == 0u) { if (xb_ld(&(bar)[XB_TMO])) break; if (_sp > XB_SPIN_CAP) { atomicAdd(&(bar)[XB_TMO], 1u); break; } } } } while (0)

struct XcdBarrier {
    unsigned* bar; unsigned x;
    volatile LAS unsigned* st;
};

__device__ __forceinline__ XcdBarrier xcd_barrier_post(unsigned* bar, volatile LAS unsigned* st) {
    XcdBarrier b; b.bar = bar; b.x = xb_xcc_id(); b.st = st;
    if (threadIdx.x == 0) (void)xb_add(&bar[XB_XCNT(b.x)], 1u);
    return b;
}
__device__ __forceinline__ void xcd_barrier_complete(unsigned* bar, unsigned x, unsigned& nloc, unsigned& nx) {
    const unsigned G = gridDim.x * gridDim.y * gridDim.z;
    unsigned sum, cnt, mine, sp = 0u;
    for (;;) {
        sum = 0u; cnt = 0u; mine = 0u;
#pragma unroll
        for (unsigned j = 0; j < 16; ++j) { const unsigned c = xb_ld(&bar[XB_XCNT(j)]); sum += c; cnt += (c > 0u) ? 1u : 0u; mine = (j == x) ? c : mine; }
        if (sum == G) break;
        __builtin_amdgcn_s_sleep(1);
        if ((++sp & 255u) == 0u) { if (xb_ld(&bar[XB_TMO])) break; if (sp > XB_SPIN_CAP) { atomicAdd(&bar[XB_TMO], 1u); break; } }
    }
    nloc = mine > 0u ? mine : 1u; nx = cnt > 0u ? cnt : 1u;
}

__device__ __forceinline__ void xcd_barrier(const XcdBarrier& b) {
    asm volatile("s_waitcnt vmcnt(0)" ::: "memory");
    __syncthreads();
    if (threadIdx.x == 0) {
        unsigned* bar = b.bar;
        __builtin_amdgcn_s_waitcnt(0);
        unsigned nloc = b.st[0], nx = b.st[1];
        if (nloc == 0u) { xcd_barrier_complete(bar, b.x, nloc, nx); b.st[0] = nloc; b.st[1] = nx; }
        const unsigned old = xb_add(&bar[XB_XSUB(b.x)], 1u);
        const unsigned gen = old / nloc;
        if (old + 1u == (gen + 1u) * nloc) {
            __builtin_amdgcn_fence(__ATOMIC_RELEASE, "agent");
            asm volatile("s_waitcnt vmcnt(0)" ::: "memory");
            const unsigned og = xb_add(&bar[XB_TOP], 1u);
            const unsigned tg = og / nx;
            if (og + 1u == (tg + 1u) * nx) xb_add(&bar[XB_TOPGEN], 1u);
            else XB_SPIN(xb_ld(&bar[XB_TOPGEN]) == tg, bar);
            __builtin_amdgcn_fence(__ATOMIC_ACQUIRE, "agent");
            xb_add(&bar[XB_XGEN(b.x)], 1u);
            asm volatile("s_waitcnt vmcnt(0)" ::: "memory");
        } else {
            XB_SPIN(xb_ld(&bar[XB_XGEN(b.x)]) == gen, bar);
            __builtin_amdgcn_fence(__ATOMIC_ACQUIRE, "agent");
            asm volatile("s_waitcnt vmcnt(0)" ::: "memory");
        }
    }
    __syncthreads();
}

enum { I_X = 0, I_C, I_CTX, I_CCTX, I_ADAW, I_ADAB, I_NMIX, I_NFFN, I_WIN, I_MU, I_W0, I_W2, I_A0, I_A2, I_G2, I_KK, I_KA, I_RK, I_LNW, I_LNB, I_SINK, I_WOUT, I_POOLW, I_POOLS, I_ROUTER, I_EG, I_EU, I_ED, I_NFIN, N_IN };
struct Args { const float* in[N_IN]; float* out; unsigned char* ws; int ph_lo, ph_hi; };
static_assert(sizeof(Args) == N_IN * 8 + 24, "Args has no padding");
typedef __attribute__((address_space(4))) const Args* KArgP;

__device__ __forceinline__ f32x4 ld4bf(const bf16* p) { const v2u w = *(const v2u*)p; return (f32x4){bflo(w.x), bfhi(w.x), bflo(w.y), bfhi(w.y)}; }
__device__ __forceinline__ const float* modp(const unsigned char* ws, int l, int r, int chunk) { return (const float*)(ws + WS_MOD) + (size_t)((l * 3 + r) * 6 + chunk) * D; }

template <int MODE>
__device__ __forceinline__ void tr_item(const float* W, int ldw, int k0, int n0, bf16* WT, int ldt, int lane, LAS float* scr) {
    const int row8 = lane >> 3, c4 = lane & 7;
    f32x4 v[8];
#pragma unroll
    for (int i = 0; i < 8; ++i) v[i] = *(const f32x4*)(W + (size_t)(k0 + 8 * i + row8) * ldw + n0 + 4 * c4);
#pragma unroll
    for (int i = 0; i < 8; ++i) { LAS float* w = scr + (8 * i + row8) * 33 + 4 * c4; w[0] = v[i].x; w[1] = v[i].y; w[2] = v[i].z; w[3] = v[i].w; }
    LDS_WAIT(); asm volatile("" ::: "memory");
    const int c = lane & 7;
#pragma unroll
    for (int j = 0; j < 4; ++j) { const int n = (lane >> 3) + 8 * j; const LAS float* s = scr + (8 * c) * 33 + n;
        v4u o; o.x = pk2(s[0 * 33], s[1 * 33]); o.y = pk2(s[2 * 33], s[3 * 33]); o.z = pk2(s[4 * 33], s[5 * 33]); o.w = pk2(s[6 * 33], s[7 * 33]);
        const int ns = n0 + n; const int drow = (MODE == 0) ? ns : (256 * (ns >> 7) + (ns & 127) + (MODE == 2 ? 128 : 0));
        *(v4u*)(WT + (size_t)drow * ldt + k0 + 8 * c) = o; }
    LDS_WAIT(); asm volatile("" ::: "memory");
}

__device__ __forceinline__ void p0_prologue(const Args& a, LAS unsigned char* lds, int tid, int lane, int wave, int bid, int G) {
    unsigned char* ws = a.ws;
    {
        LAS float* sv = (LAS float*)lds;
        LAS float* red = (LAS float*)(lds + 3 * 2048 * 4);
        for (int i = tid; i < 3 * 2048; i += NTHR) { const int r = i >> 11, k = i & 2047; const float v = (r < 2) ? a.in[I_C][r * 2048 + k] : a.in[I_CCTX][k]; sv[i] = v / (1.f + __expf(-v)); }
        __syncthreads();
        for (int slab = bid; slab < 256; slab += G) {
            const int l = slab >> 7, col0 = (slab & 127) * 96;
            const int cg = tid % 24, kg = tid / 24;
            if (kg < 16) {
                f32x4 acc0 = {0.f, 0.f, 0.f, 0.f}, acc1 = acc0, acc2 = acc0;
                const float* wp = a.in[I_ADAW] + ((size_t)l * 2048 + kg * 128) * 12288 + col0 + 4 * cg;
#pragma unroll 16
                for (int k = 0; k < 128; ++k) { const f32x4 w = __builtin_nontemporal_load((const f32x4*)(wp + (size_t)k * 12288)); const int kk = kg * 128 + k;
                    acc0 += w * sv[kk]; acc1 += w * sv[2048 + kk]; acc2 += w * sv[4096 + kk]; }
                *(LAS f32x4*)(red + (kg * 3 + 0) * 96 + 4 * cg) = acc0; *(LAS f32x4*)(red + (kg * 3 + 1) * 96 + 4 * cg) = acc1; *(LAS f32x4*)(red + (kg * 3 + 2) * 96 + 4 * cg) = acc2;
            }
            __syncthreads();
            if (tid < 288) { const int r = tid / 96, ci = tid % 96; float s = a.in[I_ADAB][l * 12288 + col0 + ci];
#pragma unroll
                for (int k = 0; k < 16; ++k) s += red[(k * 3 + r) * 96 + ci];
                ((float*)(ws + WS_MOD))[(size_t)(l * 3 + r) * 12288 + col0 + ci] = s; }
            __syncthreads();
        }
    }
    {
        for (int i = bid * NTHR + tid; i < 320 * 16; i += G * NTHR) { const int pos = (i >> 4) < 256 ? (i >> 4) : (i >> 4) - 256, fi = i & 15;
            const double inv4[4] = {1.0, 0.5623413251903491, 0.31622776601683794, 0.1778279410038923};
            double inv = inv4[fi & 3]; const int q = fi >> 2; inv *= (q == 0 ? 1.0 : q == 1 ? 0.1 : q == 2 ? 0.01 : 0.001);
            const float angf = (float)pos * (float)inv;
            const double rev = (double)angf * 0.15915494309189535; const float fr = (float)(rev - __builtin_rint(rev));
            f32x2 cs; cs.x = __builtin_amdgcn_cosf(fr); cs.y = __builtin_amdgcn_sinf(fr);
            ((f32x2*)(ws + WS_ROPE))[i] = cs; }
    }
    for (int i = bid * NTHR + tid; i < 1024 * 160; i += G * NTHR) { const int k = i >> 10, ch = i & 1023;
        const int frag = ((ch >> 6) * 2 + ((ch >> 5) & 1)) * 10 + (k >> 4); ((bf16*)(ws + WS_G2T))[(frag * 64 + ((k >> 3) & 1) * 32 + (ch & 31)) * 8 + (k & 7)] = (bf16)f2bf(a.in[I_G2][i]); }
    for (int i = bid * NTHR + tid; i < 2 * 1024 * 64; i += G * NTHR) { const int dd = i >> 16, k = (i >> 10) & 63, c = i & 1023;
        const int frag = ((dd * 16 + (c >> 6)) * 2 + ((c >> 5) & 1)) * 4 + (k >> 4), o = (frag * 64 + ((k >> 3) & 1) * 32 + (c & 31)) * 8 + (k & 7);
        ((bf16*)(ws + WS_W2T))[o] = (bf16)f2bf(a.in[I_W2][(size_t)(dd * 64 + k) * RWW + c]); ((bf16*)(ws + WS_A2T))[o] = (bf16)f2bf(a.in[I_A2][(size_t)(dd * 64 + k) * RWW + c]); }
    { v4u* z = (v4u*)(ws + WS_WIN + (size_t)IN_COLS * D * 2); const int n16 = (NPAD - IN_COLS) * D * 2 / 16; for (int i = bid * NTHR + tid; i < n16; i += G * NTHR) z[i] = (v4u){0u, 0u, 0u, 0u}; }
    {
        LAS float* scr = (LAS float*)(lds + wave * 16384);
        const int gw = bid * NWAVES + wave, NGW = G * NWAVES;
        constexpr int I_IN = 32 * 157, I_OUT = 32 * 64, I_POOL = 4 * 128;
        constexpr int NITEMS = I_IN + I_OUT + I_POOL;
        for (int it = gw; it < NITEMS; it += NGW) {
            int r = it;
            if (r < I_IN) { tr_item<0>(a.in[I_WIN], IN_COLS, 64 * (r / 157), 32 * (r % 157), (bf16*)(ws + WS_WIN), D, lane, scr); continue; } r -= I_IN;
            if (r < I_OUT) { tr_item<0>(a.in[I_WOUT], D, 64 * (r / 64), 32 * (r % 64), (bf16*)(ws + WS_WOUT), D, lane, scr); continue; } r -= I_OUT;
            if (r < I_POOL) { const int g = r >> 7, rr = r & 127; tr_item<0>(a.in[I_POOLW] + (size_t)g * 512 * 512, 512, 64 * (rr / 16), 32 * (rr % 16), (bf16*)(ws + WS_WPOOL) + (size_t)g * 512 * 512, 512, lane, scr); }
        }
    }
}


struct TrDesc { const float* src; bf16* dst; int ldw, k0, n0, ldt, mode; };
__device__ __forceinline__ TrDesc conv_decode(const Args& a, int l, int it) {
    constexpr int I_GU = 16 * 2048; TrDesc d;
    if (it < I_GU) { const int le = l * 16 + (it >> 11), rem = it & 2047, mat = rem >> 10, rr = rem & 1023;
        d.src = (mat ? a.in[I_EU] : a.in[I_EG]) + (size_t)le * 2048 * 1024; d.dst = (bf16*)(a.ws + WS_WGU) + (size_t)le * 2048 * 2048; d.ldw = FF; d.k0 = 64 * (rr >> 5); d.n0 = 32 * (rr & 31); d.ldt = D; d.mode = 1 + mat; }
    else { const int r = it - I_GU, le = l * 16 + (r >> 10), rr = r & 1023;
        d.src = a.in[I_ED] + (size_t)le * 1024 * 2048; d.dst = (bf16*)(a.ws + WS_WD) + (size_t)le * 2048 * 1024; d.ldw = D; d.k0 = 64 * (rr >> 6); d.n0 = 32 * (rr & 63); d.ldt = FF; d.mode = 0; }
    return d;
}
constexpr int CONV_NIT = 16 * 2048 + 16 * 1024;
__device__ __forceinline__ int conv_tail_blocks(int G) { return ((MT / 256) * (NPAD / 256)) % G; }
__device__ __forceinline__ int conv_tail_items(int G) { const int tb = conv_tail_blocks(G); if (tb == 0) return 0; const int n = (G - tb) * NWAVES * 8; return n < CONV_NIT ? n : CONV_NIT; }
__device__ __forceinline__ void conv_experts(const Args& a, int l, LAS unsigned char* lds, int lane, int wave, int vb, int VG, int it_lo, int NIT) {
    LAS float* scr = (LAS float*)(lds + wave * 16384);
    constexpr int NB4 = 4; const int stride = VG * NWAVES, row8 = lane >> 3, c4 = lane & 7, c = lane & 7;
#pragma unroll 1
    for (int it0 = it_lo + vb * NWAVES + wave; it0 < NIT; it0 += NB4 * stride) {
        TrDesc d[NB4]; f32x4 v[NB4][8];
#pragma unroll
        for (int u = 0; u < NB4; ++u) { const int it = it0 + u * stride; d[u] = conv_decode(a, l, it < NIT ? it : it0);
#pragma unroll
            for (int i = 0; i < 8; ++i) v[u][i] = __builtin_nontemporal_load((const f32x4*)(d[u].src + (size_t)(d[u].k0 + 8 * i + row8) * d[u].ldw + d[u].n0 + 4 * c4)); }
#pragma unroll
        for (int u = 0; u < NB4; ++u) { if (it0 + u * stride >= NIT) break;
#pragma unroll
            for (int i = 0; i < 8; ++i) { LAS float* w = scr + (8 * i + row8) * 33 + 4 * c4; w[0] = v[u][i].x; w[1] = v[u][i].y; w[2] = v[u][i].z; w[3] = v[u][i].w; }
            LDS_WAIT(); asm volatile("" ::: "memory");
#pragma unroll
            for (int j = 0; j < 4; ++j) { const int n = (lane >> 3) + 8 * j; const LAS float* s = scr + (8 * c) * 33 + n;
                v4u o; o.x = pk2(s[0 * 33], s[1 * 33]); o.y = pk2(s[2 * 33], s[3 * 33]); o.z = pk2(s[4 * 33], s[5 * 33]); o.w = pk2(s[6 * 33], s[7 * 33]);
                const int ns = d[u].n0 + n; const int drow = (d[u].mode == 0) ? ns : (256 * (ns >> 7) + (ns & 127) + (d[u].mode == 2 ? 128 : 0));
                *(v4u*)(d[u].dst + (size_t)drow * d[u].ldt + d[u].k0 + 8 * c) = o; }
            LDS_WAIT(); asm volatile("" ::: "memory"); }
    }
}

__device__ __forceinline__ void load_coef(const float* g, const float* sc, const float* sh, int lane, f32x4 (&A)[8], f32x4 (&B)[8]) {
#pragma unroll
    for (int j = 0; j < 8; ++j) { const int col = 4 * lane + 256 * j; const f32x4 gv = *(const f32x4*)(g + col), sv = *(const f32x4*)(sc + col); A[j] = gv * (sv + 1.f); B[j] = *(const f32x4*)(sh + col); }
}
__device__ __forceinline__ float row_rstd(const f32x4 (&v)[8]) {
    float s = 0.f;
#pragma unroll
    for (int j = 0; j < 8; ++j) s += (v[j].x * v[j].x + v[j].y * v[j].y) + (v[j].z * v[j].z + v[j].w * v[j].w);
    return 1.f / sqrtf(wave_sum(s) * (1.f / D) + NORM_EPS);
}
__device__ __forceinline__ void load_row_bf16(const bf16* irow, f32x4 (&v)[8], int lane) {
    const v2u* p = (const v2u*)irow + lane;
#pragma unroll
    for (int j = 0; j < 8; ++j) { const v2u w = p[64 * j]; v[j] = (f32x4){bflo(w.x), bfhi(w.x), bflo(w.y), bfhi(w.y)}; }
}
__device__ __forceinline__ void store_row_bf16(bf16* orow, const f32x4 (&o)[8], int lane) {
    unsigned long long* o8 = (unsigned long long*)orow + lane;
#pragma unroll
    for (int j = 0; j < 8; ++j) o8[64 * j] = (unsigned long long)pk2(o[j].x, o[j].y) | ((unsigned long long)pk2(o[j].z, o[j].w) << 32);
}
__device__ __forceinline__ void p1_norm0(const Args& a, int lane, int wave, int bid, int G) {
    const int gw = bid * NWAVES + wave, NGW = G * NWAVES; bf16* h0 = (bf16*)(a.ws + WS_H);
    f32x4 A[8], B[8];
    for (int ch = gw; ch < M / 16; ch += NGW) {
        const int b = ch / (T / 16);
        load_coef(a.in[I_NMIX], modp(a.ws, 0, b, 1), modp(a.ws, 0, b, 0), lane, A, B);
        f32x4 nx[8];
        { const f32x4* xr = (const f32x4*)(a.in[I_X] + (size_t)ch * 16 * D) + lane;
#pragma unroll
          for (int j = 0; j < 8; ++j) nx[j] = xr[64 * j]; }
#pragma unroll 1
        for (int rr = 0; rr < 16; ++rr) { const size_t row = (size_t)ch * 16 + rr; f32x4 v[8];
#pragma unroll
            for (int j = 0; j < 8; ++j) v[j] = nx[j];
            if (rr + 1 < 16) { const f32x4* xr = (const f32x4*)(a.in[I_X] + (row + 1) * D) + lane;
#pragma unroll
                for (int j = 0; j < 8; ++j) nx[j] = xr[64 * j]; }
            const float rstd = row_rstd(v);
#pragma unroll
            for (int j = 0; j < 8; ++j) v[j] = v[j] * rstd * A[j] + B[j];
            store_row_bf16(h0 + row * D, v, lane); }
    }
    if (gw < MC) {
        load_coef(a.in[I_NMIX], modp(a.ws, 0, 2, 1), modp(a.ws, 0, 2, 0), lane, A, B);
        for (int r = gw; r < MC; r += NGW) { f32x4 v[8]; const f32x4* xr = (const f32x4*)(a.in[I_CTX] + (size_t)r * D) + lane;
#pragma unroll
            for (int j = 0; j < 8; ++j) v[j] = xr[64 * j];
            const float rstd = row_rstd(v);
#pragma unroll
            for (int j = 0; j < 8; ++j) v[j] = v[j] * rstd * A[j] + B[j];
            store_row_bf16(h0 + (size_t)(M + r) * D, v, lane); }
    }
}

__device__ __forceinline__ f32x16 mfma32(bf16x8 a, bf16x8 b, f32x16 c) { return __builtin_amdgcn_mfma_f32_32x32x16_bf16(a, b, c, 0, 0, 0); }
__device__ __forceinline__ void rope8(v4u& A_, v4u& B_, const f32x2* tb, float scale) {
#pragma unroll
    for (int w = 0; w < 4; ++w) { const float a0 = bflo(A_[w]), a1 = bfhi(A_[w]), b0 = bflo(B_[w]), b1 = bfhi(B_[w]); const f32x2 c0 = tb[2 * w], c1 = tb[2 * w + 1];
        A_[w] = pk2((a0 * c0.x - b0 * c0.y) * scale, (a1 * c1.x - b1 * c1.y) * scale); B_[w] = pk2((b0 * c0.x + a0 * c0.y) * scale, (b1 * c1.x + a1 * c1.y) * scale); }
}
__device__ __forceinline__ void p3_attention(const Args& a, LAS unsigned char* lds, int tid, int lane, int wave, int bid, int G) {
    constexpr float LOG2E = 1.4426950408889634f, QS = 0.125f * LOG2E;
    constexpr int KT_BYTES = 32 * 144, VT_PITCH = 192, VT_BYTES = 32 * VT_PITCH;
    const bf16* px = (const bf16*)(a.ws + WS_PX); bf16* mix = (bf16*)(a.ws + WS_MIX);
    const f32x2* tabR = (const f32x2*)(a.ws + WS_ROPE); const f32x2* tabC = tabR + 256 * 16;
    LAS unsigned char* Kl = lds; LAS unsigned char* Vl = lds + 4 * KT_BYTES;
    const int h = lane >> 5, l31 = lane & 31;
    for (int unit = bid; unit < 1024; unit += G) {
        const int b = unit >> 9, kvh = (unit >> 7) & 3, qb = unit & 127;
        const int qhead = kvh * 4 + (wave >> 1), q0w = qb * 128 + 64 * (wave & 1);
        bf16x8 qf[2][4];
#pragma unroll
        for (int qt = 0; qt < 2; ++qt) {
            const int qpos = q0w + 32 * qt + l31;
            const bf16* qp = px + (size_t)(b * T + qpos) * NPAD + C_Q + qhead * 64 + 8 * h;
            v4u raw[4];
#pragma unroll
            for (int s = 0; s < 4; ++s) raw[s] = *(const v4u*)(qp + 16 * s);
            rope8(raw[0], raw[1], tabR + (qpos >> 6) * 16 + 8 * h, QS);
            rope8(raw[2], raw[3], tabC + (qpos & 63) * 16 + 8 * h, QS);
#pragma unroll
            for (int s = 0; s < 4; ++s) qf[qt][s] = __builtin_bit_cast(bf16x8, raw[s]);
        }
        float mrun[2], lrun[2]; f32x16 O[2][2];
#pragma unroll
        for (int qt = 0; qt < 2; ++qt) { mrun[qt] = a.in[I_SINK][qhead] * LOG2E; lrun[qt] = 1.f;
#pragma unroll
            for (int dt = 0; dt < 2; ++dt)
#pragma unroll
                for (int r = 0; r < 16; ++r) O[qt][dt][r] = 0.f; }
        const int skk = tid >> 2, sp = tid & 3, sbase = 32 * (sp >> 1) + 8 * (sp & 1);
        v4u rka, rkb, rv0, rv1; bool rvalid, rctx; int rkp;
#define ATT_PREFETCH(grp_) do { const int gk_ = (grp_) * 128 + skk; rctx = gk_ < 256; rkp = qb * 128 - 128 + (gk_ - 256); rvalid = rctx || (rkp >= 0 && rkp < T); \
            const size_t row_ = rctx ? (size_t)(M + b * CL + gk_) : (size_t)(b * T + (rvalid ? rkp : 0)); const bf16* rp_ = px + row_ * NPAD; \
            rka = (v4u){0u, 0u, 0u, 0u}; rkb = rka; rv0 = rka; rv1 = rka; \
            if (rvalid) { rka = *(const v4u*)(rp_ + C_AK + kvh * 64 + sbase); rkb = *(const v4u*)(rp_ + C_AK + kvh * 64 + sbase + 16); rv0 = *(const v4u*)(rp_ + C_AV + kvh * 64 + 16 * sp); rv1 = *(const v4u*)(rp_ + C_AV + kvh * 64 + 16 * sp + 8); } } while (0)
        ATT_PREFETCH(0);
        for (int grp = 0; grp < 5; ++grp) {
            __syncthreads();
            {
                v4u ka = rka, kb = rkb;
                if (rvalid && !rctx) rope8(ka, kb, ((sp >> 1) ? tabC + (rkp & 63) * 16 : tabR + (rkp >> 6) * 16) + 8 * (sp & 1), 1.f);
                LAS unsigned char* kd = Kl + (skk >> 5) * KT_BYTES + (skk & 31) * 144;
                *(LAS v4u*)(kd + sbase * 2) = ka; *(LAS v4u*)(kd + (sbase + 16) * 2) = kb;
                { LAS unsigned char* vd = Vl + (skk >> 5) * VT_BYTES + (skk & 31) * VT_PITCH + sp * 32; *(LAS v4u*)vd = rv0; *(LAS v4u*)(vd + 16) = rv1; }
                if (grp + 1 < 5) ATT_PREFETCH(grp + 1);
            }
            __syncthreads();
#pragma unroll 1
            for (int tl = 0; tl < 4; ++tl) {
                const int tile = grp * 4 + tl; const bool isctx = tile < 8; const int k0 = qb * 128 - 128 + (tile - 8) * 32;
                bool need[2], interior[2];
#pragma unroll
                for (int qt = 0; qt < 2; ++qt) { const int q0 = q0w + 32 * qt;
                    need[qt] = isctx || (k0 + 31 >= q0 - 128 && k0 <= q0 + 31 + 128 && k0 + 31 >= 0 && k0 < T);
                    interior[qt] = isctx || (k0 >= q0 + 31 - 128 && k0 + 31 <= q0 + 128 && k0 >= 0 && k0 + 31 < T); }
                if (!(need[0] || need[1])) continue;
                bf16x8 kf[4], vf[2][2];
#pragma unroll
                for (int s = 0; s < 4; ++s) kf[s] = *(const LAS bf16x8*)(Kl + tl * KT_BYTES + l31 * 144 + (16 * s + 8 * h) * 2);
#pragma unroll
                for (int dt = 0; dt < 2; ++dt)
#pragma unroll
                    for (int sp = 0; sp < 2; ++sp) {
                        const LAS unsigned char* vp = Vl + tl * VT_BYTES + (16 * sp + 4 * h + ((lane & 15) >> 2)) * VT_PITCH + (32 * dt + 16 * ((lane >> 4) & 1) + 4 * (lane & 3)) * 2;
                        const s16x4 lo = __builtin_amdgcn_ds_read_tr16_b64_v4i16((LAS s16x4*)vp), hi = __builtin_amdgcn_ds_read_tr16_b64_v4i16((LAS s16x4*)(vp + 8 * VT_PITCH));
                        vf[dt][sp] = (bf16x8){lo.x, lo.y, lo.z, lo.w, hi.x, hi.y, hi.z, hi.w}; }
#pragma unroll
                for (int qt = 0; qt < 2; ++qt) {
                    if (!need[qt]) continue;
                    f32x16 s;
#pragma unroll
                    for (int r = 0; r < 16; ++r) s[r] = 0.f;
#pragma unroll
                    for (int st = 0; st < 4; ++st) s = mfma32(kf[st], qf[qt][st], s);
                    if (!interior[qt]) { const int qpos = q0w + 32 * qt + l31;
#pragma unroll
                        for (int r = 0; r < 16; ++r) { const int kp = k0 + (r & 3) + 8 * (r >> 2) + 4 * h, dl = kp - qpos; const bool ok = dl >= -128 && dl <= 128 && kp >= 0 && kp < T; s[r] = ok ? s[r] : -__builtin_inff(); } }
                    float mx = s[0];
#pragma unroll
                    for (int r = 1; r < 16; ++r) mx = fmaxf(mx, s[r]);
                    mx = fmaxf(mx, __shfl_xor(mx, 32));
                    const float mn = fmaxf(mrun[qt], mx), alpha = __builtin_amdgcn_exp2f(mrun[qt] - mn); mrun[qt] = mn;
                    float rs = 0.f;
#pragma unroll
                    for (int r = 0; r < 16; ++r) { s[r] = __builtin_amdgcn_exp2f(s[r] - mn); rs += s[r]; }
                    rs += __shfl_xor(rs, 32); lrun[qt] = lrun[qt] * alpha + rs;
                    if (__any(alpha != 1.f)) {
#pragma unroll
                    for (int dt = 0; dt < 2; ++dt)
#pragma unroll
                        for (int r = 0; r < 16; ++r) O[qt][dt][r] *= alpha; }
                    bf16x8 pf[2];
#pragma unroll
                    for (int sp = 0; sp < 2; ++sp) { v4u w;
#pragma unroll
                        for (int i = 0; i < 4; ++i) w[i] = pk2(s[8 * sp + 2 * i], s[8 * sp + 2 * i + 1]);
                        pf[sp] = __builtin_bit_cast(bf16x8, w); }
#pragma unroll
                    for (int dt = 0; dt < 2; ++dt)
#pragma unroll
                        for (int sp = 0; sp < 2; ++sp) O[qt][dt] = mfma32(vf[dt][sp], pf[sp], O[qt][dt]);
                }
            }
        }
#pragma unroll
        for (int qt = 0; qt < 2; ++qt) { const float inv = 1.f / lrun[qt];
            LAS unsigned char* ob = lds + 45056 + wave * 4608;
#pragma unroll
            for (int dt = 0; dt < 2; ++dt)
#pragma unroll
                for (int rg = 0; rg < 4; ++rg) { v2u w; w.x = pk2(O[qt][dt][4 * rg] * inv, O[qt][dt][4 * rg + 1] * inv); w.y = pk2(O[qt][dt][4 * rg + 2] * inv, O[qt][dt][4 * rg + 3] * inv);
                    *(LAS v2u*)(ob + l31 * 144 + (32 * dt + 8 * rg + 4 * h) * 2) = w; }
            LDS_WAIT(); asm volatile("" ::: "memory");
#pragma unroll
            for (int j = 0; j < 4; ++j) { const int rr = (lane >> 3) + 8 * j; const v4u x = *(const LAS v4u*)(ob + rr * 144 + (lane & 7) * 16);
                *(v4u*)(mix + (size_t)(b * T + q0w + 32 * qt + rr) * D + RWW + qhead * 64 + (lane & 7) * 8) = x; }
            LDS_WAIT(); asm volatile("" ::: "memory"); }
    }
}


constexpr int RW_WLDS = 18432, RW_GAM = 16384, RW_PAR = 16640, LP = 3584;

struct LerpBuf { v4u r[10]; f32x4 m0, m1; };
__device__ __forceinline__ void lerp_load(LerpBuf& B, const bf16* __restrict__ px, const float* mu, long it) {
    constexpr int NCG = 3488 / 8, NCGP = 448, RB = 8;
    const int rb = (int)(it / NCGP), cg = (int)(it % NCGP), row0 = rb * RB; if (cg >= NCG) return; int t0, len; if (row0 < M) { t0 = row0 & (T - 1); len = T; } else { t0 = (row0 - M) & (CL - 1); len = CL; }
    const bf16* base = px + (size_t)row0 * NPAD + 8 * cg;
    B.r[0] = (v4u){0u, 0u, 0u, 0u}; B.r[RB + 1] = B.r[0];
    if (t0 > 0) B.r[0] = *(const v4u*)(base - NPAD);
#pragma unroll
    for (int i = 0; i < RB; ++i) B.r[i + 1] = *(const v4u*)(base + (size_t)i * NPAD);
    if (t0 + RB < len) B.r[RB + 1] = *(const v4u*)(base + (size_t)RB * NPAD);
    B.m0 = *(const f32x4*)(mu + 8 * cg); B.m1 = *(const f32x4*)(mu + 8 * cg + 4);
}
__device__ __forceinline__ void lerp_comp(const LerpBuf& B, bf16* __restrict__ pxl, long it) {
    constexpr int NCG = 3488 / 8, NCGP = 448, RB = 8;
    const int rb = (int)(it / NCGP), cg = (int)(it % NCGP), row0 = rb * RB; if (cg >= NCG) return; const bool th = (8 * cg >= C_WD && 8 * cg < C_AD);
    f32x2 m1[4], m2[4];
#pragma unroll
    for (int w = 0; w < 4; ++w) { const f32x2 m = (w < 2) ? (f32x2){B.m0[2 * w], B.m0[2 * w + 1]} : (f32x2){B.m1[2 * w - 4], B.m1[2 * w - 3]}; m1[w] = 1.f - m; m2[w] = 0.5f * m; }
    f32x2 pv[4], cu[4];
#pragma unroll
    for (int w = 0; w < 4; ++w) { pv[w] = (f32x2){bflo(B.r[0][w]), bfhi(B.r[0][w])}; cu[w] = (f32x2){bflo(B.r[1][w]), bfhi(B.r[1][w])}; }
#pragma unroll
    for (int i = 0; i < RB; ++i) { f32x2 nx[4], o[4];
#pragma unroll
        for (int w = 0; w < 4; ++w) { nx[w] = (f32x2){bflo(B.r[i + 2][w]), bfhi(B.r[i + 2][w])}; o[w] = cu[w] * m1[w] + m2[w] * (pv[w] + nx[w]); }
        if (th) {
#pragma unroll
            for (int w = 0; w < 4; ++w) { o[w].x = 1.f - 2.f * __builtin_amdgcn_rcpf(1.f + __expf(2.f * o[w].x)); o[w].y = 1.f - 2.f * __builtin_amdgcn_rcpf(1.f + __expf(2.f * o[w].y)); } }
        v4u ov;
#pragma unroll
        for (int w = 0; w < 4; ++w) { ov[w] = pk2(o[w].x, o[w].y); pv[w] = cu[w]; cu[w] = nx[w]; }
        *(v4u*)(pxl + (size_t)(row0 + i) * LP + 8 * cg) = ov; }
}
__device__ __forceinline__ void lerp_phase(const Args& a, int tid, int bid, int G) {
    const bf16* __restrict__ px = (const bf16*)(a.ws + WS_PX); bf16* __restrict__ pxl = (bf16*)a.out; const float* mu = a.in[I_MU];
    constexpr int NCGP = 448, RB = 8; const long total = (long)(MT / RB) * NCGP, stride = (long)G * NTHR;
    long it = (long)bid * NTHR + tid; if (it >= total) return;
    LerpBuf A, B;
    lerp_load(A, px, mu, it);
#pragma unroll 1
    for (; it < total; it += 2 * stride) {
        const bool hb = it + stride < total; if (hb) lerp_load(B, px, mu, it + stride);
        lerp_comp(A, pxl, it);
        if (hb) { if (it + 2 * stride < total) lerp_load(A, px, mu, it + 2 * stride); lerp_comp(B, pxl, it + stride); }
    }
}

#undef ATT_PREFETCH
constexpr size_t WS_PSTART = WS_H + 60 * MiB;
constexpr size_t WS_HSUP = WS_H, WS_PSUP = WS_H + 40 * MiB;
enum { FA = 0, FBT, FKT, FRT };
__device__ __forceinline__ unsigned cvtpk(float lo, float hi) { return pk2(lo, hi); }
__device__ __forceinline__ bf16x8 packt(const f32x16& t, int ks) { v4u w;
#pragma unroll
    for (int i = 0; i < 4; ++i) w[i] = cvtpk(t[8 * ks + 2 * i], t[8 * ks + 2 * i + 1]);
    return __builtin_bit_cast(bf16x8, w); }
__device__ __forceinline__ f32x16 zero16() { f32x16 z;
#pragma unroll
    for (int r = 0; r < 16; ++r) z[r] = 0.f;
    return z; }
__device__ __forceinline__ bf16x8 ldfrag(const LAS unsigned char* wl, int arr, int ct, int ks, int lane) { return *(const LAS bf16x8*)(wl + arr * 4096 + ((ct * 2 + ks) * 64 + lane) * 16); }
__device__ __forceinline__ float scan32(float v, int l31) {
    (void)l31;
#define DPP_ADD(ctrl, rmask) v += __builtin_bit_cast(float, __builtin_amdgcn_update_dpp(0, __builtin_bit_cast(int, v), ctrl, rmask, 0xF, false))
    DPP_ADD(0x111, 0xF); DPP_ADD(0x112, 0xF); DPP_ADD(0x114, 0xF); DPP_ADD(0x118, 0xF); DPP_ADD(0x142, 0xA);
#undef DPP_ADD
    return v; }

template <int MODE, bool TRACK = false>
__device__ __forceinline__ void rwkv_run(KArgP kap, LAS unsigned char* wl, int lane, int seq, int sc, f32x16 (&ST)[2][2], f32x4* uscr = nullptr, v4u* wscr = nullptr) {
    const int d = seq >> 5, b = (seq >> 4) & 1, hh = seq & 15;
#define LL() int ln_ = lane; asm volatile("" : "+v"(ln_)); const int h = ln_ >> 5, l31 = ln_ & 31; (void)h; (void)l31
#define MKIP() bf16x8 ip[2]; _Pragma("unroll") for (int ks = 0; ks < 2; ++ks) { s16x4 lo, hi; _Pragma("unroll") for (int j = 0; j < 4; ++j) { lo[j] = (16 * ks + 4 * h + j == l31) ? (short)0x3F80 : (short)0; hi[j] = (16 * ks + 8 + 4 * h + j == l31) ? (short)0x3F80 : (short)0; } ip[ks] = (bf16x8){lo.x, lo.y, lo.z, lo.w, hi.x, hi.y, hi.z, hi.w}; }
    const int nch = sc < 8 ? 17 : 16, c0 = sc < 8 ? 17 * sc : 136 + 16 * (sc - 8);
    { const Args& a0_ = *(const Args*)kap; LAS float* par = (LAS float*)(wl + RW_PAR);
      par[lane] = a0_.in[I_W0][d * RWW + hh * 64 + lane]; par[64 + lane] = a0_.in[I_A0][d * RWW + hh * 64 + lane]; par[128 + lane] = a0_.in[I_KK][hh * 64 + lane];
      par[192 + lane] = a0_.in[I_KA][hh * 64 + lane]; par[256 + lane] = a0_.in[I_RK][hh * 64 + lane]; }
#pragma unroll 1
    for (int ci = 0; ci < nch; ++ci) {
        KArgP kl = kap; asm volatile("" : "+s"(kl)); const Args& a = *(const Args*)kl;
        const bf16* px = (const bf16*)a.out; const bf16* w2t = (const bf16*)(a.ws + WS_W2T); const bf16* a2t = (const bf16*)(a.ws + WS_A2T);
        bf16* yd = (bf16*)(a.ws + WS_YD); float* bs = (float*)(a.ws + WS_BS);
        size_t row; const bool isx = (c0 + ci) >= CL / 32;
        { LL(); const int s = 32 * (c0 + ci) + l31; int tok;
        if (!isx) { tok = d ? (CL - 1 - s) : s; row = (size_t)(M + b * CL + tok); }
        else { const int tt = s - CL; tok = d ? (T - 1 - tt) : tt; row = (size_t)(b * T + tok); } }
        const bf16* cur = px + row * LP;
        const bf16* curh; { LL(); curh = cur + 4 * h + hh * 64; }
        v2u kraw[8], rraw[8];
#pragma unroll
        for (int q8 = 0; q8 < 8; ++q8) { kraw[q8] = *(const v2u*)(curh + C_K + 8 * q8); if (MODE == 2) rraw[q8] = *(const v2u*)(curh + C_R + 8 * q8); else rraw[q8] = (v2u){0u, 0u}; }
#define UNPK4(w) ((f32x4){bflo((w).x), bfhi((w).x), bflo((w).y), bfhi((w).y)})
        f32x16 lw[2], la[2]; lw[0] = zero16(); lw[1] = zero16(); la[0] = zero16(); la[1] = zero16();
        { LL();
#pragma unroll
        for (int ks4 = 0; ks4 < 4; ++ks4) {
            const int cw = C_WD + 64 * d + 16 * ks4 + 8 * h, ca = C_AD + 64 * d + 16 * ks4 + 8 * h;
            const v4u wf = *(const v4u*)(cur + cw), af = *(const v4u*)(cur + ca);
            const bf16x8 wdf = __builtin_bit_cast(bf16x8, wf), adf = __builtin_bit_cast(bf16x8, af);
#pragma unroll
            for (int ct = 0; ct < 2; ++ct) { const size_t wo = ((size_t)((((d * 16 + hh) * 2 + ct) * 4 + ks4) * 64 + ln_)) * 8;
                lw[ct] = mfma32(*(const bf16x8*)(w2t + wo), wdf, lw[ct]); la[ct] = mfma32(*(const bf16x8*)(a2t + wo), adf, la[ct]); }
        } }
        float rinv;
        { LL(); float n2 = 0.f;
#pragma unroll
        for (int ct = 0; ct < 2; ++ct)
#pragma unroll
            for (int q = 0; q < 4; ++q) { const int c = hh * 64 + 32 * ct + 8 * q + 4 * h;
                const f32x4 kv = UNPK4(kraw[4 * ct + q]) * *(const LAS f32x4*)(wl + RW_PAR + (2 * 64 + (c - hh * 64)) * 4); n2 += (kv.x * kv.x + kv.y * kv.y) + (kv.z * kv.z + kv.w * kv.w); }
        n2 += __shfl_xor(n2, 32); rinv = 1.f / sqrtf(fmaxf(n2, 1e-24f)); }
        float bonus = 0.f;
#pragma unroll
        for (int ct = 0; ct < 2; ++ct) {
            f32x16 Lc; unsigned apk[8];
            { LL();
#pragma unroll
            for (int q = 0; q < 4; ++q) { const int c = hh * 64 + 32 * ct + 8 * q + 4 * h;
                const f32x4 w0v = *(const LAS f32x4*)(wl + RW_PAR + (0 * 64 + (c - hh * 64)) * 4), a0v = *(const LAS f32x4*)(wl + RW_PAR + (1 * 64 + (c - hh * 64)) * 4);
                float av[4];
#pragma unroll
                for (int i = 0; i < 4; ++i) {
                    Lc[4 * q + i] = scan32(-0.60653065971f * __builtin_amdgcn_rcpf(1.f + __expf(-(w0v[i] + lw[ct][4 * q + i]))), l31); av[i] = __builtin_amdgcn_rcpf(1.f + __expf(-(a0v[i] + la[ct][4 * q + i]))); }
                apk[2 * q] = cvtpk(av[0], av[1]); apk[2 * q + 1] = cvtpk(av[2], av[3]); } }
            { LL(); const int lane = ln_;
#pragma unroll
            for (int q = 0; q < 4; ++q) { const int c = hh * 64 + 32 * ct + 8 * q + 4 * h;
                const f32x4 kkc = *(const LAS f32x4*)(wl + RW_PAR + (2 * 64 + (c - hh * 64)) * 4), kac = *(const LAS f32x4*)(wl + RW_PAR + (3 * 64 + (c - hh * 64)) * 4);
                const f32x4 kv = UNPK4(kraw[4 * ct + q]);
                f32x4 rv = {0.f, 0.f, 0.f, 0.f}, rkc = rv;
                if (MODE == 2) { rv = UNPK4(rraw[4 * ct + q]); rkc = *(const LAS f32x4*)(wl + RW_PAR + (4 * 64 + (c - hh * 64)) * 4); }
                float At[4], Bt[4], Kt[4], Rt[4];
#pragma unroll
                for (int i = 0; i < 4; ++i) { const int ix = 4 * q + i; const float Lci = Lc[ix], ai = (i & 1) ? bfhi(apk[ix >> 1]) : bflo(apk[ix >> 1]);
                    const float eL = __expf(Lci), eLm = __builtin_amdgcn_rcpf(eL); float ePrev = __shfl_up(eL, 1, 32); ePrev = (l31 == 0) ? 1.f : ePrev;
                    const float kk = kv[i] * kkc[i] * rinv, kmod = kv[i] * (1.f + (ai - 1.f) * kac[i]), beta = kk * ai;
                    At[i] = -kk * ePrev; Bt[i] = beta * eLm; Kt[i] = kmod * eLm; Rt[i] = rv[i] * eL;
                    if (MODE == 2) bonus += rv[i] * kmod * rkc[i];
                    if (l31 == 31) *(LAS float*)(wl + RW_GAM + (h * 32 + ct * 16 + ix) * 4) = eL; }
                LAS unsigned char* fp = wl + ((ct * 2 + (q >> 1)) * 64 + lane) * 16 + (q & 1) * 8;
                *(LAS v2u*)(fp + FA * 4096) = (v2u){cvtpk(At[0], At[1]), cvtpk(At[2], At[3])};
                *(LAS v2u*)(fp + FBT * 4096) = (v2u){cvtpk(Bt[0], Bt[1]), cvtpk(Bt[2], Bt[3])};
                if (MODE != 1) *(LAS v2u*)(fp + FKT * 4096) = (v2u){cvtpk(Kt[0], Kt[1]), cvtpk(Kt[2], Kt[3])};
                if (MODE == 2) *(LAS v2u*)(fp + FRT * 4096) = (v2u){cvtpk(Rt[0], Rt[1]), cvtpk(Rt[2], Rt[3])};
            } }
        }
        if (MODE == 2) bonus += __shfl_xor(bonus, 32);
        v2u vraw[8];
#pragma unroll
        for (int q8 = 0; q8 < 8; ++q8) vraw[q8] = (MODE != 1) ? *(const v2u*)(curh + C_V + 8 * q8) : (v2u){0u, 0u};
        bf16x8 pT[2];
        { LL(); const int lane = ln_;
            f32x16 X = zero16(), XT = zero16();
#pragma unroll
            for (int ct = 0; ct < 2; ++ct)
#pragma unroll
                for (int ks = 0; ks < 2; ++ks) { const bf16x8 fa = ldfrag(wl, FA, ct, ks, lane), fb = ldfrag(wl, FBT, ct, ks, lane); X = mfma32(fb, fa, X); XT = mfma32(fa, fb, XT); }
            f32x16 Tm;
#pragma unroll
            for (int r = 0; r < 16; ++r) { const int rw = (r & 3) + 8 * (r >> 2) + 4 * h; X[r] = (rw < l31) ? X[r] : 0.f; XT[r] = (l31 < rw) ? XT[r] : 0.f; Tm[r] = X[r] + ((rw == l31) ? 1.f : 0.f); }
#pragma unroll
            for (int it = 0; it < 4; ++it) {
                f32x16 X2 = zero16(), X2T = zero16();
                const bf16x8 px0 = packt(X, 0), px1 = packt(X, 1), pxt0 = packt(XT, 0), pxt1 = packt(XT, 1);
                X2 = mfma32(pxt0, px0, X2); X2 = mfma32(pxt1, px1, X2); X2T = mfma32(px0, pxt0, X2T); X2T = mfma32(px1, pxt1, X2T);
                const bf16x8 p2t0 = packt(X2T, 0), p2t1 = packt(X2T, 1), pt0 = packt(Tm, 0), pt1 = packt(Tm, 1);
                Tm = mfma32(p2t0, pt0, Tm); Tm = mfma32(p2t1, pt1, Tm);
                X = X2; XT = X2T;
            }
            pT[0] = packt(Tm, 0); pT[1] = packt(Tm, 1);
        }
        bf16x8 pW1T[2][2];
        { LL(); const int lane = ln_; MKIP();
#pragma unroll
        for (int ct = 0; ct < 2; ++ct) { f32x16 at = zero16(); at = mfma32(ldfrag(wl, FA, ct, 0, lane), ip[0], at); at = mfma32(ldfrag(wl, FA, ct, 1, lane), ip[1], at);
            f32x16 w1 = zero16(); w1 = mfma32(pT[0], packt(at, 0), w1); w1 = mfma32(pT[1], packt(at, 1), w1); pW1T[ct][0] = packt(w1, 0); pW1T[ct][1] = packt(w1, 1); } }
        bf16x8 pW2T[2];
        if (MODE != 1) { LL(); const int lane = ln_;
            f32x16 nak = zero16();
#pragma unroll
            for (int ct = 0; ct < 2; ++ct)
#pragma unroll
                for (int ks = 0; ks < 2; ++ks) nak = mfma32(ldfrag(wl, FA, ct, ks, lane), ldfrag(wl, FKT, ct, ks, lane), nak);
#pragma unroll
            for (int r = 0; r < 16; ++r) { const int rw = (r & 3) + 8 * (r >> 2) + 4 * h; nak[r] = (l31 < rw) ? nak[r] : 0.f; }
            f32x16 w2 = zero16(); w2 = mfma32(pT[0], packt(nak, 0), w2); w2 = mfma32(pT[1], packt(nak, 1), w2); pW2T[0] = packt(w2, 0); pW2T[1] = packt(w2, 1);
        }
        if (MODE == 2) { LL(); const int lane = ln_;
            f32x16 nbr = zero16(), nkr = zero16();
#pragma unroll
            for (int ct = 0; ct < 2; ++ct)
#pragma unroll
                for (int ks = 0; ks < 2; ++ks) { const bf16x8 fr = ldfrag(wl, FRT, ct, ks, lane); nbr = mfma32(ldfrag(wl, FBT, ct, ks, lane), fr, nbr); nkr = mfma32(ldfrag(wl, FKT, ct, ks, lane), fr, nkr); }
#pragma unroll
            for (int r = 0; r < 16; ++r) { const int rw = (r & 3) + 8 * (r >> 2) + 4 * h; nbr[r] = (rw <= l31) ? nbr[r] : 0.f; nkr[r] = (rw <= l31) ? nkr[r] : 0.f; }
            const bf16x8 pnb0 = packt(nbr, 0), pnb1 = packt(nbr, 1);
#pragma unroll
            for (int ct = 0; ct < 2; ++ct) { f32x16 g;
#pragma unroll
                for (int ks = 0; ks < 2; ++ks) { const v4u w = __builtin_bit_cast(v4u, ldfrag(wl, FRT, ct, ks, lane));
#pragma unroll
                    for (int i = 0; i < 4; ++i) { g[8 * ks + 2 * i] = bflo(w[i]); g[8 * ks + 2 * i + 1] = bfhi(w[i]); } }
                g = mfma32(pW1T[ct][0], pnb0, g); g = mfma32(pW1T[ct][1], pnb1, g);
                *(LAS bf16x8*)(wl + FRT * 4096 + ((ct * 2 + 0) * 64 + lane) * 16) = packt(g, 0); *(LAS bf16x8*)(wl + FRT * 4096 + ((ct * 2 + 1) * 64 + lane) * 16) = packt(g, 1); }
            nkr = mfma32(pW2T[0], pnb0, nkr); nkr = mfma32(pW2T[1], pnb1, nkr);
            *(LAS bf16x8*)(wl + FA * 4096 + (0 * 64 + lane) * 16) = packt(nkr, 0); *(LAS bf16x8*)(wl + FA * 4096 + (1 * 64 + lane) * 16) = packt(nkr, 1);
        }
        bf16x8 pPp[2][2][2], pQ[2][2], pVT[2][2];
        { LL(); const int lane = ln_; MKIP();
            bf16x8 pBhT[2][2]; float gcol[2];
#pragma unroll
            for (int j2 = 0; j2 < 2; ++j2) gcol[j2] = *(const LAS float*)(wl + RW_GAM + ((((l31 >> 2) & 1) * 32) + j2 * 16 + (l31 & 3) + 4 * (l31 >> 3)) * 4);
#pragma unroll
            for (int j2 = 0; j2 < 2; ++j2) { f32x16 t = zero16(); t = mfma32(ldfrag(wl, FBT, j2, 0, lane), ip[0], t); t = mfma32(ldfrag(wl, FBT, j2, 1, lane), ip[1], t); t = t * gcol[j2]; pBhT[j2][0] = packt(t, 0); pBhT[j2][1] = packt(t, 1); }
#pragma unroll
            for (int jt = 0; jt < 2; ++jt)
#pragma unroll
                for (int j2 = 0; j2 < 2; ++j2) { f32x16 p = zero16(); p = mfma32(pW1T[jt][0], pBhT[j2][0], p); p = mfma32(pW1T[jt][1], pBhT[j2][1], p); pPp[jt][j2][0] = packt(p, 0); pPp[jt][j2][1] = packt(p, 1); }
            if (MODE != 1) {
#pragma unroll
                for (int jt = 0; jt < 2; ++jt) { f32x16 qq = zero16(); qq = mfma32(ldfrag(wl, FKT, jt, 0, lane), ip[0], qq); qq = mfma32(ldfrag(wl, FKT, jt, 1, lane), ip[1], qq); qq = qq * gcol[jt];
                    qq = mfma32(pW2T[0], pBhT[jt][0], qq); qq = mfma32(pW2T[1], pBhT[jt][1], qq); pQ[jt][0] = packt(qq, 0); pQ[jt][1] = packt(qq, 1); }
#pragma unroll
                for (int it = 0; it < 2; ++it) { f32x16 t = zero16();
#pragma unroll
                    for (int ks = 0; ks < 2; ++ks) { const v2u lo = vraw[4 * it + 2 * ks], hi = vraw[4 * it + 2 * ks + 1];
                        t = mfma32(__builtin_bit_cast(bf16x8, (v4u){lo.x, lo.y, hi.x, hi.y}), ip[ks], t); }
                    pVT[it][0] = packt(t, 0); pVT[it][1] = packt(t, 1); }
            }
        }
        bf16x8 pST[2][2][2];
#pragma unroll
        for (int jt = 0; jt < 2; ++jt)
#pragma unroll
            for (int it = 0; it < 2; ++it) { pST[jt][it][0] = packt(ST[jt][it], 0); pST[jt][it][1] = packt(ST[jt][it], 1); }
        LL();
        if (MODE == 2) {
#pragma unroll
            for (int it = 0; it < 2; ++it) { f32x16 y = zero16();
#pragma unroll
                for (int ks = 0; ks < 2; ++ks) y = mfma32(pVT[it][ks], ldfrag(wl, FA, 0, ks, ln_), y);
#pragma unroll
                for (int jt = 0; jt < 2; ++jt)
#pragma unroll
                    for (int ks = 0; ks < 2; ++ks) y = mfma32(pST[jt][it][ks], ldfrag(wl, FRT, jt, ks, ln_), y);
                if (isx) {
                    const int kx = (c0 + ci) - CL / 32, kt = d ? 511 - kx : kx, lanep = d ? ((ln_ & 32) | (31 - l31)) : ln_;
                    v4u* ydf = (v4u*)yd + ((size_t)((((d * 2 + b) * 16 + hh) * 512 + kt) * 4 + it * 2)) * 64 + lanep;
                    ydf[0] = __builtin_bit_cast(v4u, packt(y, 0)); ydf[64] = __builtin_bit_cast(v4u, packt(y, 1)); } }
            if (isx && h == 0) { const int kx = (c0 + ci) - CL / 32, kt = d ? 511 - kx : kx; bs[(size_t)((((d * 2 + b) * 16 + hh) * 512 + kt) * 32) + (d ? 31 - l31 : l31)] = bonus; }
        }
#pragma unroll
        for (int j2 = 0; j2 < 2; ++j2) {
            f32x4 gq[4];
#pragma unroll
            for (int q = 0; q < 4; ++q) gq[q] = *(const LAS f32x4*)(wl + RW_GAM + (h * 32 + j2 * 16 + 4 * q) * 4);
#pragma unroll
            for (int it = 0; it < 2; ++it) { f32x16 acc;
#pragma unroll
                for (int r = 0; r < 16; ++r) acc[r] = gq[r >> 2][r & 3] * ST[j2][it][r];
                if (MODE != 1) { acc = mfma32(pQ[j2][0], pVT[it][0], acc); acc = mfma32(pQ[j2][1], pVT[it][1], acc); }
#pragma unroll
                for (int jt = 0; jt < 2; ++jt)
#pragma unroll
                    for (int ks = 0; ks < 2; ++ks) acc = mfma32(pPp[jt][j2][ks], pST[jt][it][ks], acc);
                ST[j2][it] = acc; }
        }
        if (TRACK) { __builtin_amdgcn_sched_barrier(0);
            bf16x8 pU[2][2][2];
            const v4u* uq = (const v4u*)uscr;
#pragma unroll
            for (int jt = 0; jt < 2; ++jt)
#pragma unroll
                for (int it = 0; it < 2; ++it)
#pragma unroll
                    for (int ks = 0; ks < 2; ++ks) pU[jt][it][ks] = __builtin_bit_cast(bf16x8, uq[((jt * 2 + it) * 2 + ks) * 64 + ln_]);
            if (MODE == 2 && isx) {
#pragma unroll
                for (int i2 = 0; i2 < 2; ++i2) { f32x16 w = zero16();
#pragma unroll
                    for (int jt = 0; jt < 2; ++jt)
#pragma unroll
                        for (int ks = 0; ks < 2; ++ks) w = mfma32(pU[jt][i2][ks], ldfrag(wl, FRT, jt, ks, ln_), w);
                    wscr[((ci * 2 + i2) * 2 + 0) * 64 + ln_] = __builtin_bit_cast(v4u, packt(w, 0)); wscr[((ci * 2 + i2) * 2 + 1) * 64 + ln_] = __builtin_bit_cast(v4u, packt(w, 1)); }
            }
#pragma unroll
            for (int j2 = 0; j2 < 2; ++j2) {
                f32x4 gq[4];
#pragma unroll
                for (int q = 0; q < 4; ++q) gq[q] = *(const LAS f32x4*)(wl + RW_GAM + (h * 32 + j2 * 16 + 4 * q) * 4);
#pragma unroll
                for (int it = 0; it < 2; ++it) { f32x16 acc;
#pragma unroll
                    for (int ks = 0; ks < 2; ++ks) { const v4u w = __builtin_bit_cast(v4u, pU[j2][it][ks]);
#pragma unroll
                        for (int i = 0; i < 4; ++i) { const int r0 = 8 * ks + 2 * i; acc[r0] = gq[r0 >> 2][r0 & 3] * bflo(w[i]); acc[r0 + 1] = gq[(r0 + 1) >> 2][(r0 + 1) & 3] * bfhi(w[i]); } }
#pragma unroll
                    for (int jt = 0; jt < 2; ++jt)
#pragma unroll
                        for (int ks = 0; ks < 2; ++ks) acc = mfma32(pPp[jt][j2][ks], pU[jt][it][ks], acc);
                    v4u* us = (v4u*)uscr;
                    us[((j2 * 2 + it) * 2 + 0) * 64 + ln_] = __builtin_bit_cast(v4u, packt(acc, 0)); us[((j2 * 2 + it) * 2 + 1) * 64 + ln_] = __builtin_bit_cast(v4u, packt(acc, 1)); }
            }
        }
    }
}
#undef LL
#undef MKIP
#undef UNPK4

__device__ __forceinline__ void p4_rwkv_passA(KArgP kap, LAS unsigned char* lds, int lane0, int wave, int bid, int G) {
    const Args& a = *(const Args*)kap;
    LAS unsigned char* wl = lds + wave * RW_WLDS;
    f32x4* uscr = (f32x4*)(a.ws + WS_PX + 160 * MiB) + (size_t)(bid * NWAVES + wave) * 1024;
#pragma unroll 1
    for (int item = bid * 8 + wave; item < 2048; item += G * 8) {
        int lane = lane0; asm volatile("" : "+v"(lane)); const int h = lane >> 5, l31 = lane & 31;
        const int seq = item >> 5, sc = item & 31;
        f32x16 ST[2][2];
        float z = 0.f; asm volatile("" : "+v"(z));
#pragma unroll
        for (int r = 0; r < 16; ++r) { ST[0][0][r] = z; ST[0][1][r] = z; ST[1][0][r] = z; ST[1][1][r] = z; }
#pragma unroll
        for (int jt = 0; jt < 2; ++jt)
#pragma unroll
            for (int it = 0; it < 2; ++it)
#pragma unroll
                for (int ks = 0; ks < 2; ++ks) { f32x16 u;
#pragma unroll
                    for (int r = 0; r < 16; ++r) u[r] = (jt == it && ((r & 3) + 8 * (r >> 2) + 4 * h) == l31) ? 1.f : z;
                    ((v4u*)uscr)[((jt * 2 + it) * 2 + ks) * 64 + lane] = __builtin_bit_cast(v4u, packt(u, ks)); }
        rwkv_run<2, true>(kap, wl, lane, seq, sc, ST, uscr, (v4u*)(a.ws + WS_PX) + (size_t)item * (17 * 256));
        asm volatile("" : "+v"(lane));
        const int h2 = lane >> 5, l31b = lane & 31;
        v4u* hs = (v4u*)(a.ws + WS_HSUP) + (size_t)item * 512;
#pragma unroll
        for (int jt = 0; jt < 2; ++jt)
#pragma unroll
            for (int it = 0; it < 2; ++it)
#pragma unroll
                for (int ks = 0; ks < 2; ++ks) hs[((jt * 2 + it) * 2 + ks) * 64 + lane] = __builtin_bit_cast(v4u, packt(ST[jt][it], ks));
        bf16x8 ip[2];
#pragma unroll
        for (int ks = 0; ks < 2; ++ks) { s16x4 lo, hi;
#pragma unroll
            for (int j = 0; j < 4; ++j) { lo[j] = (16 * ks + 4 * h2 + j == l31b) ? (short)0x3F80 : (short)0; hi[j] = (16 * ks + 8 + 4 * h2 + j == l31b) ? (short)0x3F80 : (short)0; }
            ip[ks] = (bf16x8){lo.x, lo.y, lo.z, lo.w, hi.x, hi.y, hi.z, hi.w}; }
        v4u* ps = (v4u*)(a.ws + WS_PSUP) + (size_t)item * 512;
#pragma unroll
        for (int jt = 0; jt < 2; ++jt)
#pragma unroll
            for (int j2 = 0; j2 < 2; ++j2) {
                const bf16x8 u0 = __builtin_bit_cast(bf16x8, ((const v4u*)uscr)[((j2 * 2 + jt) * 2 + 0) * 64 + lane]), u1 = __builtin_bit_cast(bf16x8, ((const v4u*)uscr)[((j2 * 2 + jt) * 2 + 1) * 64 + lane]);
                f32x16 x = zero16(); x = mfma32(u0, ip[0], x); x = mfma32(u1, ip[1], x);
                ps[((jt * 2 + j2) * 2 + 0) * 64 + lane] = __builtin_bit_cast(v4u, packt(x, 0)); ps[((jt * 2 + j2) * 2 + 1) * 64 + lane] = __builtin_bit_cast(v4u, packt(x, 1)); }
    }
}
__device__ __forceinline__ void p5_rwkv_passC(KArgP kap, LAS unsigned char* lds, int lane0, int wave, int bid, int G) {
    const Args& a = *(const Args*)kap; (void)lds;
#pragma unroll 1
    for (int item = bid * 8 + wave; item < 2048; item += G * 8) {
        int lane = lane0; asm volatile("" : "+v"(lane));
        const int seq = item >> 5, sc = item & 31;
        if (sc == 0) continue;
        f32x16 ST[2][2];
        { float z = 0.f; asm volatile("" : "+v"(z));
#pragma unroll
          for (int r = 0; r < 16; ++r) { ST[0][0][r] = z; ST[0][1][r] = z; ST[1][0][r] = z; ST[1][1][r] = z; } }
        const v4u* hs0 = (const v4u*)(a.ws + WS_HSUP) + (size_t)(seq * 32) * 512 + lane; const v4u* ps0 = (const v4u*)(a.ws + WS_PSUP) + (size_t)(seq * 32) * 512 + lane;
#define PF_LOAD(BP, BH, kk) do { _Pragma("unroll") for (int f = 0; f < 8; ++f) { BP[f] = ps0[(size_t)(kk) * 512 + f * 64]; BH[f] = hs0[(size_t)(kk) * 512 + f * 64]; } } while (0)
#define PF_STEP(BP, BH) do { bf16x8 pST[2][2][2]; \
            _Pragma("unroll") for (int jt = 0; jt < 2; ++jt) _Pragma("unroll") for (int it = 0; it < 2; ++it) { pST[jt][it][0] = packt(ST[jt][it], 0); pST[jt][it][1] = packt(ST[jt][it], 1); } \
            _Pragma("unroll") for (int j2 = 0; j2 < 2; ++j2) _Pragma("unroll") for (int it = 0; it < 2; ++it) { f32x16 acc; \
                _Pragma("unroll") for (int ks = 0; ks < 2; ++ks) { const v4u w = BH[(j2 * 2 + it) * 2 + ks]; _Pragma("unroll") for (int i = 0; i < 4; ++i) { acc[8 * ks + 2 * i] = bflo(w[i]); acc[8 * ks + 2 * i + 1] = bfhi(w[i]); } } \
                _Pragma("unroll") for (int jt = 0; jt < 2; ++jt) _Pragma("unroll") for (int ks = 0; ks < 2; ++ks) acc = mfma32(__builtin_bit_cast(bf16x8, BP[(jt * 2 + j2) * 2 + ks]), pST[jt][it][ks], acc); \
                ST[j2][it] = acc; } } while (0)
        v4u aP[8], aH[8], bP[8], bH[8];
        PF_LOAD(aP, aH, 0);
#pragma unroll 1
        for (int k = 0; k < sc; k += 2) {
            if (k + 1 < sc) PF_LOAD(bP, bH, k + 1);
            PF_STEP(aP, aH);
            if (k + 1 < sc) { if (k + 2 < sc) PF_LOAD(aP, aH, k + 2); PF_STEP(bP, bH); }
        }
#undef PF_LOAD
#undef PF_STEP
        v4u* pst = (v4u*)(a.ws + WS_PSTART) + (size_t)item * 512;
#pragma unroll
        for (int jt = 0; jt < 2; ++jt)
#pragma unroll
            for (int it = 0; it < 2; ++it) { pst[((jt * 2 + it) * 2 + 0) * 64 + lane] = __builtin_bit_cast(v4u, packt(ST[jt][it], 0)); pst[((jt * 2 + it) * 2 + 1) * 64 + lane] = __builtin_bit_cast(v4u, packt(ST[jt][it], 1)); }
    }
}
__device__ __forceinline__ void p5_rwkv_finish(const Args& a, LAS unsigned char* lds, int tid, int lane, int wave, int bid, int G) {
    const bf16* px = (const bf16*)a.out; bf16* mix = (bf16*)(a.ws + WS_MIX); const bf16* yd = (const bf16*)(a.ws + WS_YD); const float* bs = (const float*)(a.ws + WS_BS);
    const bf16* g2t = (const bf16*)(a.ws + WS_G2T); LAS bf16* sgl = (LAS bf16*)lds;
    const int h = lane >> 5, l31 = lane & 31;
    for (int tile = bid; tile < M / 32; tile += G) {
        __syncthreads();
        for (int e = tid; e < 32 * 20; e += NTHR) { const int tk = e / 20, i8 = e % 20; const size_t row = (size_t)tile * 32 + tk;
            const v4u w = *(const v4u*)(px + row * LP + C_GD + 8 * i8); v4u o;
#pragma unroll
            for (int i = 0; i < 4; ++i) o[i] = pk2(__builtin_amdgcn_rcpf(1.f + __expf(-bflo(w[i]))), __builtin_amdgcn_rcpf(1.f + __expf(-bfhi(w[i]))));
            *(LAS v4u*)(sgl + tk * 168 + 8 * i8) = o; }
        __syncthreads();
        const size_t row = (size_t)tile * 32 + l31;
#pragma unroll 1
        for (int hi = 0; hi < 2; ++hi) { const int hh = 2 * wave + hi;
            f32x16 gacc[2];
#pragma unroll
            for (int ct = 0; ct < 2; ++ct)
#pragma unroll
                for (int r = 0; r < 16; ++r) gacc[ct][r] = 0.f;
#pragma unroll 5
            for (int s = 0; s < 10; ++s) { const bf16x8 bfr = *(const LAS bf16x8*)(sgl + l31 * 168 + 16 * s + 8 * h);
#pragma unroll
                for (int ct = 0; ct < 2; ++ct) { const bf16x8 afr = *(const bf16x8*)(g2t + ((size_t)(((hh * 2 + ct) * 10 + s) * 64 + lane)) * 8); gacc[ct] = mfma32(afr, bfr, gacc[ct]); } }
            f32x4 yv[2][4]; float sum = 0.f; v2u vraw[2][4]; f32x4 lwv[2][4], lbv[2][4];
            const int bbt = tile >> 9, ktt = tile & 511; const size_t f0 = (size_t)(((0 * 2 + bbt) * 16 + hh) * 512 + ktt), f1 = (size_t)(((1 * 2 + bbt) * 16 + hh) * 512 + ktt);
            const float bsum = bs[f0 * 32 + l31] + bs[f1 * 32 + l31];
            const v4u* y0p = (const v4u*)yd + f0 * 256 + lane; const v4u* y1p = (const v4u*)yd + f1 * 256 + lane;
#pragma unroll
            for (int ct = 0; ct < 2; ++ct)
#pragma unroll
                for (int qp = 0; qp < 2; ++qp) { const v4u w0 = y0p[(ct * 2 + qp) * 64], w1 = y1p[(ct * 2 + qp) * 64];
                    yv[ct][2 * qp] = (f32x4){bflo(w0.x) + bflo(w1.x), bfhi(w0.x) + bfhi(w1.x), bflo(w0.y) + bflo(w1.y), bfhi(w0.y) + bfhi(w1.y)};
                    yv[ct][2 * qp + 1] = (f32x4){bflo(w0.z) + bflo(w1.z), bfhi(w0.z) + bfhi(w1.z), bflo(w0.w) + bflo(w1.w), bfhi(w0.w) + bfhi(w1.w)}; }
#pragma unroll
            for (int ct = 0; ct < 2; ++ct)
#pragma unroll
                for (int rg = 0; rg < 4; ++rg) { const int c = hh * 64 + 32 * ct + 8 * rg + 4 * h;
                    vraw[ct][rg] = *(const v2u*)(px + row * LP + C_V + c); lwv[ct][rg] = *(const f32x4*)(a.in[I_LNW] + c); lbv[ct][rg] = *(const f32x4*)(a.in[I_LNB] + c); }
#pragma unroll
            for (int dd = 0; dd < 2; ++dd) { const int bb = (int)(row >> 14), kt = (tile & 511), cc = 8 + (dd ? (511 - kt) : kt), sc = cc < 136 ? cc / 17 : 8 + (cc - 136) / 16;
                if (sc == 0) continue;
                const int ci = cc - (sc < 8 ? 17 * sc : 136 + 16 * (sc - 8)), item = ((dd * 2 + bb) * 16 + hh) * 32 + sc;
                const v4u* pst = (const v4u*)(a.ws + WS_PSTART) + (size_t)item * 512; const v4u* wsc = (const v4u*)(a.ws + WS_PX) + (size_t)item * (17 * 256);
                bf16x8 pW[2][2];
#pragma unroll
                for (int i2 = 0; i2 < 2; ++i2)
#pragma unroll
                    for (int ks = 0; ks < 2; ++ks) pW[i2][ks] = __builtin_bit_cast(bf16x8, wsc[((ci * 2 + i2) * 2 + ks) * 64 + lane]);
#pragma unroll
                for (int it = 0; it < 2; ++it) { f32x16 cr = zero16();
#pragma unroll
                    for (int i2 = 0; i2 < 2; ++i2)
#pragma unroll
                        for (int ks = 0; ks < 2; ++ks) cr = mfma32(__builtin_bit_cast(bf16x8, pst[((i2 * 2 + it) * 2 + ks) * 64 + lane]), pW[i2][ks], cr);
#pragma unroll
                    for (int rg = 0; rg < 4; ++rg) { f32x4 cv = {cr[4 * rg], cr[4 * rg + 1], cr[4 * rg + 2], cr[4 * rg + 3]};
                        if (dd) { const int src = (lane & 32) | (31 - l31); cv.x = __shfl(cv.x, src); cv.y = __shfl(cv.y, src); cv.z = __shfl(cv.z, src); cv.w = __shfl(cv.w, src); }
                        yv[it][rg] += cv; } }
            }
#pragma unroll
            for (int ct = 0; ct < 2; ++ct)
#pragma unroll
                for (int rg = 0; rg < 4; ++rg) sum += (yv[ct][rg].x + yv[ct][rg].y) + (yv[ct][rg].z + yv[ct][rg].w);
            sum += __shfl_xor(sum, 32); const float mean = sum * (1.f / 64.f); float vs = 0.f;
#pragma unroll
            for (int ct = 0; ct < 2; ++ct)
#pragma unroll
                for (int rg = 0; rg < 4; ++rg) { const f32x4 dlt = yv[ct][rg] - mean; vs += (dlt.x * dlt.x + dlt.y * dlt.y) + (dlt.z * dlt.z + dlt.w * dlt.w); }
            vs += __shfl_xor(vs, 32); const float rstd = 1.f / sqrtf(vs * (1.f / 64.f) + GN_EPS);
#pragma unroll
            for (int ct = 0; ct < 2; ++ct)
#pragma unroll
                for (int rg = 0; rg < 4; ++rg) { const int c = hh * 64 + 32 * ct + 8 * rg + 4 * h;
                    const f32x4 lw = lwv[ct][rg], lb = lbv[ct][rg];
                    const v2u vw = vraw[ct][rg]; const f32x4 vv = {bflo(vw.x), bfhi(vw.x), bflo(vw.y), bfhi(vw.y)};
                    const f32x4 gg = {gacc[ct][4 * rg], gacc[ct][4 * rg + 1], gacc[ct][4 * rg + 2], gacc[ct][4 * rg + 3]};
                    const f32x4 o = ((yv[ct][rg] - mean) * rstd * lw + lb + vv * bsum) * gg;
                    v2u w; w.x = pk2(o.x, o.y); w.y = pk2(o.z, o.w); *(LAS v2u*)(lds + 16384 + wave * 4608 + l31 * 144 + (32 * ct + 8 * rg + 4 * h) * 2) = w; }
            LDS_WAIT(); asm volatile("" ::: "memory");
#pragma unroll
            for (int j = 0; j < 4; ++j) { const int rr = (lane >> 3) + 8 * j; const v4u x = *(const LAS v4u*)(lds + 16384 + wave * 4608 + rr * 144 + (lane & 7) * 16);
                *(v4u*)(mix + ((size_t)tile * 32 + rr) * D + hh * 64 + (lane & 7) * 8) = x; }
            LDS_WAIT(); asm volatile("" ::: "memory");
        }
    }
}

__device__ __forceinline__ float wave_sum_dpp(float v) {
#define DPP_ADD(ctrl, rmask) v += __builtin_bit_cast(float, __builtin_amdgcn_update_dpp(0, __builtin_bit_cast(int, v), ctrl, rmask, 0xF, false))
    DPP_ADD(0xB1, 0xF); DPP_ADD(0x4E, 0xF); DPP_ADD(0x141, 0xF); DPP_ADD(0x140, 0xF); DPP_ADD(0x142, 0xA); DPP_ADD(0x143, 0xC);
#undef DPP_ADD
    return rdlane(v, 63);
}
__device__ __forceinline__ void moe_norm_router(const Args& a, int l, const bf16* xin, LAS unsigned char* lds, int tid, int lane, int wave, int bid, int G) {
    LAS float* rw = (LAS float*)lds;
    __syncthreads();
    for (int i = tid; i < 2048 * 16; i += NTHR) rw[(i & 15) * 2052 + (i >> 4)] = a.in[I_ROUTER][(size_t)l * 32768 + i];
    __syncthreads();
    const int gw = bid * NWAVES + wave, NGW = G * NWAVES; bf16* h1 = (bf16*)(a.ws + WS_H); float* aff = (float*)(a.ws + WS_AFF);
    LAS float* affl = (LAS float*)(lds + 16 * 2052 * 4) + wave * 256;
    f32x4 A[8], B[8];
    for (int ch = gw; ch < M / 16; ch += NGW) {
        const int b = ch / (T / 16);
        load_coef(a.in[I_NFFN] + l * D, modp(a.ws, l, b, 4), modp(a.ws, l, b, 3), lane, A, B);
        v2u raw[4][8];
#pragma unroll
        for (int u = 0; u < 4; ++u) { const v2u* p = (const v2u*)(xin + ((size_t)ch * 16 + u) * D) + lane;
#pragma unroll
            for (int j = 0; j < 8; ++j) raw[u][j] = p[64 * j]; }
#pragma unroll 1
        for (int rr = 0; rr < 16; rr += 2) { const size_t row = (size_t)ch * 16 + rr; f32x4 v0[8], v1[8];
#pragma unroll
            for (int j = 0; j < 8; ++j) { v0[j] = (f32x4){bflo(raw[0][j].x), bfhi(raw[0][j].x), bflo(raw[0][j].y), bfhi(raw[0][j].y)}; v1[j] = (f32x4){bflo(raw[1][j].x), bfhi(raw[1][j].x), bflo(raw[1][j].y), bfhi(raw[1][j].y)};
                raw[0][j] = raw[2][j]; raw[1][j] = raw[3][j]; }
            if (rr + 4 < 16) {
#pragma unroll
                for (int u = 0; u < 2; ++u) { const v2u* p = (const v2u*)(xin + (row + 4 + u) * D) + lane;
#pragma unroll
                    for (int j = 0; j < 8; ++j) raw[2 + u][j] = p[64 * j]; } }
            const float rs0 = row_rstd(v0), rs1 = row_rstd(v1);
#pragma unroll
            for (int j = 0; j < 8; ++j) { v0[j] = v0[j] * rs0 * A[j] + B[j]; v1[j] = v1[j] * rs1 * A[j] + B[j]; }
            store_row_bf16(h1 + row * D, v0, lane); store_row_bf16(h1 + (row + 1) * D, v1, lane);
            float lg0 = -__builtin_inff(), lg1 = lg0;
#pragma unroll 2
            for (int e = 0; e < 16; ++e) { f32x4 q0 = {0.f, 0.f, 0.f, 0.f}, q1 = q0;
#pragma unroll
                for (int j = 0; j < 8; ++j) { const f32x4 w = *(const LAS f32x4*)(rw + e * 2052 + 4 * lane + 256 * j); q0 += v0[j] * w; q1 += v1[j] * w; }
                float p0 = (q0.x + q0.y) + (q0.z + q0.w), p1 = (q1.x + q1.y) + (q1.z + q1.w);
                p0 = wave_sum_dpp(p0); p1 = wave_sum_dpp(p1); lg0 = (lane == e) ? p0 : lg0; lg1 = (lane == e) ? p1 : lg1; }
            float m0 = lg0, m1 = lg1;
#pragma unroll
            for (int o = 1; o < 16; o <<= 1) { m0 = fmaxf(m0, __shfl_xor(m0, o)); m1 = fmaxf(m1, __shfl_xor(m1, o)); }
            const float e0 = (lane < 16) ? __expf(lg0 - m0) : 0.f, e1 = (lane < 16) ? __expf(lg1 - m1) : 0.f; float s0 = e0, s1 = e1;
#pragma unroll
            for (int o = 1; o < 16; o <<= 1) { s0 += __shfl_xor(s0, o); s1 += __shfl_xor(s1, o); }
            if (lane < 16) { affl[lane * 16 + rr] = e0 / s0; affl[lane * 16 + rr + 1] = e1 / s1; } }
        LDS_WAIT(); asm volatile("" ::: "memory");
        { const f32x4 av = *(const LAS f32x4*)(affl + (lane >> 2) * 16 + (lane & 3) * 4);
          *(f32x4*)(aff + ((size_t)(b * 16 + (lane >> 2))) * T + (((size_t)ch * 16) & (T - 1)) + (lane & 3) * 4) = av; }
        LDS_WAIT(); asm volatile("" ::: "memory");
    }
}
__device__ __forceinline__ int block_excl_scan(int v, int& total, LAS int* wtot, int lane, int wave) {
    int inc = v;
#pragma unroll
    for (int o = 1; o < 64; o <<= 1) { const int t = __shfl_up(inc, o); if (lane >= o) inc += t; }
    __syncthreads();
    if (lane == 63) wtot[wave] = inc;
    __syncthreads();
    int off = 0, tot = 0;
#pragma unroll
    for (int w = 0; w < NWAVES; ++w) { const int t = wtot[w]; if (w < wave) off += t; tot += t; }
    total = tot; return off + inc - v;
}
__device__ __forceinline__ void moe_topk(const Args& a, LAS unsigned char* lds, int tid, int lane, int wave, int bid, int G) {
    LAS unsigned* vals = (LAS unsigned*)lds;
    LAS int* hist = (LAS int*)(lds + 69632); LAS int* misc = hist + 4096; LAS int* wtot = misc + 8; LAS int* wtot2 = wtot + 8;
    const float* aff = (const float*)(a.ws + WS_AFF); int* idx = (int*)(a.ws + WS_IDX); float* gate = (float*)(a.ws + WS_GATE); int* slot_of = (int*)(a.ws + WS_SLOT);
    for (int be = bid; be < NB * NE; be += G) {
        __syncthreads();
        for (int i = tid; i < T; i += NTHR) vals[i + (i >> 5)] = __builtin_bit_cast(unsigned, aff[(size_t)be * T + i]) << 2;
        unsigned p0 = 0u, p1 = 0u, p2 = 0u; int kr = CAP;
#pragma unroll 1
        for (int pass = 0; pass < 3; ++pass) {
            const int nb = (pass == 2) ? 256 : 4096;
            for (int i = tid; i < nb; i += NTHR) hist[i] = 0;
            __syncthreads();
            for (int i = tid; i < T; i += NTHR) { const unsigned v = vals[i + (i >> 5)]; unsigned dgt; bool m;
                if (pass == 0) { dgt = v >> 20; m = true; } else if (pass == 1) { dgt = (v >> 8) & 4095u; m = (v >> 20) == p0; } else { dgt = v & 255u; m = (v >> 8) == ((p0 << 12) | p1); }
                if (m) __hip_atomic_fetch_add(&hist[dgt], 1, __ATOMIC_RELAXED, __HIP_MEMORY_SCOPE_WORKGROUP); }
            __syncthreads();
            int c8[8], s = 0; const bool own = 8 * tid < nb;
#pragma unroll
            for (int j = 0; j < 8; ++j) { c8[j] = own ? hist[nb - 1 - (8 * tid + j)] : 0; s += c8[j]; }
            int tot; const int ex = block_excl_scan(s, tot, wtot, lane, wave);
            if (own && ex < kr && kr <= ex + s) { int cum = ex;
#pragma unroll
                for (int j = 0; j < 8; ++j) { if (cum < kr && kr <= cum + c8[j]) { misc[0] = nb - 1 - (8 * tid + j); misc[1] = kr - cum; } cum += c8[j]; } }
            __syncthreads();
            const unsigned dsel = (unsigned)misc[0]; kr = misc[1];
            if (pass == 0) p0 = dsel; else if (pass == 1) p1 = dsel; else p2 = dsel;
            __syncthreads();
        }
        const unsigned thr = (p0 << 20) | (p1 << 8) | p2;
        int cg = 0, ce = 0;
#pragma unroll 8
        for (int i = 0; i < 32; ++i) { const unsigned v = vals[33 * tid + i]; cg += (v > thr); ce += (v == thr); }
        int ngt, neq; const int pg0 = block_excl_scan(cg, ngt, wtot, lane, wave); const int pe0 = block_excl_scan(ce, neq, wtot2, lane, wave);
        int pg = pg0, pe = pe0;
#pragma unroll 8
        for (int i = 0; i < 32; ++i) { const int t = 32 * tid + i; const unsigned v = vals[33 * tid + i]; int slot = -1;
            if (v > thr) slot = pg++; else if (v == thr) { if (pe < kr) slot = ngt + pe; ++pe; }
            slot_of[(size_t)be * T + t] = slot;
            if (slot >= 0) { idx[be * CAP + slot] = t; gate[be * CAP + slot] = __builtin_bit_cast(float, v >> 2); } }
    }
}
__device__ __forceinline__ void moe_gather(const Args& a, int lane, int wave, int bid, int G) {
    const int gw = bid * NWAVES + wave, NGW = G * NWAVES; const bf16* h1 = (const bf16*)(a.ws + WS_H); bf16* xs = (bf16*)(a.ws + WS_PX); const int* idx = (const int*)(a.ws + WS_IDX);
    for (int r = gw; r < NSLOT; r += NGW) { const int b = r >> 15; const int t = idx[r];
        const v4u* src = (const v4u*)(h1 + ((size_t)b * T + t) * D) + lane; v4u* dst = (v4u*)(xs + (size_t)r * D) + lane;
        v4u v0 = src[0], v1 = src[64], v2 = src[128], v3 = src[192]; dst[0] = v0; dst[64] = v1; dst[128] = v2; dst[192] = v3; }
}
template <int MODE>
__device__ __forceinline__ void moe_combine(const Args& a, int l, bf16* xio, int lane, int wave, int bid, int G) {
    const int gw = bid * NWAVES + wave, NGW = G * NWAVES; const bf16* y = (const bf16*)(a.ws + WS_PX); const int* slot_of = (const int*)(a.ws + WS_SLOT); bf16* hx = (bf16*)(a.ws + WS_H);
    f32x4 A[8], B[8], GT[8];
    for (int ch = gw; ch < M / 16; ch += NGW) {
        const int b = ch / (T / 16);
        if (MODE == 0) load_coef(a.in[I_NMIX] + D, modp(a.ws, 1, b, 1), modp(a.ws, 1, b, 0), lane, A, B);
        else {
#pragma unroll
            for (int j = 0; j < 8; ++j) A[j] = *(const f32x4*)(a.in[I_NFIN] + 4 * lane + 256 * j); }
#pragma unroll
        for (int j = 0; j < 8; ++j) GT[j] = *(const f32x4*)(modp(a.ws, l, b, 5) + 4 * lane + 256 * j);
        const int t0 = (int)(((size_t)ch * 16) & (T - 1)); const int* sp = slot_of + ((size_t)(b * 16 + (lane & 15))) * T + t0 + (lane >> 4);
        int slq = sp[0];
#pragma unroll 1
        for (int q = 0; q < 4; ++q) { const int cur = slq; if (q < 3) slq = sp[4 * (q + 1)];
            const unsigned long long bal = __ballot(cur >= 0);
#pragma unroll
            for (int rs = 0; rs < 4; ++rs) { const size_t row = (size_t)ch * 16 + 4 * q + rs;
                unsigned m = (unsigned)(bal >> (16 * rs)) & 0xffffu;
                const v2u* xp = (const v2u*)(xio + row * D) + lane; v2u xr[8];
#pragma unroll
                for (int j = 0; j < 8; ++j) xr[j] = xp[64 * j];
                f32x4 v[8]; bool first = true;
                do { const v2u* yp[4]; float wg[4]; v2u yv[4][8];
#pragma unroll
                    for (int k = 0; k < 4; ++k) { const bool ok = (m != 0u); const int ee = ok ? __builtin_ctz(m) : 0; m = ok ? (m & (m - 1u)) : 0u; const int s = __builtin_amdgcn_readlane(cur, 16 * rs + ee);
                        yp[k] = ok ? ((const v2u*)(y + ((size_t)(b * 16 + ee) * CAP + s) * D) + lane) : xp; wg[k] = ok ? 1.f : 0.f; }
#pragma unroll
                    for (int k = 0; k < 4; ++k)
#pragma unroll
                        for (int j = 0; j < 8; ++j) yv[k][j] = yp[k][64 * j];
                    if (first) {
#pragma unroll
                        for (int j = 0; j < 8; ++j) v[j] = (f32x4){bflo(xr[j].x), bfhi(xr[j].x), bflo(xr[j].y), bfhi(xr[j].y)};
                        first = false; }
#pragma unroll
                    for (int k = 0; k < 4; ++k)
#pragma unroll
                        for (int j = 0; j < 8; ++j) { const v2u w = yv[k][j]; v[j] += (f32x4){bflo(w.x), bfhi(w.x), bflo(w.y), bfhi(w.y)} * (GT[j] * wg[k]); }
                } while (m != 0u);
                const float rstd = row_rstd(v);
                if (MODE == 0) {
                    store_row_bf16(xio + row * D, v, lane);
#pragma unroll
                    for (int j = 0; j < 8; ++j) v[j] = v[j] * rstd * A[j] + B[j];
                    store_row_bf16(hx + row * D, v, lane);
                } else { f32x4* xr2 = (f32x4*)(a.out + row * D) + lane;
#pragma unroll
                    for (int j = 0; j < 8; ++j) xr2[64 * j] = v[j] * rstd * A[j];
                } } }
    }
}
template <int HALF, int RPT>
__device__ __forceinline__ void pool_rows(const bf16* hx, bf16* pooled, int g, int cg, int row0) {
    constexpr int NR = RPT + 2 * HALF;
    const int t0 = row0 & (T - 1), rowb = row0 - t0;
    v4u x[NR];
#pragma unroll
    for (int j = 0; j < NR; ++j) { const int u = t0 - HALF + j; const bool ok = (u >= 0) && (u < T);
        x[j] = *(const v4u*)(hx + (size_t)(rowb + (ok ? u : t0)) * D + 8 * cg); if (!ok) x[j] = (v4u){0u, 0u, 0u, 0u}; }
    float S[8];
#pragma unroll
    for (int i = 0; i < 8; ++i) S[i] = 0.f;
#pragma unroll
    for (int j = 0; j < 2 * HALF; ++j)
#pragma unroll
        for (int w = 0; w < 4; ++w) { S[2 * w] += bflo(x[j][w]); S[2 * w + 1] += bfhi(x[j][w]); }
#pragma unroll
    for (int r = 0; r < RPT; ++r) { const int t = t0 + r, lo = (t - HALF) > 0 ? (t - HALF) : 0, hi = (t + HALF) < T ? (t + HALF) : T; const float inv = 1.f / (float)(hi - lo);
        const v4u xc = x[r + HALF]; v4u o;
#pragma unroll
        for (int w = 0; w < 4; ++w) o[w] = pk2(S[2 * w] * inv - bflo(xc[w]), S[2 * w + 1] * inv - bfhi(xc[w]));
        *(v4u*)(pooled + ((size_t)g * M + row0 + r) * 512 + (8 * cg - 512 * g)) = o;
        if (r < RPT - 1) {
#pragma unroll
            for (int w = 0; w < 4; ++w) { S[2 * w] += bflo(x[r + 2 * HALF][w]) - bflo(x[r][w]); S[2 * w + 1] += bfhi(x[r + 2 * HALF][w]) - bfhi(x[r][w]); } }
        __builtin_amdgcn_sched_barrier(0); }
}
__device__ __forceinline__ void pool_phase(const Args& a, int tid, int bid, int G) {
    const bf16* hx = (const bf16*)(a.ws + WS_H); bf16* pooled = (bf16*)(a.ws + WS_MIX);
    const int cg = tid & 255, rsel = __builtin_amdgcn_readfirstlane(tid >> 8), g = __builtin_amdgcn_readfirstlane(cg >> 6);
    for (int chunk = bid; chunk < M / 32; chunk += G) { const int row0 = chunk * 32 + rsel * 16;
        if (g == 0) pool_rows<1, 16>(hx, pooled, 0, cg, row0); else if (g == 1) pool_rows<2, 16>(hx, pooled, 1, cg, row0); else if (g == 2) pool_rows<4, 16>(hx, pooled, 2, cg, row0);
        else { pool_rows<8, 8>(hx, pooled, 3, cg, row0); pool_rows<8, 8>(hx, pooled, 3, cg, row0 + 8); } }
}


constexpr int N_PHASES = 22;
template <int LO, int HI>
__global__ void __launch_bounds__(NTHR, 2) mega_fwd(Args args) {
    extern __shared__ __attribute__((aligned(16))) unsigned char lds_raw[];
    LAS unsigned char* lds = (LAS unsigned char*)lds_raw;
    const int tid = threadIdx.x, lane = tid & 63, wave = __builtin_amdgcn_readfirstlane(tid >> 6), bid = blockIdx.x, G = gridDim.x;
    unsigned char* ws = args.ws;
    for (int u = tid; u < (LDS_BYTES - LDSCTL_OFF) / 4; u += NTHR) ((LAS unsigned*)(lds + LDSCTL_OFF))[u] = 0u;
    __syncthreads();
    XcdBarrier bar = xcd_barrier_post((unsigned*)(ws + WS_CTL) + CW_BAR, (volatile LAS unsigned*)(lds + MISC_OFF) + 8);
#ifndef PH_EN
#define PH_EN 0xffffffffu
#endif
#define IN(k) (((PH_EN >> ((k) > 15 ? (k) - 8 : (k))) & 1u) && LO <= (k) && (k) < HI)
#define REP(k) ((REP_MASK >> (k)) & 1u)
#define SEAM(k) do { if (IN(k) && IN((k) + 1)) xcd_barrier(bar); } while (0)
    const KArgP kap0 = (KArgP)__builtin_amdgcn_kernarg_segment_ptr();
#define PH_BEGIN KArgP kap_ = kap0; asm volatile("; PHASE_BEGIN line %1" : "+s"(kap_) : "n"(__LINE__)); const Args& A_ = *(const Args*)kap_; int tid_ = tid; asm volatile("" : "+v"(tid_)); \
    const int lane_ = tid_ & 63, wave_ = __builtin_amdgcn_readfirstlane(tid_ >> 6); unsigned char* const ws_ = A_.ws; (void)lane_; (void)wave_; (void)ws_;

    if (IN(0)) { PH_BEGIN p0_prologue(A_, lds, tid_, lane_, wave_, bid, G); } if (REP(0) && IN(0)) { xcd_barrier(bar); { PH_BEGIN p0_prologue(A_, lds, tid_, lane_, wave_, bid, G); } } SEAM(0);
    if (IN(1)) { PH_BEGIN p1_norm0(A_, lane_, wave_, bid, G); } if (REP(1) && IN(1)) { xcd_barrier(bar); { PH_BEGIN p1_norm0(A_, lane_, wave_, bid, G); } } SEAM(1);
    if (IN(2)) { _Pragma("unroll") for (int rep_ = 0; rep_ < (REP(2) ? 2 : 1); ++rep_) { if (rep_) xcd_barrier(bar);
        PH_BEGIN
        pg8::Gemm g{(const bf16*)(ws_ + WS_H), (const bf16*)(ws_ + WS_WIN), MT, NPAD, D}; pg8::StaticOrder S; S.init(MT, NPAD, G, bid);
        pg8::EpiStoreBf16 E{(bf16*)(ws_ + WS_PX), NPAD};
        pg8::gemm_phase<pg8::EpiStoreBf16, pg8::StaticOrder, true, true>(lds, g, S, E, tid_);
        { PH_BEGIN const int tb = conv_tail_blocks(G); if (tb && bid >= tb) { asm volatile("s_waitcnt vmcnt(0)" ::: "memory"); __syncthreads(); conv_experts(A_, 0, lds, lane_, wave_, bid - tb, G - tb, 0, conv_tail_items(G)); conv_experts(A_, 1, lds, lane_, wave_, bid - tb, G - tb, 0, conv_tail_items(G)); } }
    } } SEAM(2);
    if (IN(3)) { PH_BEGIN if ((bid >> 3) & 1) lerp_phase(A_, tid_, bid, G); p3_attention(A_, lds, tid_, lane_, wave_, bid, G); if (!((bid >> 3) & 1)) lerp_phase(A_, tid_, bid, G); }        if (REP(3) && IN(3)) { xcd_barrier(bar); { PH_BEGIN p3_attention(A_, lds, tid_, lane_, wave_, bid, G); lerp_phase(A_, tid_, bid, G); } } SEAM(3);
    if (IN(4)) { PH_BEGIN p4_rwkv_passA(kap_, lds, lane_, wave_, bid, G); } if (REP(4) && IN(4)) { xcd_barrier(bar); { PH_BEGIN p4_rwkv_passA(kap_, lds, lane_, wave_, bid, G); } } SEAM(4);
    if (IN(5)) { PH_BEGIN p5_rwkv_passC(kap_, lds, lane_, wave_, bid, G); } if (REP(5) && IN(5)) { xcd_barrier(bar); { PH_BEGIN p5_rwkv_passC(kap_, lds, lane_, wave_, bid, G); } } SEAM(5);
    if (IN(6)) { PH_BEGIN p5_rwkv_finish(A_, lds, tid_, lane_, wave_, bid, G); } if (REP(6) && IN(6)) { xcd_barrier(bar); { PH_BEGIN p5_rwkv_finish(A_, lds, tid_, lane_, wave_, bid, G); } } SEAM(6);
    if (IN(7)) { _Pragma("unroll") for (int rep_ = 0; rep_ < (REP(7) ? 2 : 1); ++rep_) { if (rep_) xcd_barrier(bar);
        PH_BEGIN
        pg8::Gemm g{(const bf16*)(ws_ + WS_MIX), (const bf16*)(ws_ + WS_WOUT), M, D, D}; pg8::StaticOrder S; S.init(M, D, G, bid);
        pg8::EpiResBf16<true> E{A_.in[I_X], (bf16*)(ws_ + WS_YD), D, modp(ws_, 0, 0, 2), modp(ws_, 0, 1, 2), nullptr, T, 0x7fffffff};
        pg8::gemm_phase<pg8::EpiResBf16<true>, pg8::StaticOrder, true, true>(lds, g, S, E, tid_);
    } } SEAM(7);
#define LAYER_PHASES(l) do { \
        const int pb = 8 + 8 * l; \
        if (IN(pb + 0)) { PH_BEGIN moe_norm_router(A_, l, (const bf16*)(ws_ + WS_YD), lds, tid_, lane_, wave_, bid, G); } if (REP(pb + 0) && IN(pb + 0)) { xcd_barrier(bar); { PH_BEGIN moe_norm_router(A_, l, (const bf16*)(ws_ + WS_YD), lds, tid_, lane_, wave_, bid, G); } } SEAM(pb + 0); \
        if (IN(pb + 1)) { PH_BEGIN if (G > 32 && bid >= 32) conv_experts(A_, l, lds, lane_, wave_, bid - 32, G - 32, conv_tail_items(G), CONV_NIT); else { moe_topk(A_, lds, tid_, lane_, wave_, bid, G); if (G <= 32) conv_experts(A_, l, lds, lane_, wave_, bid, G, conv_tail_items(G), CONV_NIT); } } if (REP(pb + 1) && IN(pb + 1)) { xcd_barrier(bar); { PH_BEGIN if (G > 32 && bid >= 32) conv_experts(A_, l, lds, lane_, wave_, bid - 32, G - 32, conv_tail_items(G), CONV_NIT); else { moe_topk(A_, lds, tid_, lane_, wave_, bid, G); if (G <= 32) conv_experts(A_, l, lds, lane_, wave_, bid, G, conv_tail_items(G), CONV_NIT); } } } SEAM(pb + 1); \
        if (IN(pb + 3)) { _Pragma("unroll") for (int rep_ = 0; rep_ < (REP(pb + 3) ? 2 : 1); ++rep_) { if (rep_) xcd_barrier(bar); \
            PH_BEGIN \
            pg8::Gemm g{(const bf16*)(ws_ + WS_H), (const bf16*)(ws_ + WS_WGU) + (size_t)l * 16 * 2048 * 2048, NSLOT, 2048, D, (const int*)(ws_ + WS_IDX), 15, T}; pg8::ExpertOrder S{G, bid}; \
            pg8::EpiSwiglu E{(bf16*)(ws_ + WS_MIX), FF}; \
            pg8::gemm_phase<pg8::EpiSwiglu, pg8::ExpertOrder, true, true, true>(lds, g, S, E, tid_); \
        } } SEAM(pb + 3); \
        if (IN(pb + 4)) { _Pragma("unroll") for (int rep_ = 0; rep_ < (REP(pb + 4) ? 2 : 1); ++rep_) { if (rep_) xcd_barrier(bar); \
            PH_BEGIN \
            pg8::Gemm g{(const bf16*)(ws_ + WS_MIX), (const bf16*)(ws_ + WS_WD) + (size_t)l * 16 * 2048 * 1024, NSLOT, 2048, FF}; pg8::ExpertOrder S{G, bid}; \
            pg8::EpiRowScaleBf16 E{(bf16*)(ws_ + WS_PX), D, (const float*)(ws_ + WS_GATE)}; \
            pg8::gemm_phase<pg8::EpiRowScaleBf16, pg8::ExpertOrder, true, true>(lds, g, S, E, tid_); \
        } } SEAM(pb + 4); \
        if (l == 0) { \
            if (IN(pb + 5)) { PH_BEGIN moe_combine<0>(A_, 0, (bf16*)(ws_ + WS_YD), lane_, wave_, bid, G); } if (REP(pb + 5) && IN(pb + 5)) { xcd_barrier(bar); { PH_BEGIN moe_combine<0>(A_, 0, (bf16*)(ws_ + WS_YD), lane_, wave_, bid, G); } } SEAM(pb + 5); \
            if (IN(pb + 6)) { PH_BEGIN pool_phase(A_, tid_, bid, G); } if (REP(pb + 6) && IN(pb + 6)) { xcd_barrier(bar); { PH_BEGIN pool_phase(A_, tid_, bid, G); } } SEAM(pb + 6); \
            if (IN(pb + 7)) { _Pragma("unroll") for (int rep_ = 0; rep_ < (REP(pb + 7) ? 2 : 1); ++rep_) { if (rep_) xcd_barrier(bar); \
                PH_BEGIN \
                pg8::Gemm g{(const bf16*)(ws_ + WS_MIX), (const bf16*)(ws_ + WS_WPOOL), 4 * M, 512, 512}; pg8::PoolOrder S{G, bid}; \
                pg8::EpiResBf16<false> E{(const bf16*)(ws_ + WS_YD), (bf16*)(ws_ + WS_YD), D, modp(ws_, 1, 0, 2), modp(ws_, 1, 1, 2), A_.in[I_POOLS], T, 127}; \
                pg8::gemm_phase<pg8::EpiResBf16<false>, pg8::PoolOrder, true, true>(lds, g, S, E, tid_); \
            } } SEAM(pb + 7); \
        } else { \
            if (IN(pb + 5)) { PH_BEGIN moe_combine<1>(A_, 1, (bf16*)(ws_ + WS_YD), lane_, wave_, bid, G); } if (REP(pb + 5) && IN(pb + 5)) { xcd_barrier(bar); { PH_BEGIN moe_combine<1>(A_, 1, (bf16*)(ws_ + WS_YD), lane_, wave_, bid, G); } } \
        } \
    } while (0)
    LAYER_PHASES(0);
    LAYER_PHASES(1);
#undef LAYER_PHASES
#undef IN
#undef SEAM
#undef PH_BEGIN
}

template <int LO, int HI> static void launch_range(const Args& a, int grid, hipStream_t stream) {
    static bool attr = false;
    if (!attr) { (void)hipFuncSetAttribute((const void*)mega_fwd<LO, HI>, hipFuncAttributeMaxDynamicSharedMemorySize, LDS_BYTES); attr = true; }
    hipLaunchKernelGGL((mega_fwd<LO, HI>), dim3(grid), dim3(NTHR), LDS_BYTES, stream, a);
}
#if MK_SPLIT
template <int K> struct SplitLaunch { static void run(const Args& a, int grid, hipStream_t s) { SplitLaunch<K - 1>::run(a, grid, s); launch_range<K, K + 1>(a, grid, s); } };
template <> struct SplitLaunch<-1> { static void run(const Args&, int, hipStream_t) {} };
#endif
extern "C" void kernel_launch(void* const* d_in, const int* in_sizes, int n_in, void* d_out, int out_size, void* d_ws, size_t ws_size, hipStream_t stream) {
    static int grid = 0;
    if (grid == 0) {
        if (n_in != N_IN || out_size != M * D || ws_size < WS_END) { fprintf(stderr, "kernel_launch: unexpected shapes (n_in %d out %d ws %zu, need %zu)\n", n_in, out_size, ws_size, (size_t)WS_END); grid = -1; return; }
        int dev = 0, cus = 0;
        if (hipGetDevice(&dev) != hipSuccess || hipDeviceGetAttribute(&cus, hipDeviceAttributeMultiprocessorCount, dev) != hipSuccess) { grid = -1; return; }
        grid = cus;
    }
    if (grid < 0) return;
    (void)in_sizes;
    (void)hipMemsetAsync((char*)d_ws + WS_CTL, 0, CTL_ZERO_BYTES, stream);
    Args a{};
    for (int i = 0; i < N_IN; ++i) a.in[i] = (const float*)d_in[i];
    a.out = (float*)d_out; a.ws = (unsigned char*)d_ws; a.ph_lo = 0; a.ph_hi = N_PHASES;
#if MK_SPLIT
    SplitLaunch<N_PHASES - 1>::run(a, grid, stream);
#else
    launch_range<0, N_PHASES>(a, grid, stream);
#endif
    const hipError_t le = hipPeekAtLastError();
    if (le != hipSuccess) fprintf(stderr, "kernel_launch: launch failed: %s\n", hipGetErrorName(le));
}
```

```cpp
#include <hip/hip_runtime.h>
#include <cstdio>
#include <cstdint>

#ifndef MK_SPLIT
#define MK_SPLIT 0
#endif

#ifndef REP_MASK
#define REP_MASK 0u
#endif
namespace pg8 {
#define PG8_LAS __attribute__((address_space(3)))
typedef unsigned short bf16_t;
typedef short bf16x8 __attribute__((ext_vector_type(8)));
typedef float f32x4 __attribute__((ext_vector_type(4)));
typedef unsigned u32x4 __attribute__((ext_vector_type(4)));
constexpr int BM = 256, BK = 64, HALF = 128, HTB = HALF * BK * 2  , STAGE_BYTES = 8 * HTB, NXCD = 8, WGM = 8;

__host__ __device__ __forceinline__ int lds_byte(int r, int c) { const int st = (r >> 4) * 2 + (c >> 5), rr = r & 15, cc = c & 31, ob = rr * 64 + cc * 2; return st * 1024 + (ob ^ (((ob >> 9) & 1) << 5)); }
__host__ __device__ __forceinline__ void stage_rc(int b, int& R, int& C) { const int st = b / 1024, sb = b % 1024, swz = sb ^ (((sb >> 9) & 1) << 5); R = (st >> 1) * 16 + swz / 64; C = (st & 1) * 32 + (swz % 64) / 2; }
__host__ __device__ __forceinline__ int perm32(int rho) { const int n = rho >> 4, i = rho & 15; return 8 * (i >> 2) + 4 * n + (i & 3); }

struct Unit { int pm, pn; };
struct Gemm { const bf16_t* A; const bf16_t* Bt; int M, N, K; const int* rowmap; int rm_shift, rm_rows; };

struct StaticOrder {
    int nM, nN, nwg, G, c;
    __host__ __device__ void init(int M, int N, int G_, int c_) { nM = M / BM; nN = N / BM; nwg = nM * nN; G = G_; c = c_; }
    __host__ __device__ bool next(int i, Unit& u) const {
        const long L = (long)i * G + c; if (L >= nwg) return false;
        int wgid = (int)L; { const int q = nwg / NXCD, r = nwg % NXCD, xcd = wgid % NXCD, off = wgid / NXCD; wgid = (xcd < r ? xcd * (q + 1) : r * (q + 1) + (xcd - r) * q) + off; }
        const int nig = WGM * nN, gid = wgid / nig, fm = gid * WGM, gsz = (nM - fm) < WGM ? (nM - fm) : WGM;
        u.pm = fm + ((wgid % nig) % gsz); u.pn = (wgid % nig) / gsz; return true;
    }
    __device__ __forceinline__ void a_ready(const Unit&) const {}
    __device__ __forceinline__ void done(const Unit&) const {}
};

__device__ __forceinline__ unsigned cvt_pk_bf16(float lo, float hi) { unsigned r; asm volatile("v_cvt_pk_bf16_f32 %0, %1, %2" : "=v"(r) : "v"(lo), "v"(hi)); return r; }
typedef float f32x2 __attribute__((ext_vector_type(2)));

struct EpiStoreBf16 {
    static constexpr bool PERM = true, AFTER_DRAIN = false;
    bf16_t* O; int ldc;
    __device__ __forceinline__ void operator()(const f32x4 (&acc)[2][2][4][2], const Unit& u, int wr, int wc, int fr, int fq) const {
        const int row0 = u.pm * BM + wr * 64 + fr, col0 = u.pn * BM + wc * 32 + 8 * fq;
#pragma unroll
        for (int ai = 0; ai < 2; ++ai)
#pragma unroll
            for (int m = 0; m < 4; ++m) { bf16_t* rowp = O + (size_t)(row0 + ai * HALF + m * 16) * ldc + col0;
#pragma unroll
                for (int bj = 0; bj < 2; ++bj) { const f32x4 v0 = acc[ai][bj][m][0], v1 = acc[ai][bj][m][1];
                    u32x4 w; w.x = cvt_pk_bf16(v0[0], v0[1]); w.y = cvt_pk_bf16(v0[2], v0[3]); w.z = cvt_pk_bf16(v1[0], v1[1]); w.w = cvt_pk_bf16(v1[2], v1[3]);
                    *(u32x4*)(rowp + bj * HALF) = w; } }
    }
};
struct EpiResF32 {
    static constexpr bool PERM = false, AFTER_DRAIN = false;
    const float* res; float* out; int ldc; const float* gate0; const float* gate1; const float* scale; int rows_per_b; int pm_mask;
    __device__ __forceinline__ void operator()(const f32x4 (&acc)[2][2][4][2], const Unit& u, int wr, int wc, int fr, int fq) const {
        const int row0 = (u.pm & pm_mask) * BM + wr * 64 + fr, col0 = u.pn * BM + wc * 32 + 4 * fq;
        const float* gp = (row0 >= rows_per_b) ? gate1 : gate0;
        f32x4 gv[2][2];
#pragma unroll
        for (int bj = 0; bj < 2; ++bj)
#pragma unroll
            for (int n = 0; n < 2; ++n) { gv[bj][n] = *(const f32x4*)(gp + col0 + bj * HALF + 16 * n); if (scale) gv[bj][n] = gv[bj][n] * *(const f32x4*)(scale + col0 + bj * HALF + 16 * n); }
#pragma unroll
        for (int ai = 0; ai < 2; ++ai)
#pragma unroll
            for (int m = 0; m < 4; ++m) { const size_t ro = (size_t)(row0 + ai * HALF + m * 16) * ldc + col0;
#pragma unroll
                for (int bj = 0; bj < 2; ++bj)
#pragma unroll
                    for (int n = 0; n < 2; ++n) { const size_t o = ro + bj * HALF + 16 * n; const f32x4 r = *(const f32x4*)(res + o);
                        *(f32x4*)(out + o) = r + gv[bj][n] * acc[ai][bj][m][n]; } }
    }
};
template <bool RES_F32>
struct EpiResBf16 {
    static constexpr bool PERM = true, AFTER_DRAIN = false;
    const void* res; bf16_t* out; int ldc; const float* gate0; const float* gate1; const float* scale; int rows_per_b; int pm_mask;
    __device__ __forceinline__ void operator()(const f32x4 (&acc)[2][2][4][2], const Unit& u, int wr, int wc, int fr, int fq) const {
        const int row0 = (u.pm & pm_mask) * BM + wr * 64 + fr, col0 = u.pn * BM + wc * 32 + 8 * fq;
        const float* gp = (row0 >= rows_per_b) ? gate1 : gate0;
        f32x4 gv[2][2];
#pragma unroll
        for (int bj = 0; bj < 2; ++bj)
#pragma unroll
            for (int n = 0; n < 2; ++n) { gv[bj][n] = *(const f32x4*)(gp + col0 + bj * HALF + 4 * n); if (scale) gv[bj][n] = gv[bj][n] * *(const f32x4*)(scale + col0 + bj * HALF + 4 * n); }
#pragma unroll
        for (int ai = 0; ai < 2; ++ai) {
            f32x4 rf[4][2][2]; u32x4 rb[4][2];
#pragma unroll
            for (int m = 0; m < 4; ++m)
#pragma unroll
                for (int bj = 0; bj < 2; ++bj) { const size_t o = (size_t)(row0 + ai * HALF + m * 16) * ldc + col0 + bj * HALF;
                    if (RES_F32) { rf[m][bj][0] = *(const f32x4*)((const float*)res + o); rf[m][bj][1] = *(const f32x4*)((const float*)res + o + 4); }
                    else rb[m][bj] = *(const u32x4*)((const bf16_t*)res + o); }
#pragma unroll
            for (int m = 0; m < 4; ++m)
#pragma unroll
                for (int bj = 0; bj < 2; ++bj) { const size_t o = (size_t)(row0 + ai * HALF + m * 16) * ldc + col0 + bj * HALF; f32x4 r0, r1;
                    if (RES_F32) { r0 = rf[m][bj][0]; r1 = rf[m][bj][1]; }
                    else { const u32x4 w = rb[m][bj];
                        r0 = (f32x4){__builtin_bit_cast(float, w.x << 16), __builtin_bit_cast(float, w.x & 0xffff0000u), __builtin_bit_cast(float, w.y << 16), __builtin_bit_cast(float, w.y & 0xffff0000u)};
                        r1 = (f32x4){__builtin_bit_cast(float, w.z << 16), __builtin_bit_cast(float, w.z & 0xffff0000u), __builtin_bit_cast(float, w.w << 16), __builtin_bit_cast(float, w.w & 0xffff0000u)}; }
                    const f32x4 v0 = r0 + gv[bj][0] * acc[ai][bj][m][0], v1 = r1 + gv[bj][1] * acc[ai][bj][m][1];
                    u32x4 w; w.x = cvt_pk_bf16(v0[0], v0[1]); w.y = cvt_pk_bf16(v0[2], v0[3]); w.z = cvt_pk_bf16(v1[0], v1[1]); w.w = cvt_pk_bf16(v1[2], v1[3]);
                    *(u32x4*)(out + o) = w; } }
    }
};
struct EpiSwiglu {
    static constexpr bool PERM = true, AFTER_DRAIN = false;
    bf16_t* O; int ldc;
    __device__ __forceinline__ void operator()(const f32x4 (&acc)[2][2][4][2], const Unit& u, int wr, int wc, int fr, int fq) const {
        const int row0 = u.pm * BM + wr * 64 + fr, col0 = (u.pn & 7) * 128 + wc * 32 + 8 * fq;
#pragma unroll
        for (int ai = 0; ai < 2; ++ai)
#pragma unroll
            for (int m = 0; m < 4; ++m) { bf16_t* rowp = O + (size_t)(row0 + ai * HALF + m * 16) * ldc + col0; float h[8];
#pragma unroll
                for (int n = 0; n < 2; ++n) { const f32x4 g = acc[ai][0][m][n], up = acc[ai][1][m][n];
#pragma unroll
                    for (int i = 0; i < 4; ++i) h[4 * n + i] = g[i] * __builtin_amdgcn_rcpf(1.f + __expf(-g[i])) * up[i]; }
                u32x4 w; w.x = cvt_pk_bf16(h[0], h[1]); w.y = cvt_pk_bf16(h[2], h[3]); w.z = cvt_pk_bf16(h[4], h[5]); w.w = cvt_pk_bf16(h[6], h[7]);
                *(u32x4*)rowp = w; }
    }
};
struct EpiRowScaleBf16 {
    static constexpr bool PERM = true, AFTER_DRAIN = false;
    bf16_t* O; int ldc; const float* rs;
    __device__ __forceinline__ void operator()(const f32x4 (&acc)[2][2][4][2], const Unit& u, int wr, int wc, int fr, int fq) const {
        const int row0 = u.pm * BM + wr * 64 + fr, col0 = (u.pn & 7) * BM + wc * 32 + 8 * fq;
        float sc[2][4];
#pragma unroll
        for (int ai = 0; ai < 2; ++ai)
#pragma unroll
            for (int m = 0; m < 4; ++m) sc[ai][m] = rs[row0 + ai * HALF + m * 16];
#pragma unroll
        for (int ai = 0; ai < 2; ++ai)
#pragma unroll
            for (int m = 0; m < 4; ++m) { const int row = row0 + ai * HALF + m * 16; const float s = sc[ai][m]; bf16_t* rowp = O + (size_t)row * ldc + col0;
#pragma unroll
                for (int bj = 0; bj < 2; ++bj) { const f32x4 v0 = acc[ai][bj][m][0] * s, v1 = acc[ai][bj][m][1] * s;
                    u32x4 w; w.x = cvt_pk_bf16(v0[0], v0[1]); w.y = cvt_pk_bf16(v0[2], v0[3]); w.z = cvt_pk_bf16(v1[0], v1[1]); w.w = cvt_pk_bf16(v1[2], v1[3]);
                    *(u32x4*)(rowp + bj * HALF) = w; } }
    }
};
struct ExpertOrder {
    int G, c;
    __device__ __forceinline__ bool next(int i, Unit& u) const {
        const long L = (long)i * G + c; if (L >= 2048) return false;
        const int r256 = (int)(L >> 8), w = (int)(L & 255), x = w & 7, j = w >> 3, grp = 4 * r256 + (x >> 1), e = grp >> 1, b = grp & 1;
        u.pm = (b * 16 + e) * 8 + 4 * (x & 1) + (j & 3); u.pn = e * 8 + (j >> 2); return true;
    }
    __device__ __forceinline__ void a_ready(const Unit&) const {}
    __device__ __forceinline__ void done(const Unit&) const {}
};
struct PoolOrder {
    int G, c;
    __device__ __forceinline__ bool next(int i, Unit& u) const {
        const long L = (long)i * G + c; if (L >= 1024) return false;
        const int g = (int)(L >> 8), w = (int)(L & 255);
        u.pm = g * 128 + (w & 127); u.pn = g * 2 + (w >> 7); return true;
    }
    __device__ __forceinline__ void a_ready(const Unit&) const {}
    __device__ __forceinline__ void done(const Unit&) const {}
};

template <class Epi, class Sched, bool ALIGN_EPI = false, bool SP2 = false, bool GATHER = false>
__device__ __forceinline__ void gemm_phase(PG8_LAS unsigned char* lds, const Gemm g, const Sched& S, const Epi& E, const int tid) {
    const int wid = __builtin_amdgcn_readfirstlane(tid >> 6), lane = tid & 63, wr = wid >> 2, wc = wid & 3, fr = lane & 15, fq = lane >> 4;
    const int K = g.K, nt = K / BK;
    unsigned voffA[2], voffB[2];
    int RA[2], CA[2];
#pragma unroll
    for (int i = 0; i < 2; ++i) { int R, C; stage_rc(tid * 16 + i * 8192, R, C); const int Rb = Epi::PERM ? ((R & ~31) + perm32(R & 31)) : R;
        voffA[i] = (unsigned)(R * K + C) * 2u; voffB[i] = (unsigned)(Rb * K + C) * 2u; RA[i] = R; CA[i] = C; }
    static_assert(!GATHER || SP2, "GATHER is written for the SP2 loop");
    unsigned vc[2][2] = {{0u, 0u}, {0u, 0u}}, vn[2][2] = {{0u, 0u}, {0u, 0u}};
#define PG8_GOFF(dst, u) do { _Pragma("unroll") for (int h_ = 0; h_ < 2; ++h_) _Pragma("unroll") for (int i_ = 0; i_ < 2; ++i_) { const int r_ = (u).pm * BM + h_ * HALF + RA[i_]; \
        dst[h_][i_] = (unsigned)(((r_ >> g.rm_shift) * g.rm_rows + g.rowmap[r_]) * K + CA[i_]) * 2u; } } while (0)
    const size_t kstep = (size_t)(BK * 2);
    const size_t hstep = (size_t)HALF * K * 2;
    const size_t tstep = 2 * hstep;
    const size_t hstepA = GATHER ? (size_t)0 : hstep, tstepA = GATHER ? (size_t)0 : tstep;
    const unsigned ldsw = (unsigned)wid * 1024u;
    const int aoff = lds_byte(wr * 64 + fr, fq * 8), boff = lds_byte(wc * 32 + fr, fq * 8);
#define PG8_SA(b, h) (((b) * 2 + (h)) * HTB)
#define PG8_SB(b, h) ((4 + (b) * 2 + (h)) * HTB)
#define PG8_STAGE(bufoff, gbase, voff) do { _Pragma("unroll") for (int _i = 0; _i < 2; ++_i) \
        __builtin_amdgcn_global_load_lds((const unsigned*)((const char*)(gbase) + (voff)[_i]), (PG8_LAS unsigned*)(lds + (bufoff) + ldsw + _i * 8192), 16, 0, 0); } while (0)
#define PG8_STAGE_A(bufoff, gbase, half, nx) do { if constexpr (GATHER) { const unsigned vv_[2] = {(nx) ? vn[half][0] : vc[half][0], (nx) ? vn[half][1] : vc[half][1]}; PG8_STAGE(bufoff, gbase, vv_); } else { PG8_STAGE(bufoff, gbase, voffA); } } while (0)
#define PG8_LDA(dst, b, h) do { _Pragma("unroll") for (int m = 0; m < 4; ++m) _Pragma("unroll") for (int k = 0; k < 2; ++k) dst[m][k] = *(const PG8_LAS bf16x8*)(lds + PG8_SA(b, h) + aoff + m * 2048 + k * 1024); } while (0)
#define PG8_LDB(dst, b, h) do { _Pragma("unroll") for (int n = 0; n < 2; ++n) _Pragma("unroll") for (int k = 0; k < 2; ++k) dst[n][k] = *(const PG8_LAS bf16x8*)(lds + PG8_SB(b, h) + boff + n * 2048 + k * 1024); } while (0)
#define PG8_MMA(ai, bj, At, Bt) do { __builtin_amdgcn_s_setprio(1); _Pragma("unroll") for (int m = 0; m < 4; ++m) _Pragma("unroll") for (int n = 0; n < 2; ++n) _Pragma("unroll") for (int k = 0; k < 2; ++k) \
        acc[ai][bj][m][n] = __builtin_amdgcn_mfma_f32_16x16x32_bf16(Bt[n][k], At[m][k], acc[ai][bj][m][n], 0, 0, 0); __builtin_amdgcn_s_setprio(0); } while (0)
#define PG8_WAIT_V(n) asm volatile("s_waitcnt vmcnt(" #n ")" ::: "memory")
#define PG8_WAIT_L(n) asm volatile("s_waitcnt lgkmcnt(" #n ")" ::: "memory")
#define PG8_BAR __builtin_amdgcn_s_barrier()
#define PG8_SCHED __builtin_amdgcn_sched_barrier(0)
    Unit cur, nxt; int ui = 0;
    if (!S.next(0, cur)) return;
    f32x4 acc[2][2][4][2];
#pragma unroll
    for (int a = 0; a < 2; ++a)
#pragma unroll
        for (int b = 0; b < 2; ++b)
#pragma unroll
            for (int m = 0; m < 4; ++m)
#pragma unroll
                for (int n = 0; n < 2; ++n) acc[a][b][m][n] = (f32x4){0.f, 0.f, 0.f, 0.f};
    bf16x8 At[4][2], B0[2][2], B1[2][2];
    const char* cA = (const char*)g.A + (size_t)cur.pm * tstepA; const char* cB = (const char*)g.Bt + (size_t)cur.pn * tstep;
    if constexpr (GATHER) PG8_GOFF(vc, cur);
    S.a_ready(cur);
    if constexpr (SP2) {
        PG8_STAGE(PG8_SB(0, 0), cB, voffB); PG8_STAGE(PG8_SB(0, 1), cB + hstep, voffB); PG8_STAGE_A(PG8_SA(0, 0), cA, 0, false); PG8_STAGE_A(PG8_SA(0, 1), cA + hstepA, 1, false);
        if (wr == 1) PG8_BAR;
        PG8_WAIT_V(2); PG8_BAR;
        PG8_STAGE(PG8_SB(1, 0), cB + kstep, voffB); PG8_STAGE_A(PG8_SA(1, 0), cA + kstep, 0, false); PG8_STAGE(PG8_SB(1, 1), cB + hstep + kstep, voffB);
        PG8_WAIT_V(6); PG8_BAR;
    } else {
        PG8_STAGE(PG8_SB(0, 0), cB, voffB); PG8_STAGE(PG8_SA(0, 0), cA, voffA); PG8_STAGE(PG8_SB(0, 1), cB + hstep, voffB); PG8_STAGE(PG8_SA(0, 1), cA + hstep, voffA);
        if (wr == 1) PG8_BAR;
        PG8_WAIT_V(4); PG8_BAR;
        PG8_STAGE(PG8_SB(1, 0), cB + kstep, voffB); PG8_STAGE(PG8_SA(1, 0), cA + kstep, voffA); PG8_STAGE(PG8_SB(1, 1), cB + hstep + kstep, voffB);
        PG8_WAIT_V(6); PG8_BAR;
    }
    for (;;) {
        const bool has_next = S.next(ui + 1, nxt);
        const char* nA = has_next ? (const char*)g.A + (size_t)nxt.pm * tstepA : cA;
        if constexpr (GATHER) { if (has_next) PG8_GOFF(vn, nxt); else { vn[0][0] = vc[0][0]; vn[0][1] = vc[0][1]; vn[1][0] = vc[1][0]; vn[1][1] = vc[1][1]; } } const char* nB = has_next ? (const char*)g.Bt + (size_t)nxt.pn * tstep : cB;
        for (int t = 0; t < nt; t += 2) {
            const bool last = (t == nt - 2);
            const char* a1 = cA + (size_t)(t + 1) * kstep;
            const char* a2 = last ? nA : cA + (size_t)(t + 2) * kstep; const char* b2 = last ? nB : cB + (size_t)(t + 2) * kstep;
            const char* a3 = a2 + kstep; const char* b3 = b2 + kstep;
            if (last && has_next) S.a_ready(nxt);
            if constexpr (SP2) {
            PG8_LDB(B0, 0, 0); PG8_LDB(B1, 0, 1); PG8_SCHED; PG8_LDA(At, 0, 0); PG8_STAGE_A(PG8_SA(1, 1), a1 + hstepA, 1, false);
            PG8_WAIT_V(8); PG8_WAIT_L(0); PG8_BAR; PG8_MMA(0, 0, At, B0); PG8_MMA(0, 1, At, B1); PG8_BAR; PG8_SCHED;
            PG8_LDA(At, 0, 1); PG8_STAGE(PG8_SB(0, 0), b2, voffB); PG8_STAGE(PG8_SB(0, 1), b2 + hstep, voffB); PG8_STAGE_A(PG8_SA(0, 0), a2, 0, last);
            PG8_WAIT_V(8); PG8_WAIT_L(0); PG8_BAR; PG8_MMA(1, 0, At, B0); PG8_MMA(1, 1, At, B1); PG8_BAR; PG8_SCHED;
            PG8_LDB(B0, 1, 0); PG8_LDB(B1, 1, 1); PG8_SCHED; PG8_LDA(At, 1, 0); PG8_STAGE_A(PG8_SA(0, 1), a2 + hstepA, 1, last);
            PG8_WAIT_V(8); PG8_WAIT_L(0); PG8_BAR; PG8_MMA(0, 0, At, B0); PG8_MMA(0, 1, At, B1); PG8_BAR; PG8_SCHED;
            PG8_LDA(At, 1, 1); PG8_STAGE(PG8_SB(1, 0), b3, voffB); PG8_STAGE(PG8_SB(1, 1), b3 + hstep, voffB); PG8_STAGE_A(PG8_SA(1, 0), a3, 0, last);
            PG8_WAIT_V(8); PG8_WAIT_L(0); PG8_BAR; PG8_MMA(1, 0, At, B0); PG8_MMA(1, 1, At, B1); PG8_BAR; PG8_SCHED;
            } else {
            PG8_LDB(B0, 0, 0); PG8_SCHED; PG8_LDA(At, 0, 0); PG8_STAGE(PG8_SA(1, 1), a1 + hstep, voffA);
            PG8_WAIT_L(8); PG8_BAR; PG8_WAIT_L(0); PG8_MMA(0, 0, At, B0); PG8_BAR; PG8_SCHED;
            PG8_LDB(B1, 0, 1); PG8_STAGE(PG8_SB(0, 0), b2, voffB);
            PG8_BAR; PG8_WAIT_L(0); PG8_MMA(0, 1, At, B1); PG8_BAR;
            PG8_LDA(At, 0, 1); PG8_STAGE(PG8_SA(0, 0), a2, voffA);
            PG8_BAR; PG8_WAIT_L(0); PG8_MMA(1, 0, At, B0); PG8_BAR; PG8_SCHED;
            PG8_STAGE(PG8_SB(0, 1), b2 + hstep, voffB);
            PG8_WAIT_V(6); PG8_BAR; PG8_MMA(1, 1, At, B1); PG8_BAR;
            PG8_LDB(B0, 1, 0); PG8_SCHED; PG8_LDA(At, 1, 0); PG8_STAGE(PG8_SA(0, 1), a2 + hstep, voffA);
            PG8_WAIT_L(8); PG8_BAR; PG8_WAIT_L(0); PG8_MMA(0, 0, At, B0); PG8_BAR; PG8_SCHED;
            PG8_LDB(B1, 1, 1); PG8_STAGE(PG8_SB(1, 0), b3, voffB);
            PG8_BAR; PG8_WAIT_L(0); PG8_MMA(0, 1, At, B1); PG8_BAR;
            PG8_LDA(At, 1, 1); PG8_STAGE(PG8_SA(1, 0), a3, voffA);
            PG8_BAR; PG8_WAIT_L(0); PG8_MMA(1, 0, At, B0); PG8_BAR; PG8_SCHED;
            PG8_STAGE(PG8_SB(1, 1), b3 + hstep, voffB);
            PG8_WAIT_V(6); PG8_BAR; PG8_MMA(1, 1, At, B1); PG8_BAR;
            }
        }
        if constexpr (ALIGN_EPI) { if (wr == 0) PG8_BAR; }
        if constexpr (!Epi::AFTER_DRAIN) { E(acc, cur, wr, wc, fr, fq); S.done(cur); }
        if (!has_next) break;
#pragma unroll
        for (int a = 0; a < 2; ++a)
#pragma unroll
            for (int b = 0; b < 2; ++b)
#pragma unroll
                for (int m = 0; m < 4; ++m)
#pragma unroll
                    for (int n = 0; n < 2; ++n) acc[a][b][m][n] = (f32x4){0.f, 0.f, 0.f, 0.f};
        cur = nxt; cA = nA; cB = nB; ++ui;
        if constexpr (GATHER) { vc[0][0] = vn[0][0]; vc[0][1] = vn[0][1]; vc[1][0] = vn[1][0]; vc[1][1] = vn[1][1]; }
        if constexpr (ALIGN_EPI) { if (wr == 1) PG8_BAR; }
    }
    PG8_WAIT_V(0);
    if constexpr (!ALIGN_EPI) { if (wr == 0) PG8_BAR; }
    PG8_BAR;
    if constexpr (Epi::AFTER_DRAIN) { E.fused(acc, cur, wr, wc, fr, fq, lds, wid, lane); S.done(cur); }
#undef PG8_SA
#undef PG8_SB
#undef PG8_STAGE
#undef PG8_STAGE_A
#undef PG8_GOFF
#undef PG8_LDA
#undef PG8_LDB
#undef PG8_MMA
#undef PG8_WAIT_V
#undef PG8_WAIT_L
#undef PG8_BAR
#undef PG8_SCHED
}
}

constexpr int D = 2048, NB = 2, T = 16384, M = NB * T, CL = 256, MC = NB * CL, MT = M + MC;
constexpr int NH = 16, HD = 64, RWW = 1024;
constexpr int NPAD = 5120;
constexpr int C_R = 0, C_K = 1024, C_V = 2048, C_WD = 3072, C_AD = 3200, C_GD = 3328, C_Q = 3488, C_AK = 4512, C_AV = 4768, IN_COLS = 5024;
constexpr int NE = 16, CAP = 2048, FF = 1024, NSLOT = NB * NE * CAP;
constexpr float NORM_EPS = 1e-6f, GN_EPS = 64e-5f;
constexpr int NWAVES = 8, NTHR = 512;

constexpr size_t MiB = 1u << 20;
constexpr size_t WS_CTL = 0, CTL_ZERO_BYTES = 64 * 1024;
constexpr size_t WS_MOD = 1 * MiB;
constexpr size_t WS_ROPE = 1 * MiB + 512 * 1024;
constexpr size_t WS_G2T = 11 * MiB;
constexpr size_t WS_W2T = 11 * MiB + 384 * 1024, WS_A2T = 11 * MiB + 640 * 1024;
constexpr size_t WS_AFF = 2 * MiB;
constexpr size_t WS_IDX = 4 * MiB, WS_GATE = 4 * MiB + 512 * 1024;
constexpr size_t WS_SLOT = 5 * MiB;
constexpr size_t WS_BS = 7 * MiB;
constexpr size_t WS_WIN = 12 * MiB;
constexpr size_t WS_WOUT = 32 * MiB;
constexpr size_t WS_WPOOL = 40 * MiB;
constexpr size_t WS_WGU = 42 * MiB;
constexpr size_t WS_WD = 298 * MiB;
constexpr size_t WS_H = 426 * MiB;
constexpr size_t WS_PX = 556 * MiB;
constexpr size_t WS_MIX = 881 * MiB;
constexpr size_t WS_YD = 1009 * MiB;
constexpr size_t WS_END = 1265 * MiB;
static_assert(WS_WIN + (size_t)NPAD * D * 2 <= WS_WOUT && WS_WGU + (size_t)2 * 16 * 2048 * 2048 * 2 <= WS_WD && WS_WD + (size_t)2 * 16 * 2048 * 1024 * 2 <= WS_H, "ws map 1");
static_assert(WS_H + (size_t)MT * D * 2 <= WS_PX && WS_PX + (size_t)MT * NPAD * 2 <= WS_MIX && WS_MIX + (size_t)M * D * 2 <= WS_YD && WS_YD + (size_t)2 * M * RWW * 4 <= WS_END, "ws map 2");
constexpr int CW_BAR = 4096;

constexpr int RING_BYTES = 131072, LDSCTL_OFF = 147456, MISC_OFF = LDSCTL_OFF + 320, LDS_BYTES = 147456 + 512;

#define GAS __attribute__((address_space(1)))
#define LAS __attribute__((address_space(3)))
typedef unsigned short bf16;
typedef unsigned v4u __attribute__((ext_vector_type(4)));
typedef unsigned v2u __attribute__((ext_vector_type(2)));
typedef float f32x4 __attribute__((ext_vector_type(4)));
typedef float f32x2 __attribute__((ext_vector_type(2)));
typedef float f32x16 __attribute__((ext_vector_type(16)));
typedef short bf16x8 __attribute__((ext_vector_type(8)));
typedef short s16x4 __attribute__((ext_vector_type(4)));
#define LDS_WAIT() asm volatile("s_waitcnt lgkmcnt(0)" ::: "memory")

__device__ __forceinline__ unsigned f2bf(float f) { unsigned u = __builtin_bit_cast(unsigned, f); return (u + 0x7fffu + ((u >> 16) & 1u)) >> 16; }
typedef __bf16 bf16x2_t __attribute__((ext_vector_type(2)));
__device__ __forceinline__ unsigned pk2(float lo, float hi) { const f32x2 v = {lo, hi}; return __builtin_bit_cast(unsigned, __builtin_convertvector(v, bf16x2_t)); }
__device__ __forceinline__ float bf2f(unsigned short u) { return __builtin_bit_cast(float, (unsigned)u << 16); }
__device__ __forceinline__ float bflo(unsigned w) { return __builtin_bit_cast(float, w << 16); }
__device__ __forceinline__ float bfhi(unsigned w) { return __builtin_bit_cast(float, w & 0xffff0000u); }
__device__ __forceinline__ float wave_sum(float v) {
#pragma unroll
    for (int o = 1; o < 64; o <<= 1) v += __shfl_xor(v, o);
    return v;
}
__device__ __forceinline__ float rdlane(float v, int l) { return __builtin_bit_cast(float, __builtin_amdgcn_readlane(__builtin_bit_cast(int, v), l)); }

#define XB_TMO      128
#define XB_XCNT(j)  (256  + 64 * (j))
#define XB_XSUB(j)  (1280 + 64 * (j))
#define XB_XGEN(j)  (2304 + 64 * (j))
#define XB_TOP      3328
#define XB_TOPGEN   3392
#define XCD_BAR_WORDS 3456
#define XB_SPIN_CAP (1u << 23)

__device__ __forceinline__ unsigned xb_ld(unsigned* p)              { return __hip_atomic_load(p, __ATOMIC_RELAXED, __HIP_MEMORY_SCOPE_AGENT); }
__device__ __forceinline__ unsigned xb_add(unsigned* p, unsigned v) { return __hip_atomic_fetch_add(p, v, __ATOMIC_RELAXED, __HIP_MEMORY_SCOPE_AGENT); }
__device__ __forceinline__ unsigned xb_xcc_id() { return (unsigned)__builtin_amdgcn_s_getreg((3 << 11) | 20) & 0xFu; }
#define XB_SPIN(cond, bar) do { unsigned _sp = 0; while (cond) { __builtin_amdgcn_s_sleep(1); \
    if ((++_sp & 255u) == 0u) { if (xb_ld(&(bar)[XB_TMO])) break; if (_sp > XB_SPIN_CAP) { atomicAdd(&(bar)[XB_TMO], 1u); break; } } } } while (0)

struct XcdBarrier {
    unsigned* bar; unsigned x;
    volatile LAS unsigned* st;
};

__device__ __forceinline__ XcdBarrier xcd_barrier_post(unsigned* bar, volatile LAS unsigned* st) {
    XcdBarrier b; b.bar = bar; b.x = xb_xcc_id(); b.st = st;
    if (threadIdx.x == 0) (void)xb_add(&bar[XB_XCNT(b.x)], 1u);
    return b;
}
__device__ __forceinline__ void xcd_barrier_complete(unsigned* bar, unsigned x, unsigned& nloc, unsigned& nx) {
    const unsigned G = gridDim.x * gridDim.y * gridDim.z;
    unsigned sum, cnt, mine, sp = 0u;
    for (;;) {
        sum = 0u; cnt = 0u; mine = 0u;
#pragma unroll
        for (unsigned j = 0; j < 16; ++j) { const unsigned c = xb_ld(&bar[XB_XCNT(j)]); sum += c; cnt += (c > 0u) ? 1u : 0u; mine = (j == x) ? c : mine; }
        if (sum == G) break;
        __builtin_amdgcn_s_sleep(1);
        if ((++sp & 255u) == 0u) { if (xb_ld(&bar[XB_TMO])) break; if (sp > XB_SPIN_CAP) { atomicAdd(&bar[XB_TMO], 1u); break; } }
    }
    nloc = mine > 0u ? mine : 1u; nx = cnt > 0u ? cnt : 1u;
}

__device__ __forceinline__ void xcd_barrier(const XcdBarrier& b) {
    asm volatile("s_waitcnt vmcnt(0)" ::: "memory");
    __syncthreads();
    if (threadIdx.x == 0) {
        unsigned* bar = b.bar;
        __builtin_amdgcn_s_waitcnt(0);
        unsigned nloc = b.st[0], nx = b.st[1];
        if (nloc == 0u) { xcd_barrier_complete(bar, b.x, nloc, nx); b.st[0] = nloc; b.st[1] = nx; }
        const unsigned old = xb_add(&bar[XB_XSUB(b.x)], 1u);
        const unsigned gen = old / nloc;
        if (old + 1u == (gen + 1u) * nloc) {
            __builtin_amdgcn_fence(__ATOMIC_RELEASE, "agent");
            asm volatile("s_waitcnt vmcnt(0)" ::: "memory");
            const unsigned og = xb_add(&bar[XB_TOP], 1u);
            const unsigned tg = og / nx;
            if (og + 1u == (tg + 1u) * nx) xb_add(&bar[XB_TOPGEN], 1u);
            else XB_SPIN(xb_ld(&bar[XB_TOPGEN]) == tg, bar);
            __builtin_amdgcn_fence(__ATOMIC_ACQUIRE, "agent");
            xb_add(&bar[XB_XGEN(b.x)], 1u);
            asm volatile("s_waitcnt vmcnt(0)" ::: "memory");
        } else {
            XB_SPIN(xb_ld(&bar[XB_XGEN(b.x)]) == gen, bar);
            __builtin_amdgcn_fence(__ATOMIC_ACQUIRE, "agent");
            asm volatile("s_waitcnt vmcnt(0)" ::: "memory");
        }
    }
    __syncthreads();
}

enum { I_X = 0, I_C, I_CTX, I_CCTX, I_ADAW, I_ADAB, I_NMIX, I_NFFN, I_WIN, I_MU, I_W0, I_W2, I_A0, I_A2, I_G2, I_KK, I_KA, I_RK, I_LNW, I_LNB, I_SINK, I_WOUT, I_POOLW, I_POOLS, I_ROUTER, I_EG, I_EU, I_ED, I_NFIN, N_IN };
struct Args { const float* in[N_IN]; float* out; unsigned char* ws; int ph_lo, ph_hi; };
static_assert(sizeof(Args) == N_IN * 8 + 24, "Args has no padding");
typedef __attribute__((address_space(4))) const Args* KArgP;

__device__ __forceinline__ f32x4 ld4bf(const bf16* p) { const v2u w = *(const v2u*)p; return (f32x4){bflo(w.x), bfhi(w.x), bflo(w.y), bfhi(w.y)}; }
__device__ __forceinline__ const float* modp(const unsigned char* ws, int l, int r, int chunk) { return (const float*)(ws + WS_MOD) + (size_t)((l * 3 + r) * 6 + chunk) * D; }

template <int MODE>
__device__ __forceinline__ void tr_item(const float* W, int ldw, int k0, int n0, bf16* WT, int ldt, int lane, LAS float* scr) {
    const int row8 = lane >> 3, c4 = lane & 7;
    f32x4 v[8];
#pragma unroll
    for (int i = 0; i < 8; ++i) v[i] = *(const f32x4*)(W + (size_t)(k0 + 8 * i + row8) * ldw + n0 + 4 * c4);
#pragma unroll
    for (int i = 0; i < 8; ++i) { LAS float* w = scr + (8 * i + row8) * 33 + 4 * c4; w[0] = v[i].x; w[1] = v[i].y; w[2] = v[i].z; w[3] = v[i].w; }
    LDS_WAIT(); asm volatile("" ::: "memory");
    const int c = lane & 7;
#pragma unroll
    for (int j = 0; j < 4; ++j) { const int n = (lane >> 3) + 8 * j; const LAS float* s = scr + (8 * c) * 33 + n;
        v4u o; o.x = pk2(s[0 * 33], s[1 * 33]); o.y = pk2(s[2 * 33], s[3 * 33]); o.z = pk2(s[4 * 33], s[5 * 33]); o.w = pk2(s[6 * 33], s[7 * 33]);
        const int ns = n0 + n; const int drow = (MODE == 0) ? ns : (256 * (ns >> 7) + (ns & 127) + (MODE == 2 ? 128 : 0));
        *(v4u*)(WT + (size_t)drow * ldt + k0 + 8 * c) = o; }
    LDS_WAIT(); asm volatile("" ::: "memory");
}

__device__ __forceinline__ void p0_prologue(const Args& a, LAS unsigned char* lds, int tid, int lane, int wave, int bid, int G) {
    unsigned char* ws = a.ws;
    {
        LAS float* sv = (LAS float*)lds;
        LAS float* red = (LAS float*)(lds + 3 * 2048 * 4);
        for (int i = tid; i < 3 * 2048; i += NTHR) { const int r = i >> 11, k = i & 2047; const float v = (r < 2) ? a.in[I_C][r * 2048 + k] : a.in[I_CCTX][k]; sv[i] = v / (1.f + __expf(-v)); }
        __syncthreads();
        for (int slab = bid; slab < 256; slab += G) {
            const int l = slab >> 7, col0 = (slab & 127) * 96;
            const int cg = tid % 24, kg = tid / 24;
            if (kg < 16) {
                f32x4 acc0 = {0.f, 0.f, 0.f, 0.f}, acc1 = acc0, acc2 = acc0;
                const float* wp = a.in[I_ADAW] + ((size_t)l * 2048 + kg * 128) * 12288 + col0 + 4 * cg;
#pragma unroll 16
                for (int k = 0; k < 128; ++k) { const f32x4 w = __builtin_nontemporal_load((const f32x4*)(wp + (size_t)k * 12288)); const int kk = kg * 128 + k;
                    acc0 += w * sv[kk]; acc1 += w * sv[2048 + kk]; acc2 += w * sv[4096 + kk]; }
                *(LAS f32x4*)(red + (kg * 3 + 0) * 96 + 4 * cg) = acc0; *(LAS f32x4*)(red + (kg * 3 + 1) * 96 + 4 * cg) = acc1; *(LAS f32x4*)(red + (kg * 3 + 2) * 96 + 4 * cg) = acc2;
            }
            __syncthreads();
            if (tid < 288) { const int r = tid / 96, ci = tid % 96; float s = a.in[I_ADAB][l * 12288 + col0 + ci];
#pragma unroll
                for (int k = 0; k < 16; ++k) s += red[(k * 3 + r) * 96 + ci];
                ((float*)(ws + WS_MOD))[(size_t)(l * 3 + r) * 12288 + col0 + ci] = s; }
            __syncthreads();
        }
    }
    {
        for (int i = bid * NTHR + tid; i < 320 * 16; i += G * NTHR) { const int pos = (i >> 4) < 256 ? (i >> 4) : (i >> 4) - 256, fi = i & 15;
            const double inv4[4] = {1.0, 0.5623413251903491, 0.31622776601683794, 0.1778279410038923};
            double inv = inv4[fi & 3]; const int q = fi >> 2; inv *= (q == 0 ? 1.0 : q == 1 ? 0.1 : q == 2 ? 0.01 : 0.001);
            const float angf = (float)pos * (float)inv;
            const double rev = (double)angf * 0.15915494309189535; const float fr = (float)(rev - __builtin_rint(rev));
            f32x2 cs; cs.x = __builtin_amdgcn_cosf(fr); cs.y = __builtin_amdgcn_sinf(fr);
            ((f32x2*)(ws + WS_ROPE))[i] = cs; }
    }
    for (int i = bid * NTHR + tid; i < 1024 * 160; i += G * NTHR) { const int k = i >> 10, ch = i & 1023;
        const int frag = ((ch >> 6) * 2 + ((ch >> 5) & 1)) * 10 + (k >> 4); ((bf16*)(ws + WS_G2T))[(frag * 64 + ((k >> 3) & 1) * 32 + (ch & 31)) * 8 + (k & 7)] = (bf16)f2bf(a.in[I_G2][i]); }
    for (int i = bid * NTHR + tid; i < 2 * 1024 * 64; i += G * NTHR) { const int dd = i >> 16, k = (i >> 10) & 63, c = i & 1023;
        const int frag = ((dd * 16 + (c >> 6)) * 2 + ((c >> 5) & 1)) * 4 + (k >> 4), o = (frag * 64 + ((k >> 3) & 1) * 32 + (c & 31)) * 8 + (k & 7);
        ((bf16*)(ws + WS_W2T))[o] = (bf16)f2bf(a.in[I_W2][(size_t)(dd * 64 + k) * RWW + c]); ((bf16*)(ws + WS_A2T))[o] = (bf16)f2bf(a.in[I_A2][(size_t)(dd * 64 + k) * RWW + c]); }
    { v4u* z = (v4u*)(ws + WS_WIN + (size_t)IN_COLS * D * 2); const int n16 = (NPAD - IN_COLS) * D * 2 / 16; for (int i = bid * NTHR + tid; i < n16; i += G * NTHR) z[i] = (v4u){0u, 0u, 0u, 0u}; }
    {
        LAS float* scr = (LAS float*)(lds + wave * 16384);
        const int gw = bid * NWAVES + wave, NGW = G * NWAVES;
        constexpr int I_IN = 32 * 157, I_OUT = 32 * 64, I_POOL = 4 * 128;
        constexpr int NITEMS = I_IN + I_OUT + I_POOL;
        for (int it = gw; it < NITEMS; it += NGW) {
            int r = it;
            if (r < I_IN) { tr_item<0>(a.in[I_WIN], IN_COLS, 64 * (r / 157), 32 * (r % 157), (bf16*)(ws + WS_WIN), D, lane, scr); continue; } r -= I_IN;
            if (r < I_OUT) { tr_item<0>(a.in[I_WOUT], D, 64 * (r / 64), 32 * (r % 64), (bf16*)(ws + WS_WOUT), D, lane, scr); continue; } r -= I_OUT;
            if (r < I_POOL) { const int g = r >> 7, rr = r & 127; tr_item<0>(a.in[I_POOLW] + (size_t)g * 512 * 512, 512, 64 * (rr / 16), 32 * (rr % 16), (bf16*)(ws + WS_WPOOL) + (size_t)g * 512 * 512, 512, lane, scr); }
        }
    }
}


struct TrDesc { const float* src; bf16* dst; int ldw, k0, n0, ldt, mode; };
__device__ __forceinline__ TrDesc conv_decode(const Args& a, int l, int it) {
    constexpr int I_GU = 16 * 2048; TrDesc d;
    if (it < I_GU) { const int le = l * 16 + (it >> 11), rem = it & 2047, mat = rem >> 10, rr = rem & 1023;
        d.src = (mat ? a.in[I_EU] : a.in[I_EG]) + (size_t)le * 2048 * 1024; d.dst = (bf16*)(a.ws + WS_WGU) + (size_t)le * 2048 * 2048; d.ldw = FF; d.k0 = 64 * (rr >> 5); d.n0 = 32 * (rr & 31); d.ldt = D; d.mode = 1 + mat; }
    else { const int r = it - I_GU, le = l * 16 + (r >> 10), rr = r & 1023;
        d.src = a.in[I_ED] + (size_t)le * 1024 * 2048; d.dst = (bf16*)(a.ws + WS_WD) + (size_t)le * 2048 * 1024; d.ldw = D; d.k0 = 64 * (rr >> 6); d.n0 = 32 * (rr & 63); d.ldt = FF; d.mode = 0; }
    return d;
}
constexpr int CONV_NIT = 16 * 2048 + 16 * 1024;
__device__ __forceinline__ int conv_tail_blocks(int G) { return ((MT / 256) * (NPAD / 256)) % G; }
__device__ __forceinline__ int conv_tail_items(int G) { const int tb = conv_tail_blocks(G); if (tb == 0) return 0; const int n = (G - tb) * NWAVES * 8; return n < CONV_NIT ? n : CONV_NIT; }
__device__ __forceinline__ void conv_experts(const Args& a, int l, LAS unsigned char* lds, int lane, int wave, int vb, int VG, int it_lo, int NIT) {
    LAS float* scr = (LAS float*)(lds + wave * 16384);
    constexpr int NB4 = 4; const int stride = VG * NWAVES, row8 = lane >> 3, c4 = lane & 7, c = lane & 7;
#pragma unroll 1
    for (int it0 = it_lo + vb * NWAVES + wave; it0 < NIT; it0 += NB4 * stride) {
        TrDesc d[NB4]; f32x4 v[NB4][8];
#pragma unroll
        for (int u = 0; u < NB4; ++u) { const int it = it0 + u * stride; d[u] = conv_decode(a, l, it < NIT ? it : it0);
#pragma unroll
            for (int i = 0; i < 8; ++i) v[u][i] = __builtin_nontemporal_load((const f32x4*)(d[u].src + (size_t)(d[u].k0 + 8 * i + row8) * d[u].ldw + d[u].n0 + 4 * c4)); }
#pragma unroll
        for (int u = 0; u < NB4; ++u) { if (it0 + u * stride >= NIT) break;
#pragma unroll
            for (int i = 0; i < 8; ++i) { LAS float* w = scr + (8 * i + row8) * 33 + 4 * c4; w[0] = v[u][i].x; w[1] = v[u][i].y; w[2] = v[u][i].z; w[3] = v[u][i].w; }
            LDS_WAIT(); asm volatile("" ::: "memory");
#pragma unroll
            for (int j = 0; j < 4; ++j) { const int n = (lane >> 3) + 8 * j; const LAS float* s = scr + (8 * c) * 33 + n;
                v4u o; o.x = pk2(s[0 * 33], s[1 * 33]); o.y = pk2(s[2 * 33], s[3 * 33]); o.z = pk2(s[4 * 33], s[5 * 33]); o.w = pk2(s[6 * 33], s[7 * 33]);
                const int ns = d[u].n0 + n; const int drow = (d[u].mode == 0) ? ns : (256 * (ns >> 7) + (ns & 127) + (d[u].mode == 2 ? 128 : 0));
                *(v4u*)(d[u].dst + (size_t)drow * d[u].ldt + d[u].k0 + 8 * c) = o; }
            LDS_WAIT(); asm volatile("" ::: "memory"); }
    }
}

__device__ __forceinline__ void load_coef(const float* g, const float* sc, const float* sh, int lane, f32x4 (&A)[8], f32x4 (&B)[8]) {
#pragma unroll
    for (int j = 0; j < 8; ++j) { const int col = 4 * lane + 256 * j; const f32x4 gv = *(const f32x4*)(g + col), sv = *(const f32x4*)(sc + col); A[j] = gv * (sv + 1.f); B[j] = *(const f32x4*)(sh + col); }
}
__device__ __forceinline__ float row_rstd(const f32x4 (&v)[8]) {
    float s = 0.f;
#pragma unroll
    for (int j = 0; j < 8; ++j) s += (v[j].x * v[j].x + v[j].y * v[j].y) + (v[j].z * v[j].z + v[j].w * v[j].w);
    return 1.f / sqrtf(wave_sum(s) * (1.f / D) + NORM_EPS);
}
__device__ __forceinline__ void load_row_bf16(const bf16* irow, f32x4 (&v)[8], int lane) {
    const v2u* p = (const v2u*)irow + lane;
#pragma unroll
    for (int j = 0; j < 8; ++j) { const v2u w = p[64 * j]; v[j] = (f32x4){bflo(w.x), bfhi(w.x), bflo(w.y), bfhi(w.y)}; }
}
__device__ __forceinline__ void store_row_bf16(bf16* orow, const f32x4 (&o)[8], int lane) {
    unsigned long long* o8 = (unsigned long long*)orow + lane;
#pragma unroll
    for (int j = 0; j < 8; ++j) o8[64 * j] = (unsigned long long)pk2(o[j].x, o[j].y) | ((unsigned long long)pk2(o[j].z, o[j].w) << 32);
}
__device__ __forceinline__ void p1_norm0(const Args& a, int lane, int wave, int bid, int G) {
    const int gw = bid * NWAVES + wave, NGW = G * NWAVES; bf16* h0 = (bf16*)(a.ws + WS_H);
    f32x4 A[8], B[8];
    for (int ch = gw; ch < M / 16; ch += NGW) {
        const int b = ch / (T / 16);
        load_coef(a.in[I_NMIX], modp(a.ws, 0, b, 1), modp(a.ws, 0, b, 0), lane, A, B);
        f32x4 nx[8];
        { const f32x4* xr = (const f32x4*)(a.in[I_X] + (size_t)ch * 16 * D) + lane;
#pragma unroll
          for (int j = 0; j < 8; ++j) nx[j] = xr[64 * j]; }
#pragma unroll 1
        for (int rr = 0; rr < 16; ++rr) { const size_t row = (size_t)ch * 16 + rr; f32x4 v[8];
#pragma unroll
            for (int j = 0; j < 8; ++j) v[j] = nx[j];
            if (rr + 1 < 16) { const f32x4* xr = (const f32x4*)(a.in[I_X] + (row + 1) * D) + lane;
#pragma unroll
                for (int j = 0; j < 8; ++j) nx[j] = xr[64 * j]; }
            const float rstd = row_rstd(v);
#pragma unroll
            for (int j = 0; j < 8; ++j) v[j] = v[j] * rstd * A[j] + B[j];
            store_row_bf16(h0 + row * D, v, lane); }
    }
    if (gw < MC) {
        load_coef(a.in[I_NMIX], modp(a.ws, 0, 2, 1), modp(a.ws, 0, 2, 0), lane, A, B);
        for (int r = gw; r < MC; r += NGW) { f32x4 v[8]; const f32x4* xr = (const f32x4*)(a.in[I_CTX] + (size_t)r * D) + lane;
#pragma unroll
            for (int j = 0; j < 8; ++j) v[j] = xr[64 * j];
            const float rstd = row_rstd(v);
#pragma unroll
            for (int j = 0; j < 8; ++j) v[j] = v[j] * rstd * A[j] + B[j];
            store_row_bf16(h0 + (size_t)(M + r) * D, v, lane); }
    }
}

__device__ __forceinline__ f32x16 mfma32(bf16x8 a, bf16x8 b, f32x16 c) { return __builtin_amdgcn_mfma_f32_32x32x16_bf16(a, b, c, 0, 0, 0); }
__device__ __forceinline__ void rope8(v4u& A_, v4u& B_, const f32x2* tb, float scale) {
#pragma unroll
    for (int w = 0; w < 4; ++w) { const float a0 = bflo(A_[w]), a1 = bfhi(A_[w]), b0 = bflo(B_[w]), b1 = bfhi(B_[w]); const f32x2 c0 = tb[2 * w], c1 = tb[2 * w + 1];
        A_[w] = pk2((a0 * c0.x - b0 * c0.y) * scale, (a1 * c1.x - b1 * c1.y) * scale); B_[w] = pk2((b0 * c0.x + a0 * c0.y) * scale, (b1 * c1.x + a1 * c1.y) * scale); }
}
__device__ __forceinline__ void p3_attention(const Args& a, LAS unsigned char* lds, int tid, int lane, int wave, int bid, int G) {
    constexpr float LOG2E = 1.4426950408889634f, QS = 0.125f * LOG2E;
    constexpr int KT_BYTES = 32 * 144, VT_PITCH = 192, VT_BYTES = 32 * VT_PITCH, ATT_BUF = 4 * KT_BYTES + 4 * VT_BYTES;
    const bf16* px = (const bf16*)(a.ws + WS_PX); bf16* mix = (bf16*)(a.ws + WS_MIX);
    const f32x2* tabR = (const f32x2*)(a.ws + WS_ROPE); const f32x2* tabC = tabR + 256 * 16;
    LAS unsigned char* Kl = lds; LAS unsigned char* Vl = lds + 4 * KT_BYTES;
    const int h = lane >> 5, l31 = lane & 31;
    for (int unit = bid; unit < 1024; unit += G) {
        const int b = unit >> 9, kvh = (unit >> 7) & 3, qb = unit & 127;
        const int qhead = kvh * 4 + (wave >> 1), q0w = qb * 128 + 64 * (wave & 1);
        bf16x8 qf[2][4];
#pragma unroll
        for (int qt = 0; qt < 2; ++qt) {
            const int qpos = q0w + 32 * qt + l31;
            const bf16* qp = px + (size_t)(b * T + qpos) * NPAD + C_Q + qhead * 64 + 8 * h;
            v4u raw[4];
#pragma unroll
            for (int s = 0; s < 4; ++s) raw[s] = *(const v4u*)(qp + 16 * s);
            rope8(raw[0], raw[1], tabR + (qpos >> 6) * 16 + 8 * h, QS);
            rope8(raw[2], raw[3], tabC + (qpos & 63) * 16 + 8 * h, QS);
#pragma unroll
            for (int s = 0; s < 4; ++s) qf[qt][s] = __builtin_bit_cast(bf16x8, raw[s]);
        }
        float mrun[2], lrun[2]; f32x16 O[2][2];
#pragma unroll
        for (int qt = 0; qt < 2; ++qt) { mrun[qt] = a.in[I_SINK][qhead] * LOG2E; lrun[qt] = 1.f;
#pragma unroll
            for (int dt = 0; dt < 2; ++dt)
#pragma unroll
                for (int r = 0; r < 16; ++r) O[qt][dt][r] = 0.f; }
        const int skk = tid >> 2, sp = tid & 3, sbase = 32 * (sp >> 1) + 8 * (sp & 1);
        v4u rka, rkb, rv0, rv1; bool rvalid, rctx; int rkp;
#define ATT_PREFETCH(grp_) do { const int gk_ = (grp_) * 128 + skk; rctx = gk_ < 256; rkp = qb * 128 - 128 + (gk_ - 256); rvalid = rctx || (rkp >= 0 && rkp < T); \
            const size_t row_ = rctx ? (size_t)(M + b * CL + gk_) : (size_t)(b * T + (rvalid ? rkp : 0)); const bf16* rp_ = px + row_ * NPAD; \
            rka = (v4u){0u, 0u, 0u, 0u}; rkb = rka; rv0 = rka; rv1 = rka; \
            if (rvalid) { rka = *(const v4u*)(rp_ + C_AK + kvh * 64 + sbase); rkb = *(const v4u*)(rp_ + C_AK + kvh * 64 + sbase + 16); rv0 = *(const v4u*)(rp_ + C_AV + kvh * 64 + 16 * sp); rv1 = *(const v4u*)(rp_ + C_AV + kvh * 64 + 16 * sp + 8); } } while (0)
#define ATT_STAGE(buf_) do { v4u ka = rka, kb = rkb; \
                if (rvalid && !rctx) rope8(ka, kb, ((sp >> 1) ? tabC + (rkp & 63) * 16 : tabR + (rkp >> 6) * 16) + 8 * (sp & 1), 1.f); \
                LAS unsigned char* kd = Kl + (buf_) * ATT_BUF + (skk >> 5) * KT_BYTES + (skk & 31) * 144; \
                *(LAS v4u*)(kd + sbase * 2) = ka; *(LAS v4u*)(kd + (sbase + 16) * 2) = kb; \
                LAS unsigned char* vd = Vl + (buf_) * ATT_BUF + (skk >> 5) * VT_BYTES + (skk & 31) * VT_PITCH + sp * 32; *(LAS v4u*)vd = rv0; *(LAS v4u*)(vd + 16) = rv1; } while (0)
        ATT_PREFETCH(0);
        ATT_STAGE(0);
        ATT_PREFETCH(1);
        __syncthreads();
        for (int grp = 0; grp < 5; ++grp) {
            if (grp + 1 < 5) { ATT_STAGE((grp + 1) & 1); if (grp + 2 < 5) ATT_PREFETCH(grp + 2); }
            const int bo = (grp & 1) * ATT_BUF;
#pragma unroll 1
            for (int tl = 0; tl < 4; ++tl) {
                const int tile = grp * 4 + tl; const bool isctx = tile < 8; const int k0 = qb * 128 - 128 + (tile - 8) * 32;
                bool need[2], interior[2];
#pragma unroll
                for (int qt = 0; qt < 2; ++qt) { const int q0 = q0w + 32 * qt;
                    need[qt] = isctx || (k0 + 31 >= q0 - 128 && k0 <= q0 + 31 + 128 && k0 + 31 >= 0 && k0 < T);
                    interior[qt] = isctx || (k0 >= q0 + 31 - 128 && k0 + 31 <= q0 + 128 && k0 >= 0 && k0 + 31 < T); }
                if (!(need[0] || need[1])) continue;
                bf16x8 kf[4], vf[2][2];
#pragma unroll
                for (int s = 0; s < 4; ++s) kf[s] = *(const LAS bf16x8*)(Kl + bo + tl * KT_BYTES + l31 * 144 + (16 * s + 8 * h) * 2);
#pragma unroll
                for (int dt = 0; dt < 2; ++dt)
#pragma unroll
                    for (int sp = 0; sp < 2; ++sp) {
                        const LAS unsigned char* vp = Vl + bo + tl * VT_BYTES + (16 * sp + 4 * h + ((lane & 15) >> 2)) * VT_PITCH + (32 * dt + 16 * ((lane >> 4) & 1) + 4 * (lane & 3)) * 2;
                        const s16x4 lo = __builtin_amdgcn_ds_read_tr16_b64_v4i16((LAS s16x4*)vp), hi = __builtin_amdgcn_ds_read_tr16_b64_v4i16((LAS s16x4*)(vp + 8 * VT_PITCH));
                        vf[dt][sp] = (bf16x8){lo.x, lo.y, lo.z, lo.w, hi.x, hi.y, hi.z, hi.w}; }
#pragma unroll
                for (int qt = 0; qt < 2; ++qt) {
                    if (!need[qt]) continue;
                    f32x16 s;
#pragma unroll
                    for (int r = 0; r < 16; ++r) s[r] = 0.f;
#pragma unroll
                    for (int st = 0; st < 4; ++st) s = mfma32(kf[st], qf[qt][st], s);
                    if (!interior[qt]) { const int qpos = q0w + 32 * qt + l31;
#pragma unroll
                        for (int r = 0; r < 16; ++r) { const int kp = k0 + (r & 3) + 8 * (r >> 2) + 4 * h, dl = kp - qpos; const bool ok = dl >= -128 && dl <= 128 && kp >= 0 && kp < T; s[r] = ok ? s[r] : -__builtin_inff(); } }
                    float mx = s[0];
#pragma unroll
                    for (int r = 1; r < 16; ++r) mx = fmaxf(mx, s[r]);
                    mx = fmaxf(mx, __shfl_xor(mx, 32));
                    const float mn = fmaxf(mrun[qt], mx), alpha = __builtin_amdgcn_exp2f(mrun[qt] - mn); mrun[qt] = mn;
                    float rs = 0.f;
#pragma unroll
                    for (int r = 0; r < 16; ++r) { s[r] = __builtin_amdgcn_exp2f(s[r] - mn); rs += s[r]; }
                    rs += __shfl_xor(rs, 32); lrun[qt] = lrun[qt] * alpha + rs;
                    if (__any(alpha != 1.f)) {
#pragma unroll
                    for (int dt = 0; dt < 2; ++dt)
#pragma unroll
                        for (int r = 0; r < 16; ++r) O[qt][dt][r] *= alpha; }
                    bf16x8 pf[2];
#pragma unroll
                    for (int sp = 0; sp < 2; ++sp) { v4u w;
#pragma unroll
                        for (int i = 0; i < 4; ++i) w[i] = pk2(s[8 * sp + 2 * i], s[8 * sp + 2 * i + 1]);
                        pf[sp] = __builtin_bit_cast(bf16x8, w); }
#pragma unroll
                    for (int dt = 0; dt < 2; ++dt)
#pragma unroll
                        for (int sp = 0; sp < 2; ++sp) O[qt][dt] = mfma32(vf[dt][sp], pf[sp], O[qt][dt]);
                }
            }
            __syncthreads();
        }
#pragma unroll
        for (int qt = 0; qt < 2; ++qt) { const float inv = 1.f / lrun[qt];
            LAS unsigned char* ob = lds + 2 * ATT_BUF + wave * 4608;
#pragma unroll
            for (int dt = 0; dt < 2; ++dt)
#pragma unroll
                for (int rg = 0; rg < 4; ++rg) { v2u w; w.x = pk2(O[qt][dt][4 * rg] * inv, O[qt][dt][4 * rg + 1] * inv); w.y = pk2(O[qt][dt][4 * rg + 2] * inv, O[qt][dt][4 * rg + 3] * inv);
                    *(LAS v2u*)(ob + l31 * 144 + (32 * dt + 8 * rg + 4 * h) * 2) = w; }
            LDS_WAIT(); asm volatile("" ::: "memory");
#pragma unroll
            for (int j = 0; j < 4; ++j) { const int rr = (lane >> 3) + 8 * j; const v4u x = *(const LAS v4u*)(ob + rr * 144 + (lane & 7) * 16);
                *(v4u*)(mix + (size_t)(b * T + q0w + 32 * qt + rr) * D + RWW + qhead * 64 + (lane & 7) * 8) = x; }
            LDS_WAIT(); asm volatile("" ::: "memory"); }
    }
}


constexpr int RW_WLDS = 18432, RW_GAM = 16384, RW_PAR = 16640, LP = 3584;

struct LerpBuf { v4u r[10]; f32x4 m0, m1; };
__device__ __forceinline__ void lerp_load(LerpBuf& B, const bf16* __restrict__ px, const float* mu, long it) {
    constexpr int NCG = 3488 / 8, NCGP = 448, RB = 8;
    const int rb = (int)(it / NCGP), cg = (int)(it % NCGP), row0 = rb * RB; if (cg >= NCG) return; int t0, len; if (row0 < M) { t0 = row0 & (T - 1); len = T; } else { t0 = (row0 - M) & (CL - 1); len = CL; }
    const bf16* base = px + (size_t)row0 * NPAD + 8 * cg;
    B.r[0] = (v4u){0u, 0u, 0u, 0u}; B.r[RB + 1] = B.r[0];
    if (t0 > 0) B.r[0] = *(const v4u*)(base - NPAD);
#pragma unroll
    for (int i = 0; i < RB; ++i) B.r[i + 1] = *(const v4u*)(base + (size_t)i * NPAD);
    if (t0 + RB < len) B.r[RB + 1] = *(const v4u*)(base + (size_t)RB * NPAD);
    B.m0 = *(const f32x4*)(mu + 8 * cg); B.m1 = *(const f32x4*)(mu + 8 * cg + 4);
}
__device__ __forceinline__ void lerp_comp(const LerpBuf& B, bf16* __restrict__ pxl, long it) {
    constexpr int NCG = 3488 / 8, NCGP = 448, RB = 8;
    const int rb = (int)(it / NCGP), cg = (int)(it % NCGP), row0 = rb * RB; if (cg >= NCG) return; const bool th = (8 * cg >= C_WD && 8 * cg < C_AD);
    f32x2 m1[4], m2[4];
#pragma unroll
    for (int w = 0; w < 4; ++w) { const f32x2 m = (w < 2) ? (f32x2){B.m0[2 * w], B.m0[2 * w + 1]} : (f32x2){B.m1[2 * w - 4], B.m1[2 * w - 3]}; m1[w] = 1.f - m; m2[w] = 0.5f * m; }
    f32x2 pv[4], cu[4];
#pragma unroll
    for (int w = 0; w < 4; ++w) { pv[w] = (f32x2){bflo(B.r[0][w]), bfhi(B.r[0][w])}; cu[w] = (f32x2){bflo(B.r[1][w]), bfhi(B.r[1][w])}; }
#pragma unroll
    for (int i = 0; i < RB; ++i) { f32x2 nx[4], o[4];
#pragma unroll
        for (int w = 0; w < 4; ++w) { nx[w] = (f32x2){bflo(B.r[i + 2][w]), bfhi(B.r[i + 2][w])}; o[w] = cu[w] * m1[w] + m2[w] * (pv[w] + nx[w]); }
        if (th) {
#pragma unroll
            for (int w = 0; w < 4; ++w) { o[w].x = 1.f - 2.f * __builtin_amdgcn_rcpf(1.f + __expf(2.f * o[w].x)); o[w].y = 1.f - 2.f * __builtin_amdgcn_rcpf(1.f + __expf(2.f * o[w].y)); } }
        v4u ov;
#pragma unroll
        for (int w = 0; w < 4; ++w) { ov[w] = pk2(o[w].x, o[w].y); pv[w] = cu[w]; cu[w] = nx[w]; }
        *(v4u*)(pxl + (size_t)(row0 + i) * LP + 8 * cg) = ov; }
}
__device__ __forceinline__ void lerp_phase(const Args& a, int tid, int bid, int G) {
    const bf16* __restrict__ px = (const bf16*)(a.ws + WS_PX); bf16* __restrict__ pxl = (bf16*)a.out; const float* mu = a.in[I_MU];
    constexpr int NCGP = 448, RB = 8; const long total = (long)(MT / RB) * NCGP, stride = (long)G * NTHR;
    long it = (long)bid * NTHR + tid; if (it >= total) return;
    LerpBuf A, B;
    lerp_load(A, px, mu, it);
#pragma unroll 1
    for (; it < total; it += 2 * stride) {
        const bool hb = it + stride < total; if (hb) lerp_load(B, px, mu, it + stride);
        lerp_comp(A, pxl, it);
        if (hb) { if (it + 2 * stride < total) lerp_load(A, px, mu, it + 2 * stride); lerp_comp(B, pxl, it + stride); }
    }
}

#undef ATT_PREFETCH
#undef ATT_STAGE
constexpr size_t WS_PSTART = WS_H + 60 * MiB;
constexpr size_t WS_HSUP = WS_H, WS_PSUP = WS_H + 40 * MiB;
enum { FA = 0, FBT, FKT, FRT };
__device__ __forceinline__ unsigned cvtpk(float lo, float hi) { return pk2(lo, hi); }
__device__ __forceinline__ bf16x8 packt(const f32x16& t, int ks) { v4u w;
#pragma unroll
    for (int i = 0; i < 4; ++i) w[i] = cvtpk(t[8 * ks + 2 * i], t[8 * ks + 2 * i + 1]);
    return __builtin_bit_cast(bf16x8, w); }
__device__ __forceinline__ f32x16 zero16() { f32x16 z;
#pragma unroll
    for (int r = 0; r < 16; ++r) z[r] = 0.f;
    return z; }
__device__ __forceinline__ bf16x8 ldfrag(const LAS unsigned char* wl, int arr, int ct, int ks, int lane) { return *(const LAS bf16x8*)(wl + arr * 4096 + ((ct * 2 + ks) * 64 + lane) * 16); }
__device__ __forceinline__ float scan32(float v, int l31) {
    (void)l31;
#define DPP_ADD(ctrl, rmask) v += __builtin_bit_cast(float, __builtin_amdgcn_update_dpp(0, __builtin_bit_cast(int, v), ctrl, rmask, 0xF, false))
    DPP_ADD(0x111, 0xF); DPP_ADD(0x112, 0xF); DPP_ADD(0x114, 0xF); DPP_ADD(0x118, 0xF); DPP_ADD(0x142, 0xA);
#undef DPP_ADD
    return v; }

template <int MODE, bool TRACK = false>
__device__ __forceinline__ void rwkv_run(KArgP kap, LAS unsigned char* wl, int lane, int seq, int sc, f32x16 (&ST)[2][2], f32x4* uscr = nullptr, v4u* wscr = nullptr) {
    const int d = seq >> 5, b = (seq >> 4) & 1, hh = seq & 15;
#define LL() int ln_ = lane; asm volatile("" : "+v"(ln_)); const int h = ln_ >> 5, l31 = ln_ & 31; (void)h; (void)l31
#define MKIP() bf16x8 ip[2]; _Pragma("unroll") for (int ks = 0; ks < 2; ++ks) { s16x4 lo, hi; _Pragma("unroll") for (int j = 0; j < 4; ++j) { lo[j] = (16 * ks + 4 * h + j == l31) ? (short)0x3F80 : (short)0; hi[j] = (16 * ks + 8 + 4 * h + j == l31) ? (short)0x3F80 : (short)0; } ip[ks] = (bf16x8){lo.x, lo.y, lo.z, lo.w, hi.x, hi.y, hi.z, hi.w}; }
    const int nch = sc < 8 ? 17 : 16, c0 = sc < 8 ? 17 * sc : 136 + 16 * (sc - 8);
    { const Args& a0_ = *(const Args*)kap; LAS float* par = (LAS float*)(wl + RW_PAR);
      par[lane] = a0_.in[I_W0][d * RWW + hh * 64 + lane]; par[64 + lane] = a0_.in[I_A0][d * RWW + hh * 64 + lane]; par[128 + lane] = a0_.in[I_KK][hh * 64 + lane];
      par[192 + lane] = a0_.in[I_KA][hh * 64 + lane]; par[256 + lane] = a0_.in[I_RK][hh * 64 + lane]; }
#pragma unroll 1
    for (int ci = 0; ci < nch; ++ci) {
        KArgP kl = kap; asm volatile("" : "+s"(kl)); const Args& a = *(const Args*)kl;
        const bf16* px = (const bf16*)a.out; const bf16* w2t = (const bf16*)(a.ws + WS_W2T); const bf16* a2t = (const bf16*)(a.ws + WS_A2T);
        bf16* yd = (bf16*)(a.ws + WS_YD); float* bs = (float*)(a.ws + WS_BS);
        size_t row; const bool isx = (c0 + ci) >= CL / 32;
        { LL(); const int s = 32 * (c0 + ci) + l31; int tok;
        if (!isx) { tok = d ? (CL - 1 - s) : s; row = (size_t)(M + b * CL + tok); }
        else { const int tt = s - CL; tok = d ? (T - 1 - tt) : tt; row = (size_t)(b * T + tok); } }
        const bf16* cur = px + row * LP;
        const bf16* curh; { LL(); curh = cur + 4 * h + hh * 64; }
        v2u kraw[8], rraw[8];
#pragma unroll
        for (int q8 = 0; q8 < 8; ++q8) { kraw[q8] = *(const v2u*)(curh + C_K + 8 * q8); if (MODE == 2) rraw[q8] = *(const v2u*)(curh + C_R + 8 * q8); else rraw[q8] = (v2u){0u, 0u}; }
#define UNPK4(w) ((f32x4){bflo((w).x), bfhi((w).x), bflo((w).y), bfhi((w).y)})
        f32x16 lw[2], la[2]; lw[0] = zero16(); lw[1] = zero16(); la[0] = zero16(); la[1] = zero16();
        { LL();
#pragma unroll
        for (int ks4 = 0; ks4 < 4; ++ks4) {
            const int cw = C_WD + 64 * d + 16 * ks4 + 8 * h, ca = C_AD + 64 * d + 16 * ks4 + 8 * h;
            const v4u wf = *(const v4u*)(cur + cw), af = *(const v4u*)(cur + ca);
            const bf16x8 wdf = __builtin_bit_cast(bf16x8, wf), adf = __builtin_bit_cast(bf16x8, af);
#pragma unroll
            for (int ct = 0; ct < 2; ++ct) { const size_t wo = ((size_t)((((d * 16 + hh) * 2 + ct) * 4 + ks4) * 64 + ln_)) * 8;
                lw[ct] = mfma32(*(const bf16x8*)(w2t + wo), wdf, lw[ct]); la[ct] = mfma32(*(const bf16x8*)(a2t + wo), adf, la[ct]); }
        } }
        float rinv;
        { LL(); float n2 = 0.f;
#pragma unroll
        for (int ct = 0; ct < 2; ++ct)
#pragma unroll
            for (int q = 0; q < 4; ++q) { const int c = hh * 64 + 32 * ct + 8 * q + 4 * h;
                const f32x4 kv = UNPK4(kraw[4 * ct + q]) * *(const LAS f32x4*)(wl + RW_PAR + (2 * 64 + (c - hh * 64)) * 4); n2 += (kv.x * kv.x + kv.y * kv.y) + (kv.z * kv.z + kv.w * kv.w); }
        n2 += __shfl_xor(n2, 32); rinv = 1.f / sqrtf(fmaxf(n2, 1e-24f)); }
        float bonus = 0.f;
#pragma unroll
        for (int ct = 0; ct < 2; ++ct) {
            f32x16 Lc; unsigned apk[8];
            { LL();
#pragma unroll
            for (int q = 0; q < 4; ++q) { const int c = hh * 64 + 32 * ct + 8 * q + 4 * h;
                const f32x4 w0v = *(const LAS f32x4*)(wl + RW_PAR + (0 * 64 + (c - hh * 64)) * 4), a0v = *(const LAS f32x4*)(wl + RW_PAR + (1 * 64 + (c - hh * 64)) * 4);
                float av[4];
#pragma unroll
                for (int i = 0; i < 4; ++i) {
                    Lc[4 * q + i] = scan32(-0.60653065971f * __builtin_amdgcn_rcpf(1.f + __expf(-(w0v[i] + lw[ct][4 * q + i]))), l31); av[i] = __builtin_amdgcn_rcpf(1.f + __expf(-(a0v[i] + la[ct][4 * q + i]))); }
                apk[2 * q] = cvtpk(av[0], av[1]); apk[2 * q + 1] = cvtpk(av[2], av[3]); } }
            { LL(); const int lane = ln_;
#pragma unroll
            for (int q = 0; q < 4; ++q) { const int c = hh * 64 + 32 * ct + 8 * q + 4 * h;
                const f32x4 kkc = *(const LAS f32x4*)(wl + RW_PAR + (2 * 64 + (c - hh * 64)) * 4), kac = *(const LAS f32x4*)(wl + RW_PAR + (3 * 64 + (c - hh * 64)) * 4);
                const f32x4 kv = UNPK4(kraw[4 * ct + q]);
                f32x4 rv = {0.f, 0.f, 0.f, 0.f}, rkc = rv;
                if (MODE == 2) { rv = UNPK4(rraw[4 * ct + q]); rkc = *(const LAS f32x4*)(wl + RW_PAR + (4 * 64 + (c - hh * 64)) * 4); }
                float At[4], Bt[4], Kt[4], Rt[4];
#pragma unroll
                for (int i = 0; i < 4; ++i) { const int ix = 4 * q + i; const float Lci = Lc[ix], ai = (i & 1) ? bfhi(apk[ix >> 1]) : bflo(apk[ix >> 1]);
                    const float eL = __expf(Lci), eLm = __builtin_amdgcn_rcpf(eL); float ePrev = __shfl_up(eL, 1, 32); ePrev = (l31 == 0) ? 1.f : ePrev;
                    const float kk = kv[i] * kkc[i] * rinv, kmod = kv[i] * (1.f + (ai - 1.f) * kac[i]), beta = kk * ai;
                    At[i] = -kk * ePrev; Bt[i] = beta * eLm; Kt[i] = kmod * eLm; Rt[i] = rv[i] * eL;
                    if (MODE == 2) bonus += rv[i] * kmod * rkc[i];
                    if (l31 == 31) *(LAS float*)(wl + RW_GAM + (h * 32 + ct * 16 + ix) * 4) = eL; }
                LAS unsigned char* fp = wl + ((ct * 2 + (q >> 1)) * 64 + lane) * 16 + (q & 1) * 8;
                *(LAS v2u*)(fp + FA * 4096) = (v2u){cvtpk(At[0], At[1]), cvtpk(At[2], At[3])};
                *(LAS v2u*)(fp + FBT * 4096) = (v2u){cvtpk(Bt[0], Bt[1]), cvtpk(Bt[2], Bt[3])};
                if (MODE != 1) *(LAS v2u*)(fp + FKT * 4096) = (v2u){cvtpk(Kt[0], Kt[1]), cvtpk(Kt[2], Kt[3])};
                if (MODE == 2) *(LAS v2u*)(fp + FRT * 4096) = (v2u){cvtpk(Rt[0], Rt[1]), cvtpk(Rt[2], Rt[3])};
            } }
        }
        if (MODE == 2) bonus += __shfl_xor(bonus, 32);
        v2u vraw[8];
#pragma unroll
        for (int q8 = 0; q8 < 8; ++q8) vraw[q8] = (MODE != 1) ? *(const v2u*)(curh + C_V + 8 * q8) : (v2u){0u, 0u};
        bf16x8 pT[2];
        { LL(); const int lane = ln_;
            f32x16 X = zero16(), XT = zero16();
#pragma unroll
            for (int ct = 0; ct < 2; ++ct)
#pragma unroll
                for (int ks = 0; ks < 2; ++ks) { const bf16x8 fa = ldfrag(wl, FA, ct, ks, lane), fb = ldfrag(wl, FBT, ct, ks, lane); X = mfma32(fb, fa, X); XT = mfma32(fa, fb, XT); }
            f32x16 Tm;
#pragma unroll
            for (int r = 0; r < 16; ++r) { const int rw = (r & 3) + 8 * (r >> 2) + 4 * h; X[r] = (rw < l31) ? X[r] : 0.f; XT[r] = (l31 < rw) ? XT[r] : 0.f; Tm[r] = X[r] + ((rw == l31) ? 1.f : 0.f); }
#pragma unroll
            for (int it = 0; it < 4; ++it) {
                f32x16 X2 = zero16(), X2T = zero16();
                const bf16x8 px0 = packt(X, 0), px1 = packt(X, 1), pxt0 = packt(XT, 0), pxt1 = packt(XT, 1);
                X2 = mfma32(pxt0, px0, X2); X2 = mfma32(pxt1, px1, X2); X2T = mfma32(px0, pxt0, X2T); X2T = mfma32(px1, pxt1, X2T);
                const bf16x8 p2t0 = packt(X2T, 0), p2t1 = packt(X2T, 1), pt0 = packt(Tm, 0), pt1 = packt(Tm, 1);
                Tm = mfma32(p2t0, pt0, Tm); Tm = mfma32(p2t1, pt1, Tm);
                X = X2; XT = X2T;
            }
            pT[0] = packt(Tm, 0); pT[1] = packt(Tm, 1);
        }
        bf16x8 pW1T[2][2];
        { LL(); const int lane = ln_; MKIP();
#pragma unroll
        for (int ct = 0; ct < 2; ++ct) { f32x16 at = zero16(); at = mfma32(ldfrag(wl, FA, ct, 0, lane), ip[0], at); at = mfma32(ldfrag(wl, FA, ct, 1, lane), ip[1], at);
            f32x16 w1 = zero16(); w1 = mfma32(pT[0], packt(at, 0), w1); w1 = mfma32(pT[1], packt(at, 1), w1); pW1T[ct][0] = packt(w1, 0); pW1T[ct][1] = packt(w1, 1); } }
        bf16x8 pW2T[2];
        if (MODE != 1) { LL(); const int lane = ln_;
            f32x16 nak = zero16();
#pragma unroll
            for (int ct = 0; ct < 2; ++ct)
#pragma unroll
                for (int ks = 0; ks < 2; ++ks) nak = mfma32(ldfrag(wl, FA, ct, ks, lane), ldfrag(wl, FKT, ct, ks, lane), nak);
#pragma unroll
            for (int r = 0; r < 16; ++r) { const int rw = (r & 3) + 8 * (r >> 2) + 4 * h; nak[r] = (l31 < rw) ? nak[r] : 0.f; }
            f32x16 w2 = zero16(); w2 = mfma32(pT[0], packt(nak, 0), w2); w2 = mfma32(pT[1], packt(nak, 1), w2); pW2T[0] = packt(w2, 0); pW2T[1] = packt(w2, 1);
        }
        if (MODE == 2) { LL(); const int lane = ln_;
            f32x16 nbr = zero16(), nkr = zero16();
#pragma unroll
            for (int ct = 0; ct < 2; ++ct)
#pragma unroll
                for (int ks = 0; ks < 2; ++ks) { const bf16x8 fr = ldfrag(wl, FRT, ct, ks, lane); nbr = mfma32(ldfrag(wl, FBT, ct, ks, lane), fr, nbr); nkr = mfma32(ldfrag(wl, FKT, ct, ks, lane), fr, nkr); }
#pragma unroll
            for (int r = 0; r < 16; ++r) { const int rw = (r & 3) + 8 * (r >> 2) + 4 * h; nbr[r] = (rw <= l31) ? nbr[r] : 0.f; nkr[r] = (rw <= l31) ? nkr[r] : 0.f; }
            const bf16x8 pnb0 = packt(nbr, 0), pnb1 = packt(nbr, 1);
#pragma unroll
            for (int ct = 0; ct < 2; ++ct) { f32x16 g;
#pragma unroll
                for (int ks = 0; ks < 2; ++ks) { const v4u w = __builtin_bit_cast(v4u, ldfrag(wl, FRT, ct, ks, lane));
#pragma unroll
                    for (int i = 0; i < 4; ++i) { g[8 * ks + 2 * i] = bflo(w[i]); g[8 * ks + 2 * i + 1] = bfhi(w[i]); } }
                g = mfma32(pW1T[ct][0], pnb0, g); g = mfma32(pW1T[ct][1], pnb1, g);
                *(LAS bf16x8*)(wl + FRT * 4096 + ((ct * 2 + 0) * 64 + lane) * 16) = packt(g, 0); *(LAS bf16x8*)(wl + FRT * 4096 + ((ct * 2 + 1) * 64 + lane) * 16) = packt(g, 1); }
            nkr = mfma32(pW2T[0], pnb0, nkr); nkr = mfma32(pW2T[1], pnb1, nkr);
            *(LAS bf16x8*)(wl + FA * 4096 + (0 * 64 + lane) * 16) = packt(nkr, 0); *(LAS bf16x8*)(wl + FA * 4096 + (1 * 64 + lane) * 16) = packt(nkr, 1);
        }
        bf16x8 pPp[2][2][2], pQ[2][2], pVT[2][2];
        { LL(); const int lane = ln_; MKIP();
            bf16x8 pBhT[2][2]; float gcol[2];
#pragma unroll
            for (int j2 = 0; j2 < 2; ++j2) gcol[j2] = *(const LAS float*)(wl + RW_GAM + ((((l31 >> 2) & 1) * 32) + j2 * 16 + (l31 & 3) + 4 * (l31 >> 3)) * 4);
#pragma unroll
            for (int j2 = 0; j2 < 2; ++j2) { f32x16 t = zero16(); t = mfma32(ldfrag(wl, FBT, j2, 0, lane), ip[0], t); t = mfma32(ldfrag(wl, FBT, j2, 1, lane), ip[1], t); t = t * gcol[j2]; pBhT[j2][0] = packt(t, 0); pBhT[j2][1] = packt(t, 1); }
#pragma unroll
            for (int jt = 0; jt < 2; ++jt)
#pragma unroll
                for (int j2 = 0; j2 < 2; ++j2) { f32x16 p = zero16(); p = mfma32(pW1T[jt][0], pBhT[j2][0], p); p = mfma32(pW1T[jt][1], pBhT[j2][1], p); pPp[jt][j2][0] = packt(p, 0); pPp[jt][j2][1] = packt(p, 1); }
            if (MODE != 1) {
#pragma unroll
                for (int jt = 0; jt < 2; ++jt) { f32x16 qq = zero16(); qq = mfma32(ldfrag(wl, FKT, jt, 0, lane), ip[0], qq); qq = mfma32(ldfrag(wl, FKT, jt, 1, lane), ip[1], qq); qq = qq * gcol[jt];
                    qq = mfma32(pW2T[0], pBhT[jt][0], qq); qq = mfma32(pW2T[1], pBhT[jt][1], qq); pQ[jt][0] = packt(qq, 0); pQ[jt][1] = packt(qq, 1); }
#pragma unroll
                for (int it = 0; it < 2; ++it) { f32x16 t = zero16();
#pragma unroll
                    for (int ks = 0; ks < 2; ++ks) { const v2u lo = vraw[4 * it + 2 * ks], hi = vraw[4 * it + 2 * ks + 1];
                        t = mfma32(__builtin_bit_cast(bf16x8, (v4u){lo.x, lo.y, hi.x, hi.y}), ip[ks], t); }
                    pVT[it][0] = packt(t, 0); pVT[it][1] = packt(t, 1); }
            }
        }
        bf16x8 pST[2][2][2];
#pragma unroll
        for (int jt = 0; jt < 2; ++jt)
#pragma unroll
            for (int it = 0; it < 2; ++it) { pST[jt][it][0] = packt(ST[jt][it], 0); pST[jt][it][1] = packt(ST[jt][it], 1); }
        LL();
        if (MODE == 2) {
#pragma unroll
            for (int it = 0; it < 2; ++it) { f32x16 y = zero16();
#pragma unroll
                for (int ks = 0; ks < 2; ++ks) y = mfma32(pVT[it][ks], ldfrag(wl, FA, 0, ks, ln_), y);
#pragma unroll
                for (int jt = 0; jt < 2; ++jt)
#pragma unroll
                    for (int ks = 0; ks < 2; ++ks) y = mfma32(pST[jt][it][ks], ldfrag(wl, FRT, jt, ks, ln_), y);
                if (isx) {
                    const int kx = (c0 + ci) - CL / 32, kt = d ? 511 - kx : kx, lanep = d ? ((ln_ & 32) | (31 - l31)) : ln_;
                    v4u* ydf = (v4u*)yd + ((size_t)((((d * 2 + b) * 16 + hh) * 512 + kt) * 4 + it * 2)) * 64 + lanep;
                    ydf[0] = __builtin_bit_cast(v4u, packt(y, 0)); ydf[64] = __builtin_bit_cast(v4u, packt(y, 1)); } }
            if (isx && h == 0) { const int kx = (c0 + ci) - CL / 32, kt = d ? 511 - kx : kx; bs[(size_t)((((d * 2 + b) * 16 + hh) * 512 + kt) * 32) + (d ? 31 - l31 : l31)] = bonus; }
        }
#pragma unroll
        for (int j2 = 0; j2 < 2; ++j2) {
            f32x4 gq[4];
#pragma unroll
            for (int q = 0; q < 4; ++q) gq[q] = *(const LAS f32x4*)(wl + RW_GAM + (h * 32 + j2 * 16 + 4 * q) * 4);
#pragma unroll
            for (int it = 0; it < 2; ++it) { f32x16 acc;
#pragma unroll
                for (int r = 0; r < 16; ++r) acc[r] = gq[r >> 2][r & 3] * ST[j2][it][r];
                if (MODE != 1) { acc = mfma32(pQ[j2][0], pVT[it][0], acc); acc = mfma32(pQ[j2][1], pVT[it][1], acc); }
#pragma unroll
                for (int jt = 0; jt < 2; ++jt)
#pragma unroll
                    for (int ks = 0; ks < 2; ++ks) acc = mfma32(pPp[jt][j2][ks], pST[jt][it][ks], acc);
                ST[j2][it] = acc; }
        }
        if (TRACK) { __builtin_amdgcn_sched_barrier(0);
            bf16x8 pU[2][2][2];
            const v4u* uq = (const v4u*)uscr;
#pragma unroll
            for (int jt = 0; jt < 2; ++jt)
#pragma unroll
                for (int it = 0; it < 2; ++it)
#pragma unroll
                    for (int ks = 0; ks < 2; ++ks) pU[jt][it][ks] = __builtin_bit_cast(bf16x8, uq[((jt * 2 + it) * 2 + ks) * 64 + ln_]);
            if (MODE == 2 && isx) {
#pragma unroll
                for (int i2 = 0; i2 < 2; ++i2) { f32x16 w = zero16();
#pragma unroll
                    for (int jt = 0; jt < 2; ++jt)
#pragma unroll
                        for (int ks = 0; ks < 2; ++ks) w = mfma32(pU[jt][i2][ks], ldfrag(wl, FRT, jt, ks, ln_), w);
                    wscr[((ci * 2 + i2) * 2 + 0) * 64 + ln_] = __builtin_bit_cast(v4u, packt(w, 0)); wscr[((ci * 2 + i2) * 2 + 1) * 64 + ln_] = __builtin_bit_cast(v4u, packt(w, 1)); }
            }
#pragma unroll
            for (int j2 = 0; j2 < 2; ++j2) {
                f32x4 gq[4];
#pragma unroll
                for (int q = 0; q < 4; ++q) gq[q] = *(const LAS f32x4*)(wl + RW_GAM + (h * 32 + j2 * 16 + 4 * q) * 4);
#pragma unroll
                for (int it = 0; it < 2; ++it) { f32x16 acc;
#pragma unroll
                    for (int ks = 0; ks < 2; ++ks) { const v4u w = __builtin_bit_cast(v4u, pU[j2][it][ks]);
#pragma unroll
                        for (int i = 0; i < 4; ++i) { const int r0 = 8 * ks + 2 * i; acc[r0] = gq[r0 >> 2][r0 & 3] * bflo(w[i]); acc[r0 + 1] = gq[(r0 + 1) >> 2][(r0 + 1) & 3] * bfhi(w[i]); } }
#pragma unroll
                    for (int jt = 0; jt < 2; ++jt)
#pragma unroll
                        for (int ks = 0; ks < 2; ++ks) acc = mfma32(pPp[jt][j2][ks], pU[jt][it][ks], acc);
                    v4u* us = (v4u*)uscr;
                    us[((j2 * 2 + it) * 2 + 0) * 64 + ln_] = __builtin_bit_cast(v4u, packt(acc, 0)); us[((j2 * 2 + it) * 2 + 1) * 64 + ln_] = __builtin_bit_cast(v4u, packt(acc, 1)); }
            }
        }
    }
}
#undef LL
#undef MKIP
#undef UNPK4

__device__ __forceinline__ void p4_rwkv_passA(KArgP kap, LAS unsigned char* lds, int lane0, int wave, int bid, int G) {
    const Args& a = *(const Args*)kap;
    LAS unsigned char* wl = lds + wave * RW_WLDS;
    f32x4* uscr = (f32x4*)(a.ws + WS_PX + 160 * MiB) + (size_t)(bid * NWAVES + wave) * 1024;
#pragma unroll 1
    for (int item = bid * 8 + wave; item < 2048; item += G * 8) {
        int lane = lane0; asm volatile("" : "+v"(lane)); const int h = lane >> 5, l31 = lane & 31;
        const int seq = item >> 5, sc = item & 31;
        f32x16 ST[2][2];
        float z = 0.f; asm volatile("" : "+v"(z));
#pragma unroll
        for (int r = 0; r < 16; ++r) { ST[0][0][r] = z; ST[0][1][r] = z; ST[1][0][r] = z; ST[1][1][r] = z; }
#pragma unroll
        for (int jt = 0; jt < 2; ++jt)
#pragma unroll
            for (int it = 0; it < 2; ++it)
#pragma unroll
                for (int ks = 0; ks < 2; ++ks) { f32x16 u;
#pragma unroll
                    for (int r = 0; r < 16; ++r) u[r] = (jt == it && ((r & 3) + 8 * (r >> 2) + 4 * h) == l31) ? 1.f : z;
                    ((v4u*)uscr)[((jt * 2 + it) * 2 + ks) * 64 + lane] = __builtin_bit_cast(v4u, packt(u, ks)); }
        rwkv_run<2, true>(kap, wl, lane, seq, sc, ST, uscr, (v4u*)(a.ws + WS_PX) + (size_t)item * (17 * 256));
        asm volatile("" : "+v"(lane));
        const int h2 = lane >> 5, l31b = lane & 31;
        v4u* hs = (v4u*)(a.ws + WS_HSUP) + (size_t)item * 512;
#pragma unroll
        for (int jt = 0; jt < 2; ++jt)
#pragma unroll
            for (int it = 0; it < 2; ++it)
#pragma unroll
                for (int ks = 0; ks < 2; ++ks) hs[((jt * 2 + it) * 2 + ks) * 64 + lane] = __builtin_bit_cast(v4u, packt(ST[jt][it], ks));
        bf16x8 ip[2];
#pragma unroll
        for (int ks = 0; ks < 2; ++ks) { s16x4 lo, hi;
#pragma unroll
            for (int j = 0; j < 4; ++j) { lo[j] = (16 * ks + 4 * h2 + j == l31b) ? (short)0x3F80 : (short)0; hi[j] = (16 * ks + 8 + 4 * h2 + j == l31b) ? (short)0x3F80 : (short)0; }
            ip[ks] = (bf16x8){lo.x, lo.y, lo.z, lo.w, hi.x, hi.y, hi.z, hi.w}; }
        v4u* ps = (v4u*)(a.ws + WS_PSUP) + (size_t)item * 512;
#pragma unroll
        for (int jt = 0; jt < 2; ++jt)
#pragma unroll
            for (int j2 = 0; j2 < 2; ++j2) {
                const bf16x8 u0 = __builtin_bit_cast(bf16x8, ((const v4u*)uscr)[((j2 * 2 + jt) * 2 + 0) * 64 + lane]), u1 = __builtin_bit_cast(bf16x8, ((const v4u*)uscr)[((j2 * 2 + jt) * 2 + 1) * 64 + lane]);
                f32x16 x = zero16(); x = mfma32(u0, ip[0], x); x = mfma32(u1, ip[1], x);
                ps[((jt * 2 + j2) * 2 + 0) * 64 + lane] = __builtin_bit_cast(v4u, packt(x, 0)); ps[((jt * 2 + j2) * 2 + 1) * 64 + lane] = __builtin_bit_cast(v4u, packt(x, 1)); }
    }
}
__device__ __forceinline__ void p5_rwkv_passC(KArgP kap, LAS unsigned char* lds, int lane0, int wave, int bid, int G) {
    const Args& a = *(const Args*)kap; (void)lds;
#pragma unroll 1
    for (int item = bid * 8 + wave; item < 2048; item += G * 8) {
        int lane = lane0; asm volatile("" : "+v"(lane));
        const int seq = item >> 5, sc = item & 31;
        if (sc == 0) continue;
        f32x16 ST[2][2];
        { float z = 0.f; asm volatile("" : "+v"(z));
#pragma unroll
          for (int r = 0; r < 16; ++r) { ST[0][0][r] = z; ST[0][1][r] = z; ST[1][0][r] = z; ST[1][1][r] = z; } }
        const v4u* hs0 = (const v4u*)(a.ws + WS_HSUP) + (size_t)(seq * 32) * 512 + lane; const v4u* ps0 = (const v4u*)(a.ws + WS_PSUP) + (size_t)(seq * 32) * 512 + lane;
#define PF_LOAD(BP, BH, kk) do { _Pragma("unroll") for (int f = 0; f < 8; ++f) { BP[f] = ps0[(size_t)(kk) * 512 + f * 64]; BH[f] = hs0[(size_t)(kk) * 512 + f * 64]; } } while (0)
#define PF_STEP(BP, BH) do { bf16x8 pST[2][2][2]; \
            _Pragma("unroll") for (int jt = 0; jt < 2; ++jt) _Pragma("unroll") for (int it = 0; it < 2; ++it) { pST[jt][it][0] = packt(ST[jt][it], 0); pST[jt][it][1] = packt(ST[jt][it], 1); } \
            _Pragma("unroll") for (int j2 = 0; j2 < 2; ++j2) _Pragma("unroll") for (int it = 0; it < 2; ++it) { f32x16 acc; \
                _Pragma("unroll") for (int ks = 0; ks < 2; ++ks) { const v4u w = BH[(j2 * 2 + it) * 2 + ks]; _Pragma("unroll") for (int i = 0; i < 4; ++i) { acc[8 * ks + 2 * i] = bflo(w[i]); acc[8 * ks + 2 * i + 1] = bfhi(w[i]); } } \
                _Pragma("unroll") for (int jt = 0; jt < 2; ++jt) _Pragma("unroll") for (int ks = 0; ks < 2; ++ks) acc = mfma32(__builtin_bit_cast(bf16x8, BP[(jt * 2 + j2) * 2 + ks]), pST[jt][it][ks], acc); \
                ST[j2][it] = acc; } } while (0)
        v4u aP[8], aH[8], bP[8], bH[8];
        PF_LOAD(aP, aH, 0);
#pragma unroll 1
        for (int k = 0; k < sc; k += 2) {
            if (k + 1 < sc) PF_LOAD(bP, bH, k + 1);
            PF_STEP(aP, aH);
            if (k + 1 < sc) { if (k + 2 < sc) PF_LOAD(aP, aH, k + 2); PF_STEP(bP, bH); }
        }
#undef PF_LOAD
#undef PF_STEP
        v4u* pst = (v4u*)(a.ws + WS_PSTART) + (size_t)item * 512;
#pragma unroll
        for (int jt = 0; jt < 2; ++jt)
#pragma unroll
            for (int it = 0; it < 2; ++it) { pst[((jt * 2 + it) * 2 + 0) * 64 + lane] = __builtin_bit_cast(v4u, packt(ST[jt][it], 0)); pst[((jt * 2 + it) * 2 + 1) * 64 + lane] = __builtin_bit_cast(v4u, packt(ST[jt][it], 1)); }
    }
}
__device__ __forceinline__ void p5_rwkv_finish(const Args& a, LAS unsigned char* lds, int tid, int lane, int wave, int bid, int G) {
    const bf16* px = (const bf16*)a.out; bf16* mix = (bf16*)(a.ws + WS_MIX); const bf16* yd = (const bf16*)(a.ws + WS_YD); const float* bs = (const float*)(a.ws + WS_BS);
    const bf16* g2t = (const bf16*)(a.ws + WS_G2T); LAS bf16* sgl = (LAS bf16*)lds;
    const int h = lane >> 5, l31 = lane & 31;
    for (int tile = bid; tile < M / 32; tile += G) {
        __syncthreads();
        for (int e = tid; e < 32 * 20; e += NTHR) { const int tk = e / 20, i8 = e % 20; const size_t row = (size_t)tile * 32 + tk;
            const v4u w = *(const v4u*)(px + row * LP + C_GD + 8 * i8); v4u o;
#pragma unroll
            for (int i = 0; i < 4; ++i) o[i] = pk2(__builtin_amdgcn_rcpf(1.f + __expf(-bflo(w[i]))), __builtin_amdgcn_rcpf(1.f + __expf(-bfhi(w[i]))));
            *(LAS v4u*)(sgl + tk * 168 + 8 * i8) = o; }
        __syncthreads();
        const size_t row = (size_t)tile * 32 + l31;
#pragma unroll 1
        for (int hi = 0; hi < 2; ++hi) { const int hh = 2 * wave + hi;
            f32x16 gacc[2];
#pragma unroll
            for (int ct = 0; ct < 2; ++ct)
#pragma unroll
                for (int r = 0; r < 16; ++r) gacc[ct][r] = 0.f;
#pragma unroll 5
            for (int s = 0; s < 10; ++s) { const bf16x8 bfr = *(const LAS bf16x8*)(sgl + l31 * 168 + 16 * s + 8 * h);
#pragma unroll
                for (int ct = 0; ct < 2; ++ct) { const bf16x8 afr = *(const bf16x8*)(g2t + ((size_t)(((hh * 2 + ct) * 10 + s) * 64 + lane)) * 8); gacc[ct] = mfma32(afr, bfr, gacc[ct]); } }
            f32x4 yv[2][4]; float sum = 0.f; v2u vraw[2][4]; f32x4 lwv[2][4], lbv[2][4];
            const int bbt = tile >> 9, ktt = tile & 511; const size_t f0 = (size_t)(((0 * 2 + bbt) * 16 + hh) * 512 + ktt), f1 = (size_t)(((1 * 2 + bbt) * 16 + hh) * 512 + ktt);
            const float bsum = bs[f0 * 32 + l31] + bs[f1 * 32 + l31];
            const v4u* y0p = (const v4u*)yd + f0 * 256 + lane; const v4u* y1p = (const v4u*)yd + f1 * 256 + lane;
#pragma unroll
            for (int ct = 0; ct < 2; ++ct)
#pragma unroll
                for (int qp = 0; qp < 2; ++qp) { const v4u w0 = y0p[(ct * 2 + qp) * 64], w1 = y1p[(ct * 2 + qp) * 64];
                    yv[ct][2 * qp] = (f32x4){bflo(w0.x) + bflo(w1.x), bfhi(w0.x) + bfhi(w1.x), bflo(w0.y) + bflo(w1.y), bfhi(w0.y) + bfhi(w1.y)};
                    yv[ct][2 * qp + 1] = (f32x4){bflo(w0.z) + bflo(w1.z), bfhi(w0.z) + bfhi(w1.z), bflo(w0.w) + bflo(w1.w), bfhi(w0.w) + bfhi(w1.w)}; }
#pragma unroll
            for (int ct = 0; ct < 2; ++ct)
#pragma unroll
                for (int rg = 0; rg < 4; ++rg) { const int c = hh * 64 + 32 * ct + 8 * rg + 4 * h;
                    vraw[ct][rg] = *(const v2u*)(px + row * LP + C_V + c); lwv[ct][rg] = *(const f32x4*)(a.in[I_LNW] + c); lbv[ct][rg] = *(const f32x4*)(a.in[I_LNB] + c); }
#pragma unroll
            for (int dd = 0; dd < 2; ++dd) { const int bb = (int)(row >> 14), kt = (tile & 511), cc = 8 + (dd ? (511 - kt) : kt), sc = cc < 136 ? cc / 17 : 8 + (cc - 136) / 16;
                if (sc == 0) continue;
                const int ci = cc - (sc < 8 ? 17 * sc : 136 + 16 * (sc - 8)), item = ((dd * 2 + bb) * 16 + hh) * 32 + sc;
                const v4u* pst = (const v4u*)(a.ws + WS_PSTART) + (size_t)item * 512; const v4u* wsc = (const v4u*)(a.ws + WS_PX) + (size_t)item * (17 * 256);
                bf16x8 pW[2][2];
#pragma unroll
                for (int i2 = 0; i2 < 2; ++i2)
#pragma unroll
                    for (int ks = 0; ks < 2; ++ks) pW[i2][ks] = __builtin_bit_cast(bf16x8, wsc[((ci * 2 + i2) * 2 + ks) * 64 + lane]);
#pragma unroll
                for (int it = 0; it < 2; ++it) { f32x16 cr = zero16();
#pragma unroll
                    for (int i2 = 0; i2 < 2; ++i2)
#pragma unroll
                        for (int ks = 0; ks < 2; ++ks) cr = mfma32(__builtin_bit_cast(bf16x8, pst[((i2 * 2 + it) * 2 + ks) * 64 + lane]), pW[i2][ks], cr);
#pragma unroll
                    for (int rg = 0; rg < 4; ++rg) { f32x4 cv = {cr[4 * rg], cr[4 * rg + 1], cr[4 * rg + 2], cr[4 * rg + 3]};
                        if (dd) { const int src = (lane & 32) | (31 - l31); cv.x = __shfl(cv.x, src); cv.y = __shfl(cv.y, src); cv.z = __shfl(cv.z, src); cv.w = __shfl(cv.w, src); }
                        yv[it][rg] += cv; } }
            }
#pragma unroll
            for (int ct = 0; ct < 2; ++ct)
#pragma unroll
                for (int rg = 0; rg < 4; ++rg) sum += (yv[ct][rg].x + yv[ct][rg].y) + (yv[ct][rg].z + yv[ct][rg].w);
            sum += __shfl_xor(sum, 32); const float mean = sum * (1.f / 64.f); float vs = 0.f;
#pragma unroll
            for (int ct = 0; ct < 2; ++ct)
#pragma unroll
                for (int rg = 0; rg < 4; ++rg) { const f32x4 dlt = yv[ct][rg] - mean; vs += (dlt.x * dlt.x + dlt.y * dlt.y) + (dlt.z * dlt.z + dlt.w * dlt.w); }
            vs += __shfl_xor(vs, 32); const float rstd = 1.f / sqrtf(vs * (1.f / 64.f) + GN_EPS);
#pragma unroll
            for (int ct = 0; ct < 2; ++ct)
#pragma unroll
                for (int rg = 0; rg < 4; ++rg) { const int c = hh * 64 + 32 * ct + 8 * rg + 4 * h;
                    const f32x4 lw = lwv[ct][rg], lb = lbv[ct][rg];
                    const v2u vw = vraw[ct][rg]; const f32x4 vv = {bflo(vw.x), bfhi(vw.x), bflo(vw.y), bfhi(vw.y)};
                    const f32x4 gg = {gacc[ct][4 * rg], gacc[ct][4 * rg + 1], gacc[ct][4 * rg + 2], gacc[ct][4 * rg + 3]};
                    const f32x4 o = ((yv[ct][rg] - mean) * rstd * lw + lb + vv * bsum) * gg;
                    v2u w; w.x = pk2(o.x, o.y); w.y = pk2(o.z, o.w); *(LAS v2u*)(lds + 16384 + wave * 4608 + l31 * 144 + (32 * ct + 8 * rg + 4 * h) * 2) = w; }
            LDS_WAIT(); asm volatile("" ::: "memory");
#pragma unroll
            for (int j = 0; j < 4; ++j) { const int rr = (lane >> 3) + 8 * j; const v4u x = *(const LAS v4u*)(lds + 16384 + wave * 4608 + rr * 144 + (lane & 7) * 16);
                *(v4u*)(mix + ((size_t)tile * 32 + rr) * D + hh * 64 + (lane & 7) * 8) = x; }
            LDS_WAIT(); asm volatile("" ::: "memory");
        }
    }
}

__device__ __forceinline__ float wave_sum_dpp(float v) {
#define DPP_ADD(ctrl, rmask) v += __builtin_bit_cast(float, __builtin_amdgcn_update_dpp(0, __builtin_bit_cast(int, v), ctrl, rmask, 0xF, false))
    DPP_ADD(0xB1, 0xF); DPP_ADD(0x4E, 0xF); DPP_ADD(0x141, 0xF); DPP_ADD(0x140, 0xF); DPP_ADD(0x142, 0xA); DPP_ADD(0x143, 0xC);
#undef DPP_ADD
    return rdlane(v, 63);
}
__device__ __forceinline__ void moe_norm_router(const Args& a, int l, const bf16* xin, LAS unsigned char* lds, int tid, int lane, int wave, int bid, int G) {
    LAS float* rw = (LAS float*)lds;
    __syncthreads();
    for (int i = tid; i < 2048 * 16; i += NTHR) rw[(i & 15) * 2052 + (i >> 4)] = a.in[I_ROUTER][(size_t)l * 32768 + i];
    __syncthreads();
    const int gw = bid * NWAVES + wave, NGW = G * NWAVES; bf16* h1 = (bf16*)(a.ws + WS_H); float* aff = (float*)(a.ws + WS_AFF);
    LAS float* affl = (LAS float*)(lds + 16 * 2052 * 4) + wave * 256;
    f32x4 A[8], B[8];
    for (int ch = gw; ch < M / 16; ch += NGW) {
        const int b = ch / (T / 16);
        load_coef(a.in[I_NFFN] + l * D, modp(a.ws, l, b, 4), modp(a.ws, l, b, 3), lane, A, B);
        v2u raw[4][8];
#pragma unroll
        for (int u = 0; u < 4; ++u) { const v2u* p = (const v2u*)(xin + ((size_t)ch * 16 + u) * D) + lane;
#pragma unroll
            for (int j = 0; j < 8; ++j) raw[u][j] = p[64 * j]; }
#pragma unroll 1
        for (int rr = 0; rr < 16; rr += 2) { const size_t row = (size_t)ch * 16 + rr; f32x4 v0[8], v1[8];
#pragma unroll
            for (int j = 0; j < 8; ++j) { v0[j] = (f32x4){bflo(raw[0][j].x), bfhi(raw[0][j].x), bflo(raw[0][j].y), bfhi(raw[0][j].y)}; v1[j] = (f32x4){bflo(raw[1][j].x), bfhi(raw[1][j].x), bflo(raw[1][j].y), bfhi(raw[1][j].y)};
                raw[0][j] = raw[2][j]; raw[1][j] = raw[3][j]; }
            if (rr + 4 < 16) {
#pragma unroll
                for (int u = 0; u < 2; ++u) { const v2u* p = (const v2u*)(xin + (row + 4 + u) * D) + lane;
#pragma unroll
                    for (int j = 0; j < 8; ++j) raw[2 + u][j] = p[64 * j]; } }
            const float rs0 = row_rstd(v0), rs1 = row_rstd(v1);
#pragma unroll
            for (int j = 0; j < 8; ++j) { v0[j] = v0[j] * rs0 * A[j] + B[j]; v1[j] = v1[j] * rs1 * A[j] + B[j]; }
            store_row_bf16(h1 + row * D, v0, lane); store_row_bf16(h1 + (row + 1) * D, v1, lane);
            float lg0 = -__builtin_inff(), lg1 = lg0;
#pragma unroll 1
            for (int e = 0; e < 16; ++e) { f32x4 q0 = {0.f, 0.f, 0.f, 0.f}, q1 = q0;
#pragma unroll
                for (int j = 0; j < 8; ++j) { const f32x4 w = *(const LAS f32x4*)(rw + e * 2052 + 4 * lane + 256 * j); q0 += v0[j] * w; q1 += v1[j] * w; }
                float p0 = (q0.x + q0.y) + (q0.z + q0.w), p1 = (q1.x + q1.y) + (q1.z + q1.w);
                p0 = wave_sum_dpp(p0); p1 = wave_sum_dpp(p1); lg0 = (lane == e) ? p0 : lg0; lg1 = (lane == e) ? p1 : lg1; }
            float m0 = lg0, m1 = lg1;
#pragma unroll
            for (int o = 1; o < 16; o <<= 1) { m0 = fmaxf(m0, __shfl_xor(m0, o)); m1 = fmaxf(m1, __shfl_xor(m1, o)); }
            const float e0 = (lane < 16) ? __expf(lg0 - m0) : 0.f, e1 = (lane < 16) ? __expf(lg1 - m1) : 0.f; float s0 = e0, s1 = e1;
#pragma unroll
            for (int o = 1; o < 16; o <<= 1) { s0 += __shfl_xor(s0, o); s1 += __shfl_xor(s1, o); }
            if (lane < 16) { affl[lane * 16 + rr] = e0 / s0; affl[lane * 16 + rr + 1] = e1 / s1; } }
        LDS_WAIT(); asm volatile("" ::: "memory");
        { const f32x4 av = *(const LAS f32x4*)(affl + (lane >> 2) * 16 + (lane & 3) * 4);
          *(f32x4*)(aff + ((size_t)(b * 16 + (lane >> 2))) * T + (((size_t)ch * 16) & (T - 1)) + (lane & 3) * 4) = av; }
        LDS_WAIT(); asm volatile("" ::: "memory");
    }
}
__device__ __forceinline__ int block_excl_scan(int v, int& total, LAS int* wtot, int lane, int wave) {
    int inc = v;
#pragma unroll
    for (int o = 1; o < 64; o <<= 1) { const int t = __shfl_up(inc, o); if (lane >= o) inc += t; }
    __syncthreads();
    if (lane == 63) wtot[wave] = inc;
    __syncthreads();
    int off = 0, tot = 0;
#pragma unroll
    for (int w = 0; w < NWAVES; ++w) { const int t = wtot[w]; if (w < wave) off += t; tot += t; }
    total = tot; return off + inc - v;
}
__device__ __forceinline__ void moe_topk(const Args& a, LAS unsigned char* lds, int tid, int lane, int wave, int bid, int G) {
    LAS unsigned* vals = (LAS unsigned*)lds;
    LAS int* hist = (LAS int*)(lds + 69632); LAS int* misc = hist + 4096; LAS int* wtot = misc + 8; LAS int* wtot2 = wtot + 8;
    const float* aff = (const float*)(a.ws + WS_AFF); int* idx = (int*)(a.ws + WS_IDX); float* gate = (float*)(a.ws + WS_GATE); int* slot_of = (int*)(a.ws + WS_SLOT);
    for (int be = bid; be < NB * NE; be += G) {
        __syncthreads();
        for (int i = tid; i < T; i += NTHR) vals[i + (i >> 5)] = __builtin_bit_cast(unsigned, aff[(size_t)be * T + i]) << 2;
        unsigned p0 = 0u, p1 = 0u, p2 = 0u; int kr = CAP;
#pragma unroll 1
        for (int pass = 0; pass < 3; ++pass) {
            const int nb = (pass == 2) ? 256 : 4096;
            for (int i = tid; i < nb; i += NTHR) hist[i] = 0;
            __syncthreads();
            for (int i = tid; i < T; i += NTHR) { const unsigned v = vals[i + (i >> 5)]; unsigned dgt; bool m;
                if (pass == 0) { dgt = v >> 20; m = true; } else if (pass == 1) { dgt = (v >> 8) & 4095u; m = (v >> 20) == p0; } else { dgt = v & 255u; m = (v >> 8) == ((p0 << 12) | p1); }
                if (m) __hip_atomic_fetch_add(&hist[dgt], 1, __ATOMIC_RELAXED, __HIP_MEMORY_SCOPE_WORKGROUP); }
            __syncthreads();
            int c8[8], s = 0; const bool own = 8 * tid < nb;
#pragma unroll
            for (int j = 0; j < 8; ++j) { c8[j] = own ? hist[nb - 1 - (8 * tid + j)] : 0; s += c8[j]; }
            int tot; const int ex = block_excl_scan(s, tot, wtot, lane, wave);
            if (own && ex < kr && kr <= ex + s) { int cum = ex;
#pragma unroll
                for (int j = 0; j < 8; ++j) { if (cum < kr && kr <= cum + c8[j]) { misc[0] = nb - 1 - (8 * tid + j); misc[1] = kr - cum; } cum += c8[j]; } }
            __syncthreads();
            const unsigned dsel = (unsigned)misc[0]; kr = misc[1];
            if (pass == 0) p0 = dsel; else if (pass == 1) p1 = dsel; else p2 = dsel;
            __syncthreads();
        }
        const unsigned thr = (p0 << 20) | (p1 << 8) | p2;
        int cg = 0, ce = 0;
#pragma unroll 8
        for (int i = 0; i < 32; ++i) { const unsigned v = vals[33 * tid + i]; cg += (v > thr); ce += (v == thr); }
        int ngt, neq; const int pg0 = block_excl_scan(cg, ngt, wtot, lane, wave); const int pe0 = block_excl_scan(ce, neq, wtot2, lane, wave);
        int pg = pg0, pe = pe0;
#pragma unroll 8
        for (int i = 0; i < 32; ++i) { const int t = 32 * tid + i; const unsigned v = vals[33 * tid + i]; int slot = -1;
            if (v > thr) slot = pg++; else if (v == thr) { if (pe < kr) slot = ngt + pe; ++pe; }
            slot_of[(size_t)be * T + t] = slot;
            if (slot >= 0) { idx[be * CAP + slot] = t; gate[be * CAP + slot] = __builtin_bit_cast(float, v >> 2); } }
    }
}
__device__ __forceinline__ void moe_gather(const Args& a, int lane, int wave, int bid, int G) {
    const int gw = bid * NWAVES + wave, NGW = G * NWAVES; const bf16* h1 = (const bf16*)(a.ws + WS_H); bf16* xs = (bf16*)(a.ws + WS_PX); const int* idx = (const int*)(a.ws + WS_IDX);
    for (int r = gw; r < NSLOT; r += NGW) { const int b = r >> 15; const int t = idx[r];
        const v4u* src = (const v4u*)(h1 + ((size_t)b * T + t) * D) + lane; v4u* dst = (v4u*)(xs + (size_t)r * D) + lane;
        v4u v0 = src[0], v1 = src[64], v2 = src[128], v3 = src[192]; dst[0] = v0; dst[64] = v1; dst[128] = v2; dst[192] = v3; }
}
template <int MODE>
__device__ __forceinline__ void moe_combine(const Args& a, int l, bf16* xio, int lane, int wave, int bid, int G) {
    const int gw = bid * NWAVES + wave, NGW = G * NWAVES; const bf16* y = (const bf16*)(a.ws + WS_PX); const int* slot_of = (const int*)(a.ws + WS_SLOT); bf16* hx = (bf16*)(a.ws + WS_H);
    f32x4 A[8], B[8], GT[8];
    for (int ch = gw; ch < M / 16; ch += NGW) {
        const int b = ch / (T / 16);
        if (MODE == 0) load_coef(a.in[I_NMIX] + D, modp(a.ws, 1, b, 1), modp(a.ws, 1, b, 0), lane, A, B);
        else {
#pragma unroll
            for (int j = 0; j < 8; ++j) A[j] = *(const f32x4*)(a.in[I_NFIN] + 4 * lane + 256 * j); }
#pragma unroll
        for (int j = 0; j < 8; ++j) GT[j] = *(const f32x4*)(modp(a.ws, l, b, 5) + 4 * lane + 256 * j);
        const int t0 = (int)(((size_t)ch * 16) & (T - 1)); const int* sp = slot_of + ((size_t)(b * 16 + (lane & 15))) * T + t0 + (lane >> 4);
        int slq = sp[0];
#pragma unroll 1
        for (int q = 0; q < 4; ++q) { const int cur = slq; if (q < 3) slq = sp[4 * (q + 1)];
            const unsigned long long bal = __ballot(cur >= 0);
#pragma unroll
            for (int rs = 0; rs < 4; ++rs) { const size_t row = (size_t)ch * 16 + 4 * q + rs;
                unsigned m = (unsigned)(bal >> (16 * rs)) & 0xffffu;
                const v2u* xp = (const v2u*)(xio + row * D) + lane; v2u xr[8];
#pragma unroll
                for (int j = 0; j < 8; ++j) xr[j] = xp[64 * j];
                f32x4 v[8]; bool first = true;
                do { const v2u* yp[4]; float wg[4]; v2u yv[4][8];
#pragma unroll
                    for (int k = 0; k < 4; ++k) { const bool ok = (m != 0u); const int ee = ok ? __builtin_ctz(m) : 0; m = ok ? (m & (m - 1u)) : 0u; const int s = __builtin_amdgcn_readlane(cur, 16 * rs + ee);
                        yp[k] = ok ? ((const v2u*)(y + ((size_t)(b * 16 + ee) * CAP + s) * D) + lane) : xp; wg[k] = ok ? 1.f : 0.f; }
#pragma unroll
                    for (int k = 0; k < 4; ++k)
#pragma unroll
                        for (int j = 0; j < 8; ++j) yv[k][j] = yp[k][64 * j];
                    if (first) {
#pragma unroll
                        for (int j = 0; j < 8; ++j) v[j] = (f32x4){bflo(xr[j].x), bfhi(xr[j].x), bflo(xr[j].y), bfhi(xr[j].y)};
                        first = false; }
#pragma unroll
                    for (int k = 0; k < 4; ++k)
#pragma unroll
                        for (int j = 0; j < 8; ++j) { const v2u w = yv[k][j]; v[j] += (f32x4){bflo(w.x), bfhi(w.x), bflo(w.y), bfhi(w.y)} * (GT[j] * wg[k]); }
                } while (m != 0u);
                const float rstd = row_rstd(v);
                if (MODE == 0) {
                    store_row_bf16(xio + row * D, v, lane);
#pragma unroll
                    for (int j = 0; j < 8; ++j) v[j] = v[j] * rstd * A[j] + B[j];
                    store_row_bf16(hx + row * D, v, lane);
                } else { f32x4* xr2 = (f32x4*)(a.out + row * D) + lane;
#pragma unroll
                    for (int j = 0; j < 8; ++j) xr2[64 * j] = v[j] * rstd * A[j];
                } } }
    }
}
template <int HALF, int RPT>
__device__ __forceinline__ void pool_rows(const bf16* hx, bf16* pooled, int g, int cg, int row0) {
    constexpr int NR = RPT + 2 * HALF;
    const int t0 = row0 & (T - 1), rowb = row0 - t0;
    v4u x[NR];
#pragma unroll
    for (int j = 0; j < NR; ++j) { const int u = t0 - HALF + j; const bool ok = (u >= 0) && (u < T);
        x[j] = *(const v4u*)(hx + (size_t)(rowb + (ok ? u : t0)) * D + 8 * cg); if (!ok) x[j] = (v4u){0u, 0u, 0u, 0u}; }
    float S[8];
#pragma unroll
    for (int i = 0; i < 8; ++i) S[i] = 0.f;
#pragma unroll
    for (int j = 0; j < 2 * HALF; ++j)
#pragma unroll
        for (int w = 0; w < 4; ++w) { S[2 * w] += bflo(x[j][w]); S[2 * w + 1] += bfhi(x[j][w]); }
#pragma unroll
    for (int r = 0; r < RPT; ++r) { const int t = t0 + r, lo = (t - HALF) > 0 ? (t - HALF) : 0, hi = (t + HALF) < T ? (t + HALF) : T; const float inv = 1.f / (float)(hi - lo);
        const v4u xc = x[r + HALF]; v4u o;
#pragma unroll
        for (int w = 0; w < 4; ++w) o[w] = pk2(S[2 * w] * inv - bflo(xc[w]), S[2 * w + 1] * inv - bfhi(xc[w]));
        *(v4u*)(pooled + ((size_t)g * M + row0 + r) * 512 + (8 * cg - 512 * g)) = o;
        if (r < RPT - 1) {
#pragma unroll
            for (int w = 0; w < 4; ++w) { S[2 * w] += bflo(x[r + 2 * HALF][w]) - bflo(x[r][w]); S[2 * w + 1] += bfhi(x[r + 2 * HALF][w]) - bfhi(x[r][w]); } }
        __builtin_amdgcn_sched_barrier(0); }
}
__device__ __forceinline__ void pool_phase(const Args& a, int tid, int bid, int G) {
    const bf16* hx = (const bf16*)(a.ws + WS_H); bf16* pooled = (bf16*)(a.ws + WS_MIX);
    const int cg = tid & 255, rsel = __builtin_amdgcn_readfirstlane(tid >> 8), g = __builtin_amdgcn_readfirstlane(cg >> 6);
    for (int chunk = bid; chunk < M / 32; chunk += G) { const int row0 = chunk * 32 + rsel * 16;
        if (g == 0) pool_rows<1, 16>(hx, pooled, 0, cg, row0); else if (g == 1) pool_rows<2, 16>(hx, pooled, 1, cg, row0); else if (g == 2) pool_rows<4, 16>(hx, pooled, 2, cg, row0);
        else { pool_rows<8, 8>(hx, pooled, 3, cg, row0); pool_rows<8, 8>(hx, pooled, 3, cg, row0 + 8); } }
}


constexpr int N_PHASES = 22;
template <int LO, int HI>
__global__ void __launch_bounds__(NTHR, 2) mega_fwd(Args args) {
    extern __shared__ __attribute__((aligned(16))) unsigned char lds_raw[];
    LAS unsigned char* lds = (LAS unsigned char*)lds_raw;
    const int tid = threadIdx.x, lane = tid & 63, wave = __builtin_amdgcn_readfirstlane(tid >> 6), bid = blockIdx.x, G = gridDim.x;
    unsigned char* ws = args.ws;
    for (int u = tid; u < (LDS_BYTES - LDSCTL_OFF) / 4; u += NTHR) ((LAS unsigned*)(lds + LDSCTL_OFF))[u] = 0u;
    __syncthreads();
    XcdBarrier bar = xcd_barrier_post((unsigned*)(ws + WS_CTL) + CW_BAR, (volatile LAS unsigned*)(lds + MISC_OFF) + 8);
#ifndef PH_EN
#define PH_EN 0xffffffffu
#endif
#define IN(k) (((PH_EN >> ((k) > 15 ? (k) - 8 : (k))) & 1u) && LO <= (k) && (k) < HI)
#define REP(k) ((REP_MASK >> (k)) & 1u)
#define SEAM(k) do { if (IN(k) && IN((k) + 1)) xcd_barrier(bar); } while (0)
    const KArgP kap0 = (KArgP)__builtin_amdgcn_kernarg_segment_ptr();
#define PH_BEGIN KArgP kap_ = kap0; asm volatile("; PHASE_BEGIN line %1" : "+s"(kap_) : "n"(__LINE__)); const Args& A_ = *(const Args*)kap_; int tid_ = tid; asm volatile("" : "+v"(tid_)); \
    const int lane_ = tid_ & 63, wave_ = __builtin_amdgcn_readfirstlane(tid_ >> 6); unsigned char* const ws_ = A_.ws; (void)lane_; (void)wave_; (void)ws_;

    if (IN(0)) { PH_BEGIN p0_prologue(A_, lds, tid_, lane_, wave_, bid, G); } if (REP(0) && IN(0)) { xcd_barrier(bar); { PH_BEGIN p0_prologue(A_, lds, tid_, lane_, wave_, bid, G); } } SEAM(0);
    if (IN(1)) { PH_BEGIN p1_norm0(A_, lane_, wave_, bid, G); } if (REP(1) && IN(1)) { xcd_barrier(bar); { PH_BEGIN p1_norm0(A_, lane_, wave_, bid, G); } } SEAM(1);
    if (IN(2)) { _Pragma("unroll") for (int rep_ = 0; rep_ < (REP(2) ? 2 : 1); ++rep_) { if (rep_) xcd_barrier(bar);
        PH_BEGIN
        pg8::Gemm g{(const bf16*)(ws_ + WS_H), (const bf16*)(ws_ + WS_WIN), MT, NPAD, D}; pg8::StaticOrder S; S.init(MT, NPAD, G, bid);
        pg8::EpiStoreBf16 E{(bf16*)(ws_ + WS_PX), NPAD};
        pg8::gemm_phase<pg8::EpiStoreBf16, pg8::StaticOrder, true, true>(lds, g, S, E, tid_);
        { PH_BEGIN const int tb = conv_tail_blocks(G); if (tb && bid >= tb) { asm volatile("s_waitcnt vmcnt(0)" ::: "memory"); __syncthreads(); conv_experts(A_, 0, lds, lane_, wave_, bid - tb, G - tb, 0, conv_tail_items(G)); conv_experts(A_, 1, lds, lane_, wave_, bid - tb, G - tb, 0, conv_tail_items(G)); } }
    } } SEAM(2);
    if (IN(3)) { PH_BEGIN if ((bid >> 3) & 1) lerp_phase(A_, tid_, bid, G); p3_attention(A_, lds, tid_, lane_, wave_, bid, G); if (!((bid >> 3) & 1)) lerp_phase(A_, tid_, bid, G); }        if (REP(3) && IN(3)) { xcd_barrier(bar); { PH_BEGIN p3_attention(A_, lds, tid_, lane_, wave_, bid, G); lerp_phase(A_, tid_, bid, G); } } SEAM(3);
    if (IN(4)) { PH_BEGIN p4_rwkv_passA(kap_, lds, lane_, wave_, bid, G); } if (REP(4) && IN(4)) { xcd_barrier(bar); { PH_BEGIN p4_rwkv_passA(kap_, lds, lane_, wave_, bid, G); } } SEAM(4);
    if (IN(5)) { PH_BEGIN p5_rwkv_passC(kap_, lds, lane_, wave_, bid, G); } if (REP(5) && IN(5)) { xcd_barrier(bar); { PH_BEGIN p5_rwkv_passC(kap_, lds, lane_, wave_, bid, G); } } SEAM(5);
    if (IN(6)) { PH_BEGIN p5_rwkv_finish(A_, lds, tid_, lane_, wave_, bid, G); } if (REP(6) && IN(6)) { xcd_barrier(bar); { PH_BEGIN p5_rwkv_finish(A_, lds, tid_, lane_, wave_, bid, G); } } SEAM(6);
    if (IN(7)) { _Pragma("unroll") for (int rep_ = 0; rep_ < (REP(7) ? 2 : 1); ++rep_) { if (rep_) xcd_barrier(bar);
        PH_BEGIN
        pg8::Gemm g{(const bf16*)(ws_ + WS_MIX), (const bf16*)(ws_ + WS_WOUT), M, D, D}; pg8::StaticOrder S; S.init(M, D, G, bid);
        pg8::EpiResBf16<true> E{A_.in[I_X], (bf16*)(ws_ + WS_YD), D, modp(ws_, 0, 0, 2), modp(ws_, 0, 1, 2), nullptr, T, 0x7fffffff};
        pg8::gemm_phase<pg8::EpiResBf16<true>, pg8::StaticOrder, true, true>(lds, g, S, E, tid_);
    } } SEAM(7);
#define LAYER_PHASES(l) do { \
        const int pb = 8 + 8 * l; \
        if (IN(pb + 0)) { PH_BEGIN moe_norm_router(A_, l, (const bf16*)(ws_ + WS_YD), lds, tid_, lane_, wave_, bid, G); } if (REP(pb + 0) && IN(pb + 0)) { xcd_barrier(bar); { PH_BEGIN moe_norm_router(A_, l, (const bf16*)(ws_ + WS_YD), lds, tid_, lane_, wave_, bid, G); } } SEAM(pb + 0); \
        if (IN(pb + 1)) { PH_BEGIN if (G > 32 && bid >= 32) conv_experts(A_, l, lds, lane_, wave_, bid - 32, G - 32, conv_tail_items(G), CONV_NIT); else { moe_topk(A_, lds, tid_, lane_, wave_, bid, G); if (G <= 32) conv_experts(A_, l, lds, lane_, wave_, bid, G, conv_tail_items(G), CONV_NIT); } } if (REP(pb + 1) && IN(pb + 1)) { xcd_barrier(bar); { PH_BEGIN if (G > 32 && bid >= 32) conv_experts(A_, l, lds, lane_, wave_, bid - 32, G - 32, conv_tail_items(G), CONV_NIT); else { moe_topk(A_, lds, tid_, lane_, wave_, bid, G); if (G <= 32) conv_experts(A_, l, lds, lane_, wave_, bid, G, conv_tail_items(G), CONV_NIT); } } } SEAM(pb + 1); \
        if (IN(pb + 3)) { _Pragma("unroll") for (int rep_ = 0; rep_ < (REP(pb + 3) ? 2 : 1); ++rep_) { if (rep_) xcd_barrier(bar); \
            PH_BEGIN \
            pg8::Gemm g{(const bf16*)(ws_ + WS_H), (const bf16*)(ws_ + WS_WGU) + (size_t)l * 16 * 2048 * 2048, NSLOT, 2048, D, (const int*)(ws_ + WS_IDX), 15, T}; pg8::ExpertOrder S{G, bid}; \
            pg8::EpiSwiglu E{(bf16*)(ws_ + WS_MIX), FF}; \
            pg8::gemm_phase<pg8::EpiSwiglu, pg8::ExpertOrder, true, true, true>(lds, g, S, E, tid_); \
        } } SEAM(pb + 3); \
        if (IN(pb + 4)) { _Pragma("unroll") for (int rep_ = 0; rep_ < (REP(pb + 4) ? 2 : 1); ++rep_) { if (rep_) xcd_barrier(bar); \
            PH_BEGIN \
            pg8::Gemm g{(const bf16*)(ws_ + WS_MIX), (const bf16*)(ws_ + WS_WD) + (size_t)l * 16 * 2048 * 1024, NSLOT, 2048, FF}; pg8::ExpertOrder S{G, bid}; \
            pg8::EpiRowScaleBf16 E{(bf16*)(ws_ + WS_PX), D, (const float*)(ws_ + WS_GATE)}; \
            pg8::gemm_phase<pg8::EpiRowScaleBf16, pg8::ExpertOrder, true, true>(lds, g, S, E, tid_); \
        } } SEAM(pb + 4); \
        if (l == 0) { \
            if (IN(pb + 5)) { PH_BEGIN moe_combine<0>(A_, 0, (bf16*)(ws_ + WS_YD), lane_, wave_, bid, G); } if (REP(pb + 5) && IN(pb + 5)) { xcd_barrier(bar); { PH_BEGIN moe_combine<0>(A_, 0, (bf16*)(ws_ + WS_YD), lane_, wave_, bid, G); } } SEAM(pb + 5); \
            if (IN(pb + 6)) { PH_BEGIN pool_phase(A_, tid_, bid, G); } if (REP(pb + 6) && IN(pb + 6)) { xcd_barrier(bar); { PH_BEGIN pool_phase(A_, tid_, bid, G); } } SEAM(pb + 6); \
            if (IN(pb + 7)) { _Pragma("unroll") for (int rep_ = 0; rep_ < (REP(pb + 7) ? 2 : 1); ++rep_) { if (rep_) xcd_barrier(bar); \
                PH_BEGIN \
                pg8::Gemm g{(const bf16*)(ws_ + WS_MIX), (const bf16*)(ws_ + WS_WPOOL), 4 * M, 512, 512}; pg8::PoolOrder S{G, bid}; \
                pg8::EpiResBf16<false> E{(const bf16*)(ws_ + WS_YD), (bf16*)(ws_ + WS_YD), D, modp(ws_, 1, 0, 2), modp(ws_, 1, 1, 2), A_.in[I_POOLS], T, 127}; \
                pg8::gemm_phase<pg8::EpiResBf16<false>, pg8::PoolOrder, true, true>(lds, g, S, E, tid_); \
            } } SEAM(pb + 7); \
        } else { \
            if (IN(pb + 5)) { PH_BEGIN moe_combine<1>(A_, 1, (bf16*)(ws_ + WS_YD), lane_, wave_, bid, G); } if (REP(pb + 5) && IN(pb + 5)) { xcd_barrier(bar); { PH_BEGIN moe_combine<1>(A_, 1, (bf16*)(ws_ + WS_YD), lane_, wave_, bid, G); } } \
        } \
    } while (0)
    LAYER_PHASES(0);
    LAYER_PHASES(1);
#undef LAYER_PHASES
#undef IN
#undef SEAM
#undef PH_BEGIN
}

template <int LO, int HI> static void launch_range(const Args& a, int grid, hipStream_t stream) {
    static bool attr = false;
    if (!attr) { (void)hipFuncSetAttribute((const void*)mega_fwd<LO, HI>, hipFuncAttributeMaxDynamicSharedMemorySize, LDS_BYTES); attr = true; }
    hipLaunchKernelGGL((mega_fwd<LO, HI>), dim3(grid), dim3(NTHR), LDS_BYTES, stream, a);
}
#if MK_SPLIT
template <int K> struct SplitLaunch { static void run(const Args& a, int grid, hipStream_t s) { SplitLaunch<K - 1>::run(a, grid, s); launch_range<K, K + 1>(a, grid, s); } };
template <> struct SplitLaunch<-1> { static void run(const Args&, int, hipStream_t) {} };
#endif
extern "C" void kernel_launch(void* const* d_in, const int* in_sizes, int n_in, void* d_out, int out_size, void* d_ws, size_t ws_size, hipStream_t stream) {
    static int grid = 0;
    if (grid == 0) {
        if (n_in != N_IN || out_size != M * D || ws_size < WS_END) { fprintf(stderr, "kernel_launch: unexpected shapes (n_in %d out %d ws %zu, need %zu)\n", n_in, out_size, ws_size, (size_t)WS_END); grid = -1; return; }
        int dev = 0, cus = 0;
        if (hipGetDevice(&dev) != hipSuccess || hipDeviceGetAttribute(&cus, hipDeviceAttributeMultiprocessorCount, dev) != hipSuccess) { grid = -1; return; }
        grid = cus;
    }
    if (grid < 0) return;
    (void)in_sizes;
    (void)hipMemsetAsync((char*)d_ws + WS_CTL, 0, CTL_ZERO_BYTES, stream);
    Args a{};
    for (int i = 0; i < N_IN; ++i) a.in[i] = (const float*)d_in[i];
    a.out = (float*)d_out; a.ws = (unsigned char*)d_ws; a.ph_lo = 0; a.ph_hi = N_PHASES;
#if MK_SPLIT
    SplitLaunch<N_PHASES - 1>::run(a, grid, stream);
#else
    launch_range<0, N_PHASES>(a, grid, stream);
#endif
    const hipError_t le = hipPeekAtLastError();
    if (le != hipSuccess) fprintf(stderr, "kernel_launch: launch failed: %s\n", hipGetErrorName(le));
}
```

```cpp
#include <hip/hip_runtime.h>
#include <cstdio>
#include <cstdint>

#ifndef MK_SPLIT
#define MK_SPLIT 0
#endif

#ifndef REP_MASK
#define REP_MASK 0u
#endif
namespace pg8 {
#define PG8_LAS __attribute__((address_space(3)))
typedef unsigned short bf16_t;
typedef short bf16x8 __attribute__((ext_vector_type(8)));
typedef float f32x4 __attribute__((ext_vector_type(4)));
typedef unsigned u32x4 __attribute__((ext_vector_type(4)));
constexpr int BM = 256, BK = 64, HALF = 128, HTB = HALF * BK * 2  , STAGE_BYTES = 8 * HTB, NXCD = 8, WGM = 8;

__host__ __device__ __forceinline__ int lds_byte(int r, int c) { const int st = (r >> 4) * 2 + (c >> 5), rr = r & 15, cc = c & 31, ob = rr * 64 + cc * 2; return st * 1024 + (ob ^ (((ob >> 9) & 1) << 5)); }
__host__ __device__ __forceinline__ void stage_rc(int b, int& R, int& C) { const int st = b / 1024, sb = b % 1024, swz = sb ^ (((sb >> 9) & 1) << 5); R = (st >> 1) * 16 + swz / 64; C = (st & 1) * 32 + (swz % 64) / 2; }
__host__ __device__ __forceinline__ int perm32(int rho) { const int n = rho >> 4, i = rho & 15; return 8 * (i >> 2) + 4 * n + (i & 3); }

struct Unit { int pm, pn; };
struct Gemm { const bf16_t* A; const bf16_t* Bt; int M, N, K; const int* rowmap; int rm_shift, rm_rows; };

struct StaticOrder {
    int nM, nN, nwg, G, c;
    __host__ __device__ void init(int M, int N, int G_, int c_) { nM = M / BM; nN = N / BM; nwg = nM * nN; G = G_; c = c_; }
    __host__ __device__ bool next(int i, Unit& u) const {
        const long L = (long)i * G + c; if (L >= nwg) return false;
        int wgid = (int)L; { const int q = nwg / NXCD, r = nwg % NXCD, xcd = wgid % NXCD, off = wgid / NXCD; wgid = (xcd < r ? xcd * (q + 1) : r * (q + 1) + (xcd - r) * q) + off; }
        const int nig = WGM * nN, gid = wgid / nig, fm = gid * WGM, gsz = (nM - fm) < WGM ? (nM - fm) : WGM;
        u.pm = fm + ((wgid % nig) % gsz); u.pn = (wgid % nig) / gsz; return true;
    }
    __device__ __forceinline__ void a_ready(const Unit&) const {}
    __device__ __forceinline__ void done(const Unit&) const {}
};

__device__ __forceinline__ unsigned cvt_pk_bf16(float lo, float hi) { unsigned r; asm volatile("v_cvt_pk_bf16_f32 %0, %1, %2" : "=v"(r) : "v"(lo), "v"(hi)); return r; }
typedef float f32x2 __attribute__((ext_vector_type(2)));

struct EpiStoreBf16 {
    static constexpr bool PERM = true, AFTER_DRAIN = false;
    bf16_t* O; int ldc;
    __device__ __forceinline__ void operator()(const f32x4 (&acc)[2][2][4][2], const Unit& u, int wr, int wc, int fr, int fq) const {
        const int row0 = u.pm * BM + wr * 64 + fr, col0 = u.pn * BM + wc * 32 + 8 * fq;
#pragma unroll
        for (int ai = 0; ai < 2; ++ai)
#pragma unroll
            for (int m = 0; m < 4; ++m) { bf16_t* rowp = O + (size_t)(row0 + ai * HALF + m * 16) * ldc + col0;
#pragma unroll
                for (int bj = 0; bj < 2; ++bj) { const f32x4 v0 = acc[ai][bj][m][0], v1 = acc[ai][bj][m][1];
                    u32x4 w; w.x = cvt_pk_bf16(v0[0], v0[1]); w.y = cvt_pk_bf16(v0[2], v0[3]); w.z = cvt_pk_bf16(v1[0], v1[1]); w.w = cvt_pk_bf16(v1[2], v1[3]);
                    *(u32x4*)(rowp + bj * HALF) = w; } }
    }
};
struct EpiResF32 {
    static constexpr bool PERM = false, AFTER_DRAIN = false;
    const float* res; float* out; int ldc; const float* gate0; const float* gate1; const float* scale; int rows_per_b; int pm_mask;
    __device__ __forceinline__ void operator()(const f32x4 (&acc)[2][2][4][2], const Unit& u, int wr, int wc, int fr, int fq) const {
        const int row0 = (u.pm & pm_mask) * BM + wr * 64 + fr, col0 = u.pn * BM + wc * 32 + 4 * fq;
        const float* gp = (row0 >= rows_per_b) ? gate1 : gate0;
        f32x4 gv[2][2];
#pragma unroll
        for (int bj = 0; bj < 2; ++bj)
#pragma unroll
            for (int n = 0; n < 2; ++n) { gv[bj][n] = *(const f32x4*)(gp + col0 + bj * HALF + 16 * n); if (scale) gv[bj][n] = gv[bj][n] * *(const f32x4*)(scale + col0 + bj * HALF + 16 * n); }
#pragma unroll
        for (int ai = 0; ai < 2; ++ai)
#pragma unroll
            for (int m = 0; m < 4; ++m) { const size_t ro = (size_t)(row0 + ai * HALF + m * 16) * ldc + col0;
#pragma unroll
                for (int bj = 0; bj < 2; ++bj)
#pragma unroll
                    for (int n = 0; n < 2; ++n) { const size_t o = ro + bj * HALF + 16 * n; const f32x4 r = *(const f32x4*)(res + o);
                        *(f32x4*)(out + o) = r + gv[bj][n] * acc[ai][bj][m][n]; } }
    }
};
template <bool RES_F32>
struct EpiResBf16 {
    static constexpr bool PERM = true, AFTER_DRAIN = false;
    const void* res; bf16_t* out; int ldc; const float* gate0; const float* gate1; const float* scale; int rows_per_b; int pm_mask;
    __device__ __forceinline__ void operator()(const f32x4 (&acc)[2][2][4][2], const Unit& u, int wr, int wc, int fr, int fq) const {
        const int row0 = (u.pm & pm_mask) * BM + wr * 64 + fr, col0 = u.pn * BM + wc * 32 + 8 * fq;
        const float* gp = (row0 >= rows_per_b) ? gate1 : gate0;
        f32x4 gv[2][2];
#pragma unroll
        for (int bj = 0; bj < 2; ++bj)
#pragma unroll
            for (int n = 0; n < 2; ++n) { gv[bj][n] = *(const f32x4*)(gp + col0 + bj * HALF + 4 * n); if (scale) gv[bj][n] = gv[bj][n] * *(const f32x4*)(scale + col0 + bj * HALF + 4 * n); }
#pragma unroll
        for (int ai = 0; ai < 2; ++ai) {
            f32x4 rf[4][2][2]; u32x4 rb[4][2];
#pragma unroll
            for (int m = 0; m < 4; ++m)
#pragma unroll
                for (int bj = 0; bj < 2; ++bj) { const size_t o = (size_t)(row0 + ai * HALF + m * 16) * ldc + col0 + bj * HALF;
                    if (RES_F32) { rf[m][bj][0] = *(const f32x4*)((const float*)res + o); rf[m][bj][1] = *(const f32x4*)((const float*)res + o + 4); }
                    else rb[m][bj] = *(const u32x4*)((const bf16_t*)res + o); }
#pragma unroll
            for (int m = 0; m < 4; ++m)
#pragma unroll
                for (int bj = 0; bj < 2; ++bj) { const size_t o = (size_t)(row0 + ai * HALF + m * 16) * ldc + col0 + bj * HALF; f32x4 r0, r1;
                    if (RES_F32) { r0 = rf[m][bj][0]; r1 = rf[m][bj][1]; }
                    else { const u32x4 w = rb[m][bj];
                        r0 = (f32x4){__builtin_bit_cast(float, w.x << 16), __builtin_bit_cast(float, w.x & 0xffff0000u), __builtin_bit_cast(float, w.y << 16), __builtin_bit_cast(float, w.y & 0xffff0000u)};
                        r1 = (f32x4){__builtin_bit_cast(float, w.z << 16), __builtin_bit_cast(float, w.z & 0xffff0000u), __builtin_bit_cast(float, w.w << 16), __builtin_bit_cast(float, w.w & 0xffff0000u)}; }
                    const f32x4 v0 = r0 + gv[bj][0] * acc[ai][bj][m][0], v1 = r1 + gv[bj][1] * acc[ai][bj][m][1];
                    u32x4 w; w.x = cvt_pk_bf16(v0[0], v0[1]); w.y = cvt_pk_bf16(v0[2], v0[3]); w.z = cvt_pk_bf16(v1[0], v1[1]); w.w = cvt_pk_bf16(v1[2], v1[3]);
                    *(u32x4*)(out + o) = w; } }
    }
};
struct EpiSwiglu {
    static constexpr bool PERM = true, AFTER_DRAIN = false;
    bf16_t* O; int ldc;
    __device__ __forceinline__ void operator()(const f32x4 (&acc)[2][2][4][2], const Unit& u, int wr, int wc, int fr, int fq) const {
        const int row0 = u.pm * BM + wr * 64 + fr, col0 = (u.pn & 7) * 128 + wc * 32 + 8 * fq;
#pragma unroll
        for (int ai = 0; ai < 2; ++ai)
#pragma unroll
            for (int m = 0; m < 4; ++m) { bf16_t* rowp = O + (size_t)(row0 + ai * HALF + m * 16) * ldc + col0; float h[8];
#pragma unroll
                for (int n = 0; n < 2; ++n) { const f32x4 g = acc[ai][0][m][n], up = acc[ai][1][m][n];
#pragma unroll
                    for (int i = 0; i < 4; ++i) h[4 * n + i] = g[i] * __builtin_amdgcn_rcpf(1.f + __expf(-g[i])) * up[i]; }
                u32x4 w; w.x = cvt_pk_bf16(h[0], h[1]); w.y = cvt_pk_bf16(h[2], h[3]); w.z = cvt_pk_bf16(h[4], h[5]); w.w = cvt_pk_bf16(h[6], h[7]);
                *(u32x4*)rowp = w; }
    }
};
struct EpiRowScaleBf16 {
    static constexpr bool PERM = true, AFTER_DRAIN = false;
    bf16_t* O; int ldc; const float* rs;
    __device__ __forceinline__ void operator()(const f32x4 (&acc)[2][2][4][2], const Unit& u, int wr, int wc, int fr, int fq) const {
        const int row0 = u.pm * BM + wr * 64 + fr, col0 = (u.pn & 7) * BM + wc * 32 + 8 * fq;
        float sc[2][4];
#pragma unroll
        for (int ai = 0; ai < 2; ++ai)
#pragma unroll
            for (int m = 0; m < 4; ++m) sc[ai][m] = rs[row0 + ai * HALF + m * 16];
#pragma unroll
        for (int ai = 0; ai < 2; ++ai)
#pragma unroll
            for (int m = 0; m < 4; ++m) { const int row = row0 + ai * HALF + m * 16; const float s = sc[ai][m]; bf16_t* rowp = O + (size_t)row * ldc + col0;
#pragma unroll
                for (int bj = 0; bj < 2; ++bj) { const f32x4 v0 = acc[ai][bj][m][0] * s, v1 = acc[ai][bj][m][1] * s;
                    u32x4 w; w.x = cvt_pk_bf16(v0[0], v0[1]); w.y = cvt_pk_bf16(v0[2], v0[3]); w.z = cvt_pk_bf16(v1[0], v1[1]); w.w = cvt_pk_bf16(v1[2], v1[3]);
                    *(u32x4*)(rowp + bj * HALF) = w; } }
    }
};
struct ExpertOrder {
    int G, c;
    __device__ __forceinline__ bool next(int i, Unit& u) const {
        const long L = (long)i * G + c; if (L >= 2048) return false;
        const int r256 = (int)(L >> 8), w = (int)(L & 255), x = w & 7, j = w >> 3, grp = 4 * r256 + (x >> 1), e = grp >> 1, b = grp & 1;
        u.pm = (b * 16 + e) * 8 + 4 * (x & 1) + (j & 3); u.pn = e * 8 + (j >> 2); return true;
    }
    __device__ __forceinline__ void a_ready(const Unit&) const {}
    __device__ __forceinline__ void done(const Unit&) const {}
};
struct PoolOrder {
    int G, c;
    __device__ __forceinline__ bool next(int i, Unit& u) const {
        const long L = (long)i * G + c; if (L >= 1024) return false;
        const int g = (int)(L >> 8), w = (int)(L & 255);
        u.pm = g * 128 + (w & 127); u.pn = g * 2 + (w >> 7); return true;
    }
    __device__ __forceinline__ void a_ready(const Unit&) const {}
    __device__ __forceinline__ void done(const Unit&) const {}
};

template <class Epi, class Sched, bool ALIGN_EPI = false, bool SP2 = false, bool GATHER = false>
__device__ __forceinline__ void gemm_phase(PG8_LAS unsigned char* lds, const Gemm g, const Sched& S, const Epi& E, const int tid) {
    const int wid = __builtin_amdgcn_readfirstlane(tid >> 6), lane = tid & 63, wr = wid >> 2, wc = wid & 3, fr = lane & 15, fq = lane >> 4;
    const int K = g.K, nt = K / BK;
    unsigned voffA[2], voffB[2];
    int RA[2], CA[2];
#pragma unroll
    for (int i = 0; i < 2; ++i) { int R, C; stage_rc(tid * 16 + i * 8192, R, C); const int Rb = Epi::PERM ? ((R & ~31) + perm32(R & 31)) : R;
        voffA[i] = (unsigned)(R * K + C) * 2u; voffB[i] = (unsigned)(Rb * K + C) * 2u; RA[i] = R; CA[i] = C; }
    static_assert(!GATHER || SP2, "GATHER is written for the SP2 loop");
    unsigned vc[2][2] = {{0u, 0u}, {0u, 0u}}, vn[2][2] = {{0u, 0u}, {0u, 0u}};
#define PG8_GOFF(dst, u) do { _Pragma("unroll") for (int h_ = 0; h_ < 2; ++h_) _Pragma("unroll") for (int i_ = 0; i_ < 2; ++i_) { const int r_ = (u).pm * BM + h_ * HALF + RA[i_]; \
        dst[h_][i_] = (unsigned)(((r_ >> g.rm_shift) * g.rm_rows + g.rowmap[r_]) * K + CA[i_]) * 2u; } } while (0)
    const size_t kstep = (size_t)(BK * 2);
    const size_t hstep = (size_t)HALF * K * 2;
    const size_t tstep = 2 * hstep;
    const size_t hstepA = GATHER ? (size_t)0 : hstep, tstepA = GATHER ? (size_t)0 : tstep;
    const unsigned ldsw = (unsigned)wid * 1024u;
    const int aoff = lds_byte(wr * 64 + fr, fq * 8), boff = lds_byte(wc * 32 + fr, fq * 8);
#define PG8_SA(b, h) (((b) * 2 + (h)) * HTB)
#define PG8_SB(b, h) ((4 + (b) * 2 + (h)) * HTB)
#define PG8_STAGE(bufoff, gbase, voff) do { _Pragma("unroll") for (int _i = 0; _i < 2; ++_i) \
        __builtin_amdgcn_global_load_lds((const unsigned*)((const char*)(gbase) + (voff)[_i]), (PG8_LAS unsigned*)(lds + (bufoff) + ldsw + _i * 8192), 16, 0, 0); } while (0)
#define PG8_STAGE_A(bufoff, gbase, half, nx) do { if constexpr (GATHER) { const unsigned vv_[2] = {(nx) ? vn[half][0] : vc[half][0], (nx) ? vn[half][1] : vc[half][1]}; PG8_STAGE(bufoff, gbase, vv_); } else { PG8_STAGE(bufoff, gbase, voffA); } } while (0)
#define PG8_LDA(dst, b, h) do { _Pragma("unroll") for (int m = 0; m < 4; ++m) _Pragma("unroll") for (int k = 0; k < 2; ++k) dst[m][k] = *(const PG8_LAS bf16x8*)(lds + PG8_SA(b, h) + aoff + m * 2048 + k * 1024); } while (0)
#define PG8_LDB(dst, b, h) do { _Pragma("unroll") for (int n = 0; n < 2; ++n) _Pragma("unroll") for (int k = 0; k < 2; ++k) dst[n][k] = *(const PG8_LAS bf16x8*)(lds + PG8_SB(b, h) + boff + n * 2048 + k * 1024); } while (0)
#define PG8_MMA(ai, bj, At, Bt) do { __builtin_amdgcn_s_setprio(1); _Pragma("unroll") for (int m = 0; m < 4; ++m) _Pragma("unroll") for (int n = 0; n < 2; ++n) _Pragma("unroll") for (int k = 0; k < 2; ++k) \
        acc[ai][bj][m][n] = __builtin_amdgcn_mfma_f32_16x16x32_bf16(Bt[n][k], At[m][k], acc[ai][bj][m][n], 0, 0, 0); __builtin_amdgcn_s_setprio(0); } while (0)
#define PG8_WAIT_V(n) asm volatile("s_waitcnt vmcnt(" #n ")" ::: "memory")
#define PG8_WAIT_L(n) asm volatile("s_waitcnt lgkmcnt(" #n ")" ::: "memory")
#define PG8_BAR __builtin_amdgcn_s_barrier()
#define PG8_SCHED __builtin_amdgcn_sched_barrier(0)
    Unit cur, nxt; int ui = 0;
    if (!S.next(0, cur)) return;
    f32x4 acc[2][2][4][2];
#pragma unroll
    for (int a = 0; a < 2; ++a)
#pragma unroll
        for (int b = 0; b < 2; ++b)
#pragma unroll
            for (int m = 0; m < 4; ++m)
#pragma unroll
                for (int n = 0; n < 2; ++n) acc[a][b][m][n] = (f32x4){0.f, 0.f, 0.f, 0.f};
    bf16x8 At[4][2], B0[2][2], B1[2][2];
    const char* cA = (const char*)g.A + (size_t)cur.pm * tstepA; const char* cB = (const char*)g.Bt + (size_t)cur.pn * tstep;
    if constexpr (GATHER) PG8_GOFF(vc, cur);
    S.a_ready(cur);
    if constexpr (SP2) {
        PG8_STAGE(PG8_SB(0, 0), cB, voffB); PG8_STAGE(PG8_SB(0, 1), cB + hstep, voffB); PG8_STAGE_A(PG8_SA(0, 0), cA, 0, false); PG8_STAGE_A(PG8_SA(0, 1), cA + hstepA, 1, false);
        if (wr == 1) PG8_BAR;
        PG8_WAIT_V(2); PG8_BAR;
        PG8_STAGE(PG8_SB(1, 0), cB + kstep, voffB); PG8_STAGE_A(PG8_SA(1, 0), cA + kstep, 0, false); PG8_STAGE(PG8_SB(1, 1), cB + hstep + kstep, voffB);
        PG8_WAIT_V(6); PG8_BAR;
    } else {
        PG8_STAGE(PG8_SB(0, 0), cB, voffB); PG8_STAGE(PG8_SA(0, 0), cA, voffA); PG8_STAGE(PG8_SB(0, 1), cB + hstep, voffB); PG8_STAGE(PG8_SA(0, 1), cA + hstep, voffA);
        if (wr == 1) PG8_BAR;
        PG8_WAIT_V(4); PG8_BAR;
        PG8_STAGE(PG8_SB(1, 0), cB + kstep, voffB); PG8_STAGE(PG8_SA(1, 0), cA + kstep, voffA); PG8_STAGE(PG8_SB(1, 1), cB + hstep + kstep, voffB);
        PG8_WAIT_V(6); PG8_BAR;
    }
    for (;;) {
        const bool has_next = S.next(ui + 1, nxt);
        const char* nA = has_next ? (const char*)g.A + (size_t)nxt.pm * tstepA : cA;
        if constexpr (GATHER) { if (has_next) PG8_GOFF(vn, nxt); else { vn[0][0] = vc[0][0]; vn[0][1] = vc[0][1]; vn[1][0] = vc[1][0]; vn[1][1] = vc[1][1]; } } const char* nB = has_next ? (const char*)g.Bt + (size_t)nxt.pn * tstep : cB;
        for (int t = 0; t < nt; t += 2) {
            const bool last = (t == nt - 2);
            const char* a1 = cA + (size_t)(t + 1) * kstep;
            const char* a2 = last ? nA : cA + (size_t)(t + 2) * kstep; const char* b2 = last ? nB : cB + (size_t)(t + 2) * kstep;
            const char* a3 = a2 + kstep; const char* b3 = b2 + kstep;
            if (last && has_next) S.a_ready(nxt);
            if constexpr (SP2) {
            PG8_LDB(B0, 0, 0); PG8_LDB(B1, 0, 1); PG8_SCHED; PG8_LDA(At, 0, 0); PG8_STAGE_A(PG8_SA(1, 1), a1 + hstepA, 1, false);
            PG8_WAIT_V(8); PG8_WAIT_L(0); PG8_BAR; PG8_MMA(0, 0, At, B0); PG8_MMA(0, 1, At, B1); PG8_BAR; PG8_SCHED;
            PG8_LDA(At, 0, 1); PG8_STAGE(PG8_SB(0, 0), b2, voffB); PG8_STAGE(PG8_SB(0, 1), b2 + hstep, voffB); PG8_STAGE_A(PG8_SA(0, 0), a2, 0, last);
            PG8_WAIT_V(8); PG8_WAIT_L(0); PG8_BAR; PG8_MMA(1, 0, At, B0); PG8_MMA(1, 1, At, B1); PG8_BAR; PG8_SCHED;
            PG8_LDB(B0, 1, 0); PG8_LDB(B1, 1, 1); PG8_SCHED; PG8_LDA(At, 1, 0); PG8_STAGE_A(PG8_SA(0, 1), a2 + hstepA, 1, last);
            PG8_WAIT_V(8); PG8_WAIT_L(0); PG8_BAR; PG8_MMA(0, 0, At, B0); PG8_MMA(0, 1, At, B1); PG8_BAR; PG8_SCHED;
            PG8_LDA(At, 1, 1); PG8_STAGE(PG8_SB(1, 0), b3, voffB); PG8_STAGE(PG8_SB(1, 1), b3 + hstep, voffB); PG8_STAGE_A(PG8_SA(1, 0), a3, 0, last);
            PG8_WAIT_V(8); PG8_WAIT_L(0); PG8_BAR; PG8_MMA(1, 0, At, B0); PG8_MMA(1, 1, At, B1); PG8_BAR; PG8_SCHED;
            } else {
            PG8_LDB(B0, 0, 0); PG8_SCHED; PG8_LDA(At, 0, 0); PG8_STAGE(PG8_SA(1, 1), a1 + hstep, voffA);
            PG8_WAIT_L(8); PG8_BAR; PG8_WAIT_L(0); PG8_MMA(0, 0, At, B0); PG8_BAR; PG8_SCHED;
            PG8_LDB(B1, 0, 1); PG8_STAGE(PG8_SB(0, 0), b2, voffB);
            PG8_BAR; PG8_WAIT_L(0); PG8_MMA(0, 1, At, B1); PG8_BAR;
            PG8_LDA(At, 0, 1); PG8_STAGE(PG8_SA(0, 0), a2, voffA);
            PG8_BAR; PG8_WAIT_L(0); PG8_MMA(1, 0, At, B0); PG8_BAR; PG8_SCHED;
            PG8_STAGE(PG8_SB(0, 1), b2 + hstep, voffB);
            PG8_WAIT_V(6); PG8_BAR; PG8_MMA(1, 1, At, B1); PG8_BAR;
            PG8_LDB(B0, 1, 0); PG8_SCHED; PG8_LDA(At, 1, 0); PG8_STAGE(PG8_SA(0, 1), a2 + hstep, voffA);
            PG8_WAIT_L(8); PG8_BAR; PG8_WAIT_L(0); PG8_MMA(0, 0, At, B0); PG8_BAR; PG8_SCHED;
            PG8_LDB(B1, 1, 1); PG8_STAGE(PG8_SB(1, 0), b3, voffB);
            PG8_BAR; PG8_WAIT_L(0); PG8_MMA(0, 1, At, B1); PG8_BAR;
            PG8_LDA(At, 1, 1); PG8_STAGE(PG8_SA(1, 0), a3, voffA);
            PG8_BAR; PG8_WAIT_L(0); PG8_MMA(1, 0, At, B0); PG8_BAR; PG8_SCHED;
            PG8_STAGE(PG8_SB(1, 1), b3 + hstep, voffB);
            PG8_WAIT_V(6); PG8_BAR; PG8_MMA(1, 1, At, B1); PG8_BAR;
            }
        }
        if constexpr (ALIGN_EPI) { if (wr == 0) PG8_BAR; }
        if constexpr (!Epi::AFTER_DRAIN) { E(acc, cur, wr, wc, fr, fq); S.done(cur); }
        if (!has_next) break;
#pragma unroll
        for (int a = 0; a < 2; ++a)
#pragma unroll
            for (int b = 0; b < 2; ++b)
#pragma unroll
                for (int m = 0; m < 4; ++m)
#pragma unroll
                    for (int n = 0; n < 2; ++n) acc[a][b][m][n] = (f32x4){0.f, 0.f, 0.f, 0.f};
        cur = nxt; cA = nA; cB = nB; ++ui;
        if constexpr (GATHER) { vc[0][0] = vn[0][0]; vc[0][1] = vn[0][1]; vc[1][0] = vn[1][0]; vc[1][1] = vn[1][1]; }
        if constexpr (ALIGN_EPI) { if (wr == 1) PG8_BAR; }
    }
    PG8_WAIT_V(0);
    if constexpr (!ALIGN_EPI) { if (wr == 0) PG8_BAR; }
    PG8_BAR;
    if constexpr (Epi::AFTER_DRAIN) { E.fused(acc, cur, wr, wc, fr, fq, lds, wid, lane); S.done(cur); }
#undef PG8_SA
#undef PG8_SB
#undef PG8_STAGE
#undef PG8_STAGE_A
#undef PG8_GOFF
#undef PG8_LDA
#undef PG8_LDB
#undef PG8_MMA
#undef PG8_WAIT_V
#undef PG8_WAIT_L
#undef PG8_BAR
#undef PG8_SCHED
}
}

constexpr int D = 2048, NB = 2, T = 16384, M = NB * T, CL = 256, MC = NB * CL, MT = M + MC;
constexpr int NH = 16, HD = 64, RWW = 1024;
constexpr int NPAD = 5120;
constexpr int C_R = 0, C_K = 1024, C_V = 2048, C_WD = 3072, C_AD = 3200, C_GD = 3328, C_Q = 3488, C_AK = 4512, C_AV = 4768, IN_COLS = 5024;
constexpr int NE = 16, CAP = 2048, FF = 1024, NSLOT = NB * NE * CAP;
constexpr float NORM_EPS = 1e-6f, GN_EPS = 64e-5f;
constexpr int NWAVES = 8, NTHR = 512;

constexpr size_t MiB = 1u << 20;
constexpr size_t WS_CTL = 0, CTL_ZERO_BYTES = 64 * 1024;
constexpr size_t WS_MOD = 1 * MiB;
constexpr size_t WS_ROPE = 1 * MiB + 512 * 1024;
constexpr size_t WS_G2T = 11 * MiB;
constexpr size_t WS_W2T = 11 * MiB + 384 * 1024, WS_A2T = 11 * MiB + 640 * 1024;
constexpr size_t WS_AFF = 2 * MiB;
constexpr size_t WS_IDX = 4 * MiB, WS_GATE = 4 * MiB + 512 * 1024;
constexpr size_t WS_SLOT = 5 * MiB;
constexpr size_t WS_BS = 7 * MiB;
constexpr size_t WS_WIN = 12 * MiB;
constexpr size_t WS_WOUT = 32 * MiB;
constexpr size_t WS_WPOOL = 40 * MiB;
constexpr size_t WS_WGU = 42 * MiB;
constexpr size_t WS_WD = 298 * MiB;
constexpr size_t WS_H = 426 * MiB;
constexpr size_t WS_PX = 556 * MiB;
constexpr size_t WS_MIX = 881 * MiB;
constexpr size_t WS_YD = 1009 * MiB;
constexpr size_t WS_END = 1265 * MiB;
static_assert(WS_WIN + (size_t)NPAD * D * 2 <= WS_WOUT && WS_WGU + (size_t)2 * 16 * 2048 * 2048 * 2 <= WS_WD && WS_WD + (size_t)2 * 16 * 2048 * 1024 * 2 <= WS_H, "ws map 1");
static_assert(WS_H + (size_t)MT * D * 2 <= WS_PX && WS_PX + (size_t)MT * NPAD * 2 <= WS_MIX && WS_MIX + (size_t)M * D * 2 <= WS_YD && WS_YD + (size_t)2 * M * RWW * 4 <= WS_END, "ws map 2");
constexpr int CW_BAR = 4096;

constexpr int RING_BYTES = 131072, LDSCTL_OFF = 147456, MISC_OFF = LDSCTL_OFF + 320, LDS_BYTES = 147456 + 512;

#define GAS __attribute__((address_space(1)))
#define LAS __attribute__((address_space(3)))
typedef unsigned short bf16;
typedef unsigned v4u __attribute__((ext_vector_type(4)));
typedef unsigned v2u __attribute__((ext_vector_type(2)));
typedef float f32x4 __attribute__((ext_vector_type(4)));
typedef float f32x2 __attribute__((ext_vector_type(2)));
typedef float f32x16 __attribute__((ext_vector_type(16)));
typedef short bf16x8 __attribute__((ext_vector_type(8)));
typedef short s16x4 __attribute__((ext_vector_type(4)));
#define LDS_WAIT() asm volatile("s_waitcnt lgkmcnt(0)" ::: "memory")

__device__ __forceinline__ unsigned f2bf(float f) { unsigned u = __builtin_bit_cast(unsigned, f); return (u + 0x7fffu + ((u >> 16) & 1u)) >> 16; }
typedef __bf16 bf16x2_t __attribute__((ext_vector_type(2)));
__device__ __forceinline__ unsigned pk2(float lo, float hi) { const f32x2 v = {lo, hi}; return __builtin_bit_cast(unsigned, __builtin_convertvector(v, bf16x2_t)); }
__device__ __forceinline__ float bf2f(unsigned short u) { return __builtin_bit_cast(float, (unsigned)u << 16); }
__device__ __forceinline__ float bflo(unsigned w) { return __builtin_bit_cast(float, w << 16); }
__device__ __forceinline__ float bfhi(unsigned w) { return __builtin_bit_cast(float, w & 0xffff0000u); }
__device__ __forceinline__ float wave_sum(float v) {
#pragma unroll
    for (int o = 1; o < 64; o <<= 1) v += __shfl_xor(v, o);
    return v;
}
__device__ __forceinline__ float rdlane(float v, int l) { return __builtin_bit_cast(float, __builtin_amdgcn_readlane(__builtin_bit_cast(int, v), l)); }

#define XB_TMO      128
#define XB_XCNT(j)  (256  + 64 * (j))
#define XB_XSUB(j)  (1280 + 64 * (j))
#define XB_XGEN(j)  (2304 + 64 * (j))
#define XB_TOP      3328
#define XB_TOPGEN   3392
#define XCD_BAR_WORDS 3456
#define XB_SPIN_CAP (1u << 23)

__device__ __forceinline__ unsigned xb_ld(unsigned* p)              { return __hip_atomic_load(p, __ATOMIC_RELAXED, __HIP_MEMORY_SCOPE_AGENT); }
__device__ __forceinline__ unsigned xb_add(unsigned* p, unsigned v) { return __hip_atomic_fetch_add(p, v, __ATOMIC_RELAXED, __HIP_MEMORY_SCOPE_AGENT); }
__device__ __forceinline__ unsigned xb_xcc_id() { return (unsigned)__builtin_amdgcn_s_getreg((3 << 11) | 20) & 0xFu; }
#define XB_SPIN(cond, bar) do { unsigned _sp = 0; while (cond) { __builtin_amdgcn_s_sleep(1); \
    if ((++_sp & 255u) == 0u) { if (xb_ld(&(bar)[XB_TMO])) break; if (_sp > XB_SPIN_CAP) { atomicAdd(&(bar)[XB_TMO], 1u); break; } } } } while (0)

struct XcdBarrier {
    unsigned* bar; unsigned x;
    volatile LAS unsigned* st;
};

__device__ __forceinline__ XcdBarrier xcd_barrier_post(unsigned* bar, volatile LAS unsigned* st) {
    XcdBarrier b; b.bar = bar; b.x = xb_xcc_id(); b.st = st;
    if (threadIdx.x == 0) (void)xb_add(&bar[XB_XCNT(b.x)], 1u);
    return b;
}
__device__ __forceinline__ void xcd_barrier_complete(unsigned* bar, unsigned x, unsigned& nloc, unsigned& nx) {
    const unsigned G = gridDim.x * gridDim.y * gridDim.z;
    unsigned sum, cnt, mine, sp = 0u;
    for (;;) {
        sum = 0u; cnt = 0u; mine = 0u;
#pragma unroll
        for (unsigned j = 0; j < 16; ++j) { const unsigned c = xb_ld(&bar[XB_XCNT(j)]); sum += c; cnt += (c > 0u) ? 1u : 0u; mine = (j == x) ? c : mine; }
        if (sum == G) break;
        __builtin_amdgcn_s_sleep(1);
        if ((++sp & 255u) == 0u) { if (xb_ld(&bar[XB_TMO])) break; if (sp > XB_SPIN_CAP) { atomicAdd(&bar[XB_TMO], 1u); break; } }
    }
    nloc = mine > 0u ? mine : 1u; nx = cnt > 0u ? cnt : 1u;
}

__device__ __forceinline__ void xcd_barrier(const XcdBarrier& b) {
    asm volatile("s_waitcnt vmcnt(0)" ::: "memory");
    __syncthreads();
    if (threadIdx.x == 0) {
        unsigned* bar = b.bar;
        __builtin_amdgcn_s_waitcnt(0);
        unsigned nloc = b.st[0], nx = b.st[1];
        if (nloc == 0u) { xcd_barrier_complete(bar, b.x, nloc, nx); b.st[0] = nloc; b.st[1] = nx; }
        const unsigned old = xb_add(&bar[XB_XSUB(b.x)], 1u);
        const unsigned gen = old / nloc;
        if (old + 1u == (gen + 1u) * nloc) {
            __builtin_amdgcn_fence(__ATOMIC_RELEASE, "agent");
            asm volatile("s_waitcnt vmcnt(0)" ::: "memory");
            const unsigned og = xb_add(&bar[XB_TOP], 1u);
            const unsigned tg = og / nx;
            if (og + 1u == (tg + 1u) * nx) xb_add(&bar[XB_TOPGEN], 1u);
            else XB_SPIN(xb_ld(&bar[XB_TOPGEN]) == tg, bar);
            __builtin_amdgcn_fence(__ATOMIC_ACQUIRE, "agent");
            xb_add(&bar[XB_XGEN(b.x)], 1u);
            asm volatile("s_waitcnt vmcnt(0)" ::: "memory");
        } else {
            XB_SPIN(xb_ld(&bar[XB_XGEN(b.x)]) == gen, bar);
            __builtin_amdgcn_fence(__ATOMIC_ACQUIRE, "agent");
            asm volatile("s_waitcnt vmcnt(0)" ::: "memory");
        }
    }
    __syncthreads();
}

enum { I_X = 0, I_C, I_CTX, I_CCTX, I_ADAW, I_ADAB, I_NMIX, I_NFFN, I_WIN, I_MU, I_W0, I_W2, I_A0, I_A2, I_G2, I_KK, I_KA, I_RK, I_LNW, I_LNB, I_SINK, I_WOUT, I_POOLW, I_POOLS, I_ROUTER, I_EG, I_EU, I_ED, I_NFIN, N_IN };
struct Args { const float* in[N_IN]; float* out; unsigned char* ws; int ph_lo, ph_hi; };
static_assert(sizeof(Args) == N_IN * 8 + 24, "Args has no padding");
typedef __attribute__((address_space(4))) const Args* KArgP;

__device__ __forceinline__ f32x4 ld4bf(const bf16* p) { const v2u w = *(const v2u*)p; return (f32x4){bflo(w.x), bfhi(w.x), bflo(w.y), bfhi(w.y)}; }
__device__ __forceinline__ const float* modp(const unsigned char* ws, int l, int r, int chunk) { return (const float*)(ws + WS_MOD) + (size_t)((l * 3 + r) * 6 + chunk) * D; }

template <int MODE>
__device__ __forceinline__ void tr_item(const float* W, int ldw, int k0, int n0, bf16* WT, int ldt, int lane, LAS float* scr) {
    const int row8 = lane >> 3, c4 = lane & 7;
    f32x4 v[8];
#pragma unroll
    for (int i = 0; i < 8; ++i) v[i] = *(const f32x4*)(W + (size_t)(k0 + 8 * i + row8) * ldw + n0 + 4 * c4);
#pragma unroll
    for (int i = 0; i < 8; ++i) { LAS float* w = scr + (8 * i + row8) * 33 + 4 * c4; w[0] = v[i].x; w[1] = v[i].y; w[2] = v[i].z; w[3] = v[i].w; }
    LDS_WAIT(); asm volatile("" ::: "memory");
    const int c = lane & 7;
#pragma unroll
    for (int j = 0; j < 4; ++j) { const int n = (lane >> 3) + 8 * j; const LAS float* s = scr + (8 * c) * 33 + n;
        v4u o; o.x = pk2(s[0 * 33], s[1 * 33]); o.y = pk2(s[2 * 33], s[3 * 33]); o.z = pk2(s[4 * 33], s[5 * 33]); o.w = pk2(s[6 * 33], s[7 * 33]);
        const int ns = n0 + n; const int drow = (MODE == 0) ? ns : (256 * (ns >> 7) + (ns & 127) + (MODE == 2 ? 128 : 0));
        *(v4u*)(WT + (size_t)drow * ldt + k0 + 8 * c) = o; }
    LDS_WAIT(); asm volatile("" ::: "memory");
}

__device__ __forceinline__ void p0_prologue(const Args& a, LAS unsigned char* lds, int tid, int lane, int wave, int bid, int G) {
    unsigned char* ws = a.ws;
    {
        LAS float* sv = (LAS float*)lds;
        LAS float* red = (LAS float*)(lds + 3 * 2048 * 4);
        for (int i = tid; i < 3 * 2048; i += NTHR) { const int r = i >> 11, k = i & 2047; const float v = (r < 2) ? a.in[I_C][r * 2048 + k] : a.in[I_CCTX][k]; sv[i] = v / (1.f + __expf(-v)); }
        __syncthreads();
        for (int slab = bid; slab < 256; slab += G) {
            const int l = slab >> 7, col0 = (slab & 127) * 96;
            const int cg = tid % 24, kg = tid / 24;
            if (kg < 16) {
                f32x4 acc0 = {0.f, 0.f, 0.f, 0.f}, acc1 = acc0, acc2 = acc0;
                const float* wp = a.in[I_ADAW] + ((size_t)l * 2048 + kg * 128) * 12288 + col0 + 4 * cg;
#pragma unroll 16
                for (int k = 0; k < 128; ++k) { const f32x4 w = __builtin_nontemporal_load((const f32x4*)(wp + (size_t)k * 12288)); const int kk = kg * 128 + k;
                    acc0 += w * sv[kk]; acc1 += w * sv[2048 + kk]; acc2 += w * sv[4096 + kk]; }
                *(LAS f32x4*)(red + (kg * 3 + 0) * 96 + 4 * cg) = acc0; *(LAS f32x4*)(red + (kg * 3 + 1) * 96 + 4 * cg) = acc1; *(LAS f32x4*)(red + (kg * 3 + 2) * 96 + 4 * cg) = acc2;
            }
            __syncthreads();
            if (tid < 288) { const int r = tid / 96, ci = tid % 96; float s = a.in[I_ADAB][l * 12288 + col0 + ci];
#pragma unroll
                for (int k = 0; k < 16; ++k) s += red[(k * 3 + r) * 96 + ci];
                ((float*)(ws + WS_MOD))[(size_t)(l * 3 + r) * 12288 + col0 + ci] = s; }
            __syncthreads();
        }
    }
    {
        for (int i = bid * NTHR + tid; i < 320 * 16; i += G * NTHR) { const int pos = (i >> 4) < 256 ? (i >> 4) : (i >> 4) - 256, fi = i & 15;
            const double inv4[4] = {1.0, 0.5623413251903491, 0.31622776601683794, 0.1778279410038923};
            double inv = inv4[fi & 3]; const int q = fi >> 2; inv *= (q == 0 ? 1.0 : q == 1 ? 0.1 : q == 2 ? 0.01 : 0.001);
            const float angf = (float)pos * (float)inv;
            const double rev = (double)angf * 0.15915494309189535; const float fr = (float)(rev - __builtin_rint(rev));
            f32x2 cs; cs.x = __builtin_amdgcn_cosf(fr); cs.y = __builtin_amdgcn_sinf(fr);
            ((f32x2*)(ws + WS_ROPE))[i] = cs; }
    }
    for (int i = bid * NTHR + tid; i < 1024 * 160; i += G * NTHR) { const int k = i >> 10, ch = i & 1023;
        const int frag = ((ch >> 6) * 2 + ((ch >> 5) & 1)) * 10 + (k >> 4); ((bf16*)(ws + WS_G2T))[(frag * 64 + ((k >> 3) & 1) * 32 + (ch & 31)) * 8 + (k & 7)] = (bf16)f2bf(a.in[I_G2][i]); }
    for (int i = bid * NTHR + tid; i < 2 * 1024 * 64; i += G * NTHR) { const int dd = i >> 16, k = (i >> 10) & 63, c = i & 1023;
        const int frag = ((dd * 16 + (c >> 6)) * 2 + ((c >> 5) & 1)) * 4 + (k >> 4), o = (frag * 64 + ((k >> 3) & 1) * 32 + (c & 31)) * 8 + (k & 7);
        ((bf16*)(ws + WS_W2T))[o] = (bf16)f2bf(a.in[I_W2][(size_t)(dd * 64 + k) * RWW + c]); ((bf16*)(ws + WS_A2T))[o] = (bf16)f2bf(a.in[I_A2][(size_t)(dd * 64 + k) * RWW + c]); }
    { v4u* z = (v4u*)(ws + WS_WIN + (size_t)IN_COLS * D * 2); const int n16 = (NPAD - IN_COLS) * D * 2 / 16; for (int i = bid * NTHR + tid; i < n16; i += G * NTHR) z[i] = (v4u){0u, 0u, 0u, 0u}; }
    {
        LAS float* scr = (LAS float*)(lds + wave * 16384);
        const int gw = bid * NWAVES + wave, NGW = G * NWAVES;
        constexpr int I_IN = 32 * 157, I_OUT = 32 * 64, I_POOL = 4 * 128;
        constexpr int NITEMS = I_IN + I_OUT + I_POOL;
        const int row8 = lane >> 3, c4 = lane & 7;
#pragma unroll 1
        for (int it0 = gw; it0 < NITEMS; it0 += 4 * NGW) {
            const float* src[4]; bf16* dst[4]; int ldw[4], k0[4], n0[4], ldt[4]; f32x4 v[4][8];
#pragma unroll
            for (int u = 0; u < 4; ++u) { int r = it0 + u * NGW; if (r >= NITEMS) r = it0;
                if (r < I_IN) { src[u] = a.in[I_WIN]; ldw[u] = IN_COLS; k0[u] = 64 * (r / 157); n0[u] = 32 * (r % 157); dst[u] = (bf16*)(ws + WS_WIN); ldt[u] = D; }
                else if (r < I_IN + I_OUT) { r -= I_IN; src[u] = a.in[I_WOUT]; ldw[u] = D; k0[u] = 64 * (r / 64); n0[u] = 32 * (r % 64); dst[u] = (bf16*)(ws + WS_WOUT); ldt[u] = D; }
                else { r -= I_IN + I_OUT; const int g = r >> 7, rr = r & 127; src[u] = a.in[I_POOLW] + (size_t)g * 512 * 512; ldw[u] = 512; k0[u] = 64 * (rr / 16); n0[u] = 32 * (rr % 16); dst[u] = (bf16*)(ws + WS_WPOOL) + (size_t)g * 512 * 512; ldt[u] = 512; }
#pragma unroll
                for (int i = 0; i < 8; ++i) v[u][i] = *(const f32x4*)(src[u] + (size_t)(k0[u] + 8 * i + row8) * ldw[u] + n0[u] + 4 * c4); }
#pragma unroll
            for (int u = 0; u < 4; ++u) { if (it0 + u * NGW >= NITEMS) break;
#pragma unroll
                for (int i = 0; i < 8; ++i) { LAS float* w = scr + (8 * i + row8) * 33 + 4 * c4; w[0] = v[u][i].x; w[1] = v[u][i].y; w[2] = v[u][i].z; w[3] = v[u][i].w; }
                LDS_WAIT(); asm volatile("" ::: "memory");
#pragma unroll
                for (int j = 0; j < 4; ++j) { const int n = (lane >> 3) + 8 * j; const LAS float* s = scr + (8 * c4) * 33 + n;
                    v4u o; o.x = pk2(s[0 * 33], s[1 * 33]); o.y = pk2(s[2 * 33], s[3 * 33]); o.z = pk2(s[4 * 33], s[5 * 33]); o.w = pk2(s[6 * 33], s[7 * 33]);
                    *(v4u*)(dst[u] + (size_t)(n0[u] + n) * ldt[u] + k0[u] + 8 * c4) = o; }
                LDS_WAIT(); asm volatile("" ::: "memory"); }
        }
    }
}
struct TrDesc { const float* src; bf16* dst; int ldw, k0, n0, ldt, mode; };
__device__ __forceinline__ TrDesc conv_decode(const Args& a, int l, int it) {
    constexpr int I_GU = 16 * 2048; TrDesc d;
    if (it < I_GU) { const int le = l * 16 + (it >> 11), rem = it & 2047, mat = rem >> 10, rr = rem & 1023;
        d.src = (mat ? a.in[I_EU] : a.in[I_EG]) + (size_t)le * 2048 * 1024; d.dst = (bf16*)(a.ws + WS_WGU) + (size_t)le * 2048 * 2048; d.ldw = FF; d.k0 = 64 * (rr >> 5); d.n0 = 32 * (rr & 31); d.ldt = D; d.mode = 1 + mat; }
    else { const int r = it - I_GU, le = l * 16 + (r >> 10), rr = r & 1023;
        d.src = a.in[I_ED] + (size_t)le * 1024 * 2048; d.dst = (bf16*)(a.ws + WS_WD) + (size_t)le * 2048 * 1024; d.ldw = D; d.k0 = 64 * (rr >> 6); d.n0 = 32 * (rr & 63); d.ldt = FF; d.mode = 0; }
    return d;
}
constexpr int CONV_NIT = 16 * 2048 + 16 * 1024;
__device__ __forceinline__ int conv_tail_blocks(int G) { return ((MT / 256) * (NPAD / 256)) % G; }
__device__ __forceinline__ int conv_tail_items(int G) { const int tb = conv_tail_blocks(G); if (tb == 0) return 0; const int n = (G - tb) * NWAVES * 8; return n < CONV_NIT ? n : CONV_NIT; }
__device__ __forceinline__ void conv_experts(const Args& a, int l, LAS unsigned char* lds, int lane, int wave, int vb, int VG, int it_lo, int NIT) {
    LAS float* scr = (LAS float*)(lds + wave * 16384);
    constexpr int NB4 = 4; const int stride = VG * NWAVES, row8 = lane >> 3, c4 = lane & 7, c = lane & 7;
#pragma unroll 1
    for (int it0 = it_lo + vb * NWAVES + wave; it0 < NIT; it0 += NB4 * stride) {
        TrDesc d[NB4]; f32x4 v[NB4][8];
#pragma unroll
        for (int u = 0; u < NB4; ++u) { const int it = it0 + u * stride; d[u] = conv_decode(a, l, it < NIT ? it : it0);
#pragma unroll
            for (int i = 0; i < 8; ++i) v[u][i] = __builtin_nontemporal_load((const f32x4*)(d[u].src + (size_t)(d[u].k0 + 8 * i + row8) * d[u].ldw + d[u].n0 + 4 * c4)); }
#pragma unroll
        for (int u = 0; u < NB4; ++u) { if (it0 + u * stride >= NIT) break;
#pragma unroll
            for (int i = 0; i < 8; ++i) { LAS float* w = scr + (8 * i + row8) * 33 + 4 * c4; w[0] = v[u][i].x; w[1] = v[u][i].y; w[2] = v[u][i].z; w[3] = v[u][i].w; }
            LDS_WAIT(); asm volatile("" ::: "memory");
#pragma unroll
            for (int j = 0; j < 4; ++j) { const int n = (lane >> 3) + 8 * j; const LAS float* s = scr + (8 * c) * 33 + n;
                v4u o; o.x = pk2(s[0 * 33], s[1 * 33]); o.y = pk2(s[2 * 33], s[3 * 33]); o.z = pk2(s[4 * 33], s[5 * 33]); o.w = pk2(s[6 * 33], s[7 * 33]);
                const int ns = d[u].n0 + n; const int drow = (d[u].mode == 0) ? ns : (256 * (ns >> 7) + (ns & 127) + (d[u].mode == 2 ? 128 : 0));
                *(v4u*)(d[u].dst + (size_t)drow * d[u].ldt + d[u].k0 + 8 * c) = o; }
            LDS_WAIT(); asm volatile("" ::: "memory"); }
    }
}

__device__ __forceinline__ void load_coef(const float* g, const float* sc, const float* sh, int lane, f32x4 (&A)[8], f32x4 (&B)[8]) {
#pragma unroll
    for (int j = 0; j < 8; ++j) { const int col = 4 * lane + 256 * j; const f32x4 gv = *(const f32x4*)(g + col), sv = *(const f32x4*)(sc + col); A[j] = gv * (sv + 1.f); B[j] = *(const f32x4*)(sh + col); }
}
__device__ __forceinline__ float row_rstd(const f32x4 (&v)[8]) {
    float s = 0.f;
#pragma unroll
    for (int j = 0; j < 8; ++j) s += (v[j].x * v[j].x + v[j].y * v[j].y) + (v[j].z * v[j].z + v[j].w * v[j].w);
    return 1.f / sqrtf(wave_sum(s) * (1.f / D) + NORM_EPS);
}
__device__ __forceinline__ void load_row_bf16(const bf16* irow, f32x4 (&v)[8], int lane) {
    const v2u* p = (const v2u*)irow + lane;
#pragma unroll
    for (int j = 0; j < 8; ++j) { const v2u w = p[64 * j]; v[j] = (f32x4){bflo(w.x), bfhi(w.x), bflo(w.y), bfhi(w.y)}; }
}
__device__ __forceinline__ void store_row_bf16(bf16* orow, const f32x4 (&o)[8], int lane) {
    unsigned long long* o8 = (unsigned long long*)orow + lane;
#pragma unroll
    for (int j = 0; j < 8; ++j) o8[64 * j] = (unsigned long long)pk2(o[j].x, o[j].y) | ((unsigned long long)pk2(o[j].z, o[j].w) << 32);
}
__device__ __forceinline__ void p1_norm0(const Args& a, int lane, int wave, int bid, int G) {
    const int gw = bid * NWAVES + wave, NGW = G * NWAVES; bf16* h0 = (bf16*)(a.ws + WS_H);
    f32x4 A[8], B[8];
    for (int ch = gw; ch < M / 16; ch += NGW) {
        const int b = ch / (T / 16);
        load_coef(a.in[I_NMIX], modp(a.ws, 0, b, 1), modp(a.ws, 0, b, 0), lane, A, B);
        f32x4 nx[8];
        { const f32x4* xr = (const f32x4*)(a.in[I_X] + (size_t)ch * 16 * D) + lane;
#pragma unroll
          for (int j = 0; j < 8; ++j) nx[j] = xr[64 * j]; }
#pragma unroll 1
        for (int rr = 0; rr < 16; ++rr) { const size_t row = (size_t)ch * 16 + rr; f32x4 v[8];
#pragma unroll
            for (int j = 0; j < 8; ++j) v[j] = nx[j];
            if (rr + 1 < 16) { const f32x4* xr = (const f32x4*)(a.in[I_X] + (row + 1) * D) + lane;
#pragma unroll
                for (int j = 0; j < 8; ++j) nx[j] = xr[64 * j]; }
            const float rstd = row_rstd(v);
#pragma unroll
            for (int j = 0; j < 8; ++j) v[j] = v[j] * rstd * A[j] + B[j];
            store_row_bf16(h0 + row * D, v, lane); }
    }
    if (gw < MC) {
        load_coef(a.in[I_NMIX], modp(a.ws, 0, 2, 1), modp(a.ws, 0, 2, 0), lane, A, B);
        for (int r = gw; r < MC; r += NGW) { f32x4 v[8]; const f32x4* xr = (const f32x4*)(a.in[I_CTX] + (size_t)r * D) + lane;
#pragma unroll
            for (int j = 0; j < 8; ++j) v[j] = xr[64 * j];
            const float rstd = row_rstd(v);
#pragma unroll
            for (int j = 0; j < 8; ++j) v[j] = v[j] * rstd * A[j] + B[j];
            store_row_bf16(h0 + (size_t)(M + r) * D, v, lane); }
    }
}

__device__ __forceinline__ f32x16 mfma32(bf16x8 a, bf16x8 b, f32x16 c) { return __builtin_amdgcn_mfma_f32_32x32x16_bf16(a, b, c, 0, 0, 0); }
__device__ __forceinline__ void rope8(v4u& A_, v4u& B_, const f32x2* tb, float scale) {
#pragma unroll
    for (int w = 0; w < 4; ++w) { const float a0 = bflo(A_[w]), a1 = bfhi(A_[w]), b0 = bflo(B_[w]), b1 = bfhi(B_[w]); const f32x2 c0 = tb[2 * w], c1 = tb[2 * w + 1];
        A_[w] = pk2((a0 * c0.x - b0 * c0.y) * scale, (a1 * c1.x - b1 * c1.y) * scale); B_[w] = pk2((b0 * c0.x + a0 * c0.y) * scale, (b1 * c1.x + a1 * c1.y) * scale); }
}
__device__ __forceinline__ void p3_attention(const Args& a, LAS unsigned char* lds, int tid, int lane, int wave, int bid, int G) {
    constexpr float LOG2E = 1.4426950408889634f, QS = 0.125f * LOG2E;
    constexpr int KT_BYTES = 32 * 144, VT_PITCH = 192, VT_BYTES = 32 * VT_PITCH;
    const bf16* px = (const bf16*)(a.ws + WS_PX); bf16* mix = (bf16*)(a.ws + WS_MIX);
    const f32x2* tabR = (const f32x2*)(a.ws + WS_ROPE); const f32x2* tabC = tabR + 256 * 16;
    LAS unsigned char* Kl = lds; LAS unsigned char* Vl = lds + 4 * KT_BYTES;
    const int h = lane >> 5, l31 = lane & 31;
    for (int unit = bid; unit < 1024; unit += G) {
        const int b = unit >> 9, kvh = (unit >> 7) & 3, qb = unit & 127;
        const int qhead = kvh * 4 + (wave >> 1), q0w = qb * 128 + 64 * (wave & 1);
        bf16x8 qf[2][4];
#pragma unroll
        for (int qt = 0; qt < 2; ++qt) {
            const int qpos = q0w + 32 * qt + l31;
            const bf16* qp = px + (size_t)(b * T + qpos) * NPAD + C_Q + qhead * 64 + 8 * h;
            v4u raw[4];
#pragma unroll
            for (int s = 0; s < 4; ++s) raw[s] = *(const v4u*)(qp + 16 * s);
            rope8(raw[0], raw[1], tabR + (qpos >> 6) * 16 + 8 * h, QS);
            rope8(raw[2], raw[3], tabC + (qpos & 63) * 16 + 8 * h, QS);
#pragma unroll
            for (int s = 0; s < 4; ++s) qf[qt][s] = __builtin_bit_cast(bf16x8, raw[s]);
        }
        float mrun[2], lrun[2]; f32x16 O[2][2];
#pragma unroll
        for (int qt = 0; qt < 2; ++qt) { mrun[qt] = a.in[I_SINK][qhead] * LOG2E; lrun[qt] = 1.f;
#pragma unroll
            for (int dt = 0; dt < 2; ++dt)
#pragma unroll
                for (int r = 0; r < 16; ++r) O[qt][dt][r] = 0.f; }
        const int skk = tid >> 2, sp = tid & 3, sbase = 32 * (sp >> 1) + 8 * (sp & 1);
        v4u rka, rkb, rv0, rv1; bool rvalid, rctx; int rkp;
#define ATT_PREFETCH(grp_) do { const int gk_ = (grp_) * 128 + skk; rctx = gk_ < 256; rkp = qb * 128 - 128 + (gk_ - 256); rvalid = rctx || (rkp >= 0 && rkp < T); \
            const size_t row_ = rctx ? (size_t)(M + b * CL + gk_) : (size_t)(b * T + (rvalid ? rkp : 0)); const bf16* rp_ = px + row_ * NPAD; \
            rka = (v4u){0u, 0u, 0u, 0u}; rkb = rka; rv0 = rka; rv1 = rka; \
            if (rvalid) { rka = *(const v4u*)(rp_ + C_AK + kvh * 64 + sbase); rkb = *(const v4u*)(rp_ + C_AK + kvh * 64 + sbase + 16); rv0 = *(const v4u*)(rp_ + C_AV + kvh * 64 + 16 * sp); rv1 = *(const v4u*)(rp_ + C_AV + kvh * 64 + 16 * sp + 8); } } while (0)
        ATT_PREFETCH(0);
        for (int grp = 0; grp < 5; ++grp) {
            __syncthreads();
            {
                v4u ka = rka, kb = rkb;
                if (rvalid && !rctx) rope8(ka, kb, ((sp >> 1) ? tabC + (rkp & 63) * 16 : tabR + (rkp >> 6) * 16) + 8 * (sp & 1), 1.f);
                LAS unsigned char* kd = Kl + (skk >> 5) * KT_BYTES + (skk & 31) * 144;
                *(LAS v4u*)(kd + sbase * 2) = ka; *(LAS v4u*)(kd + (sbase + 16) * 2) = kb;
                { LAS unsigned char* vd = Vl + (skk >> 5) * VT_BYTES + (skk & 31) * VT_PITCH + sp * 32; *(LAS v4u*)vd = rv0; *(LAS v4u*)(vd + 16) = rv1; }
                if (grp + 1 < 5) ATT_PREFETCH(grp + 1);
            }
            __syncthreads();
#pragma unroll 1
            for (int tl = 0; tl < 4; ++tl) {
                const int tile = grp * 4 + tl; const bool isctx = tile < 8; const int k0 = qb * 128 - 128 + (tile - 8) * 32;
                bool need[2], interior[2];
#pragma unroll
                for (int qt = 0; qt < 2; ++qt) { const int q0 = q0w + 32 * qt;
                    need[qt] = isctx || (k0 + 31 >= q0 - 128 && k0 <= q0 + 31 + 128 && k0 + 31 >= 0 && k0 < T);
                    interior[qt] = isctx || (k0 >= q0 + 31 - 128 && k0 + 31 <= q0 + 128 && k0 >= 0 && k0 + 31 < T); }
                if (!(need[0] || need[1])) continue;
                bf16x8 kf[4], vf[2][2];
#pragma unroll
                for (int s = 0; s < 4; ++s) kf[s] = *(const LAS bf16x8*)(Kl + tl * KT_BYTES + l31 * 144 + (16 * s + 8 * h) * 2);
#pragma unroll
                for (int dt = 0; dt < 2; ++dt)
#pragma unroll
                    for (int sp = 0; sp < 2; ++sp) {
                        const LAS unsigned char* vp = Vl + tl * VT_BYTES + (16 * sp + 4 * h + ((lane & 15) >> 2)) * VT_PITCH + (32 * dt + 16 * ((lane >> 4) & 1) + 4 * (lane & 3)) * 2;
                        const s16x4 lo = __builtin_amdgcn_ds_read_tr16_b64_v4i16((LAS s16x4*)vp), hi = __builtin_amdgcn_ds_read_tr16_b64_v4i16((LAS s16x4*)(vp + 8 * VT_PITCH));
                        vf[dt][sp] = (bf16x8){lo.x, lo.y, lo.z, lo.w, hi.x, hi.y, hi.z, hi.w}; }
#pragma unroll
                for (int qt = 0; qt < 2; ++qt) {
                    if (!need[qt]) continue;
                    f32x16 s;
#pragma unroll
                    for (int r = 0; r < 16; ++r) s[r] = 0.f;
#pragma unroll
                    for (int st = 0; st < 4; ++st) s = mfma32(kf[st], qf[qt][st], s);
                    if (!interior[qt]) { const int qpos = q0w + 32 * qt + l31;
#pragma unroll
                        for (int r = 0; r < 16; ++r) { const int kp = k0 + (r & 3) + 8 * (r >> 2) + 4 * h, dl = kp - qpos; const bool ok = dl >= -128 && dl <= 128 && kp >= 0 && kp < T; s[r] = ok ? s[r] : -__builtin_inff(); } }
                    float mx = s[0];
#pragma unroll
                    for (int r = 1; r < 16; ++r) mx = fmaxf(mx, s[r]);
                    mx = fmaxf(mx, __shfl_xor(mx, 32));
                    const float mn = fmaxf(mrun[qt], mx), alpha = __builtin_amdgcn_exp2f(mrun[qt] - mn); mrun[qt] = mn;
                    float rs = 0.f;
#pragma unroll
                    for (int r = 0; r < 16; ++r) { s[r] = __builtin_amdgcn_exp2f(s[r] - mn); rs += s[r]; }
                    rs += __shfl_xor(rs, 32); lrun[qt] = lrun[qt] * alpha + rs;
                    if (__any(alpha != 1.f)) {
#pragma unroll
                    for (int dt = 0; dt < 2; ++dt)
#pragma unroll
                        for (int r = 0; r < 16; ++r) O[qt][dt][r] *= alpha; }
                    bf16x8 pf[2];
#pragma unroll
                    for (int sp = 0; sp < 2; ++sp) { v4u w;
#pragma unroll
                        for (int i = 0; i < 4; ++i) w[i] = pk2(s[8 * sp + 2 * i], s[8 * sp + 2 * i + 1]);
                        pf[sp] = __builtin_bit_cast(bf16x8, w); }
#pragma unroll
                    for (int dt = 0; dt < 2; ++dt)
#pragma unroll
                        for (int sp = 0; sp < 2; ++sp) O[qt][dt] = mfma32(vf[dt][sp], pf[sp], O[qt][dt]);
                }
            }
        }
#pragma unroll
        for (int qt = 0; qt < 2; ++qt) { const float inv = 1.f / lrun[qt];
            LAS unsigned char* ob = lds + 45056 + wave * 4608;
#pragma unroll
            for (int dt = 0; dt < 2; ++dt)
#pragma unroll
                for (int rg = 0; rg < 4; ++rg) { v2u w; w.x = pk2(O[qt][dt][4 * rg] * inv, O[qt][dt][4 * rg + 1] * inv); w.y = pk2(O[qt][dt][4 * rg + 2] * inv, O[qt][dt][4 * rg + 3] * inv);
                    *(LAS v2u*)(ob + l31 * 144 + (32 * dt + 8 * rg + 4 * h) * 2) = w; }
            LDS_WAIT(); asm volatile("" ::: "memory");
#pragma unroll
            for (int j = 0; j < 4; ++j) { const int rr = (lane >> 3) + 8 * j; const v4u x = *(const LAS v4u*)(ob + rr * 144 + (lane & 7) * 16);
                *(v4u*)(mix + (size_t)(b * T + q0w + 32 * qt + rr) * D + RWW + qhead * 64 + (lane & 7) * 8) = x; }
            LDS_WAIT(); asm volatile("" ::: "memory"); }
    }
}


constexpr int RW_WLDS = 18432, RW_GAM = 16384, RW_PAR = 16640, LP = 3584;

struct LerpBuf { v4u r[10]; f32x4 m0, m1; };
__device__ __forceinline__ void lerp_load(LerpBuf& B, const bf16* __restrict__ px, const float* mu, long it) {
    constexpr int NCG = 3488 / 8, NCGP = 448, RB = 8;
    const int rb = (int)(it / NCGP), cg = (int)(it % NCGP), row0 = rb * RB; if (cg >= NCG) return; int t0, len; if (row0 < M) { t0 = row0 & (T - 1); len = T; } else { t0 = (row0 - M) & (CL - 1); len = CL; }
    const bf16* base = px + (size_t)row0 * NPAD + 8 * cg;
    B.r[0] = (v4u){0u, 0u, 0u, 0u}; B.r[RB + 1] = B.r[0];
    if (t0 > 0) B.r[0] = *(const v4u*)(base - NPAD);
#pragma unroll
    for (int i = 0; i < RB; ++i) B.r[i + 1] = *(const v4u*)(base + (size_t)i * NPAD);
    if (t0 + RB < len) B.r[RB + 1] = *(const v4u*)(base + (size_t)RB * NPAD);
    B.m0 = *(const f32x4*)(mu + 8 * cg); B.m1 = *(const f32x4*)(mu + 8 * cg + 4);
}
__device__ __forceinline__ void lerp_comp(const LerpBuf& B, bf16* __restrict__ pxl, long it) {
    constexpr int NCG = 3488 / 8, NCGP = 448, RB = 8;
    const int rb = (int)(it / NCGP), cg = (int)(it % NCGP), row0 = rb * RB; if (cg >= NCG) return; const bool th = (8 * cg >= C_WD && 8 * cg < C_AD);
    f32x2 m1[4], m2[4];
#pragma unroll
    for (int w = 0; w < 4; ++w) { const f32x2 m = (w < 2) ? (f32x2){B.m0[2 * w], B.m0[2 * w + 1]} : (f32x2){B.m1[2 * w - 4], B.m1[2 * w - 3]}; m1[w] = 1.f - m; m2[w] = 0.5f * m; }
    f32x2 pv[4], cu[4];
#pragma unroll
    for (int w = 0; w < 4; ++w) { pv[w] = (f32x2){bflo(B.r[0][w]), bfhi(B.r[0][w])}; cu[w] = (f32x2){bflo(B.r[1][w]), bfhi(B.r[1][w])}; }
#pragma unroll
    for (int i = 0; i < RB; ++i) { f32x2 nx[4], o[4];
#pragma unroll
        for (int w = 0; w < 4; ++w) { nx[w] = (f32x2){bflo(B.r[i + 2][w]), bfhi(B.r[i + 2][w])}; o[w] = cu[w] * m1[w] + m2[w] * (pv[w] + nx[w]); }
        if (th) {
#pragma unroll
            for (int w = 0; w < 4; ++w) { o[w].x = 1.f - 2.f * __builtin_amdgcn_rcpf(1.f + __expf(2.f * o[w].x)); o[w].y = 1.f - 2.f * __builtin_amdgcn_rcpf(1.f + __expf(2.f * o[w].y)); } }
        v4u ov;
#pragma unroll
        for (int w = 0; w < 4; ++w) { ov[w] = pk2(o[w].x, o[w].y); pv[w] = cu[w]; cu[w] = nx[w]; }
        *(v4u*)(pxl + (size_t)(row0 + i) * LP + 8 * cg) = ov; }
}
__device__ __forceinline__ void lerp_phase(const Args& a, int tid, int bid, int G) {
    const bf16* __restrict__ px = (const bf16*)(a.ws + WS_PX); bf16* __restrict__ pxl = (bf16*)a.out; const float* mu = a.in[I_MU];
    constexpr int NCGP = 448, RB = 8; const long total = (long)(MT / RB) * NCGP, stride = (long)G * NTHR;
    long it = (long)bid * NTHR + tid; if (it >= total) return;
    LerpBuf A, B;
    lerp_load(A, px, mu, it);
#pragma unroll 1
    for (; it < total; it += 2 * stride) {
        const bool hb = it + stride < total; if (hb) lerp_load(B, px, mu, it + stride);
        lerp_comp(A, pxl, it);
        if (hb) { if (it + 2 * stride < total) lerp_load(A, px, mu, it + 2 * stride); lerp_comp(B, pxl, it + stride); }
    }
}

#undef ATT_PREFETCH
constexpr size_t WS_PSTART = WS_H + 60 * MiB;
constexpr size_t WS_HSUP = WS_H, WS_PSUP = WS_H + 40 * MiB;
enum { FA = 0, FBT, FKT, FRT };
__device__ __forceinline__ unsigned cvtpk(float lo, float hi) { return pk2(lo, hi); }
__device__ __forceinline__ bf16x8 packt(const f32x16& t, int ks) { v4u w;
#pragma unroll
    for (int i = 0; i < 4; ++i) w[i] = cvtpk(t[8 * ks + 2 * i], t[8 * ks + 2 * i + 1]);
    return __builtin_bit_cast(bf16x8, w); }
__device__ __forceinline__ f32x16 zero16() { f32x16 z;
#pragma unroll
    for (int r = 0; r < 16; ++r) z[r] = 0.f;
    return z; }
__device__ __forceinline__ bf16x8 ldfrag(const LAS unsigned char* wl, int arr, int ct, int ks, int lane) { return *(const LAS bf16x8*)(wl + arr * 4096 + ((ct * 2 + ks) * 64 + lane) * 16); }
__device__ __forceinline__ float scan32(float v, int l31) {
    (void)l31;
#define DPP_ADD(ctrl, rmask) v += __builtin_bit_cast(float, __builtin_amdgcn_update_dpp(0, __builtin_bit_cast(int, v), ctrl, rmask, 0xF, false))
    DPP_ADD(0x111, 0xF); DPP_ADD(0x112, 0xF); DPP_ADD(0x114, 0xF); DPP_ADD(0x118, 0xF); DPP_ADD(0x142, 0xA);
#undef DPP_ADD
    return v; }

template <int MODE, bool TRACK = false>
__device__ __forceinline__ void rwkv_run(KArgP kap, LAS unsigned char* wl, int lane, int seq, int sc, f32x16 (&ST)[2][2], f32x4* uscr = nullptr, v4u* wscr = nullptr) {
    const int d = seq >> 5, b = (seq >> 4) & 1, hh = seq & 15;
#define LL() int ln_ = lane; asm volatile("" : "+v"(ln_)); const int h = ln_ >> 5, l31 = ln_ & 31; (void)h; (void)l31
#define MKIP() bf16x8 ip[2]; _Pragma("unroll") for (int ks = 0; ks < 2; ++ks) { s16x4 lo, hi; _Pragma("unroll") for (int j = 0; j < 4; ++j) { lo[j] = (16 * ks + 4 * h + j == l31) ? (short)0x3F80 : (short)0; hi[j] = (16 * ks + 8 + 4 * h + j == l31) ? (short)0x3F80 : (short)0; } ip[ks] = (bf16x8){lo.x, lo.y, lo.z, lo.w, hi.x, hi.y, hi.z, hi.w}; }
    const int nch = sc < 8 ? 17 : 16, c0 = sc < 8 ? 17 * sc : 136 + 16 * (sc - 8);
    { const Args& a0_ = *(const Args*)kap; LAS float* par = (LAS float*)(wl + RW_PAR);
      par[lane] = a0_.in[I_W0][d * RWW + hh * 64 + lane]; par[64 + lane] = a0_.in[I_A0][d * RWW + hh * 64 + lane]; par[128 + lane] = a0_.in[I_KK][hh * 64 + lane];
      par[192 + lane] = a0_.in[I_KA][hh * 64 + lane]; par[256 + lane] = a0_.in[I_RK][hh * 64 + lane]; }
#pragma unroll 1
    for (int ci = 0; ci < nch; ++ci) {
        KArgP kl = kap; asm volatile("" : "+s"(kl)); const Args& a = *(const Args*)kl;
        const bf16* px = (const bf16*)a.out; const bf16* w2t = (const bf16*)(a.ws + WS_W2T); const bf16* a2t = (const bf16*)(a.ws + WS_A2T);
        bf16* yd = (bf16*)(a.ws + WS_YD); float* bs = (float*)(a.ws + WS_BS);
        size_t row; const bool isx = (c0 + ci) >= CL / 32;
        { LL(); const int s = 32 * (c0 + ci) + l31; int tok;
        if (!isx) { tok = d ? (CL - 1 - s) : s; row = (size_t)(M + b * CL + tok); }
        else { const int tt = s - CL; tok = d ? (T - 1 - tt) : tt; row = (size_t)(b * T + tok); } }
        const bf16* cur = px + row * LP;
        const bf16* curh; { LL(); curh = cur + 4 * h + hh * 64; }
        v2u kraw[8], rraw[8];
#pragma unroll
        for (int q8 = 0; q8 < 8; ++q8) { kraw[q8] = *(const v2u*)(curh + C_K + 8 * q8); if (MODE == 2) rraw[q8] = *(const v2u*)(curh + C_R + 8 * q8); else rraw[q8] = (v2u){0u, 0u}; }
#define UNPK4(w) ((f32x4){bflo((w).x), bfhi((w).x), bflo((w).y), bfhi((w).y)})
        f32x16 lw[2], la[2]; lw[0] = zero16(); lw[1] = zero16(); la[0] = zero16(); la[1] = zero16();
        { LL();
#pragma unroll
        for (int ks4 = 0; ks4 < 4; ++ks4) {
            const int cw = C_WD + 64 * d + 16 * ks4 + 8 * h, ca = C_AD + 64 * d + 16 * ks4 + 8 * h;
            const v4u wf = *(const v4u*)(cur + cw), af = *(const v4u*)(cur + ca);
            const bf16x8 wdf = __builtin_bit_cast(bf16x8, wf), adf = __builtin_bit_cast(bf16x8, af);
#pragma unroll
            for (int ct = 0; ct < 2; ++ct) { const size_t wo = ((size_t)((((d * 16 + hh) * 2 + ct) * 4 + ks4) * 64 + ln_)) * 8;
                lw[ct] = mfma32(*(const bf16x8*)(w2t + wo), wdf, lw[ct]); la[ct] = mfma32(*(const bf16x8*)(a2t + wo), adf, la[ct]); }
        } }
        float rinv;
        { LL(); float n2 = 0.f;
#pragma unroll
        for (int ct = 0; ct < 2; ++ct)
#pragma unroll
            for (int q = 0; q < 4; ++q) { const int c = hh * 64 + 32 * ct + 8 * q + 4 * h;
                const f32x4 kv = UNPK4(kraw[4 * ct + q]) * *(const LAS f32x4*)(wl + RW_PAR + (2 * 64 + (c - hh * 64)) * 4); n2 += (kv.x * kv.x + kv.y * kv.y) + (kv.z * kv.z + kv.w * kv.w); }
        n2 += __shfl_xor(n2, 32); rinv = 1.f / sqrtf(fmaxf(n2, 1e-24f)); }
        float bonus = 0.f;
#pragma unroll
        for (int ct = 0; ct < 2; ++ct) {
            f32x16 Lc; unsigned apk[8];
            { LL();
#pragma unroll
            for (int q = 0; q < 4; ++q) { const int c = hh * 64 + 32 * ct + 8 * q + 4 * h;
                const f32x4 w0v = *(const LAS f32x4*)(wl + RW_PAR + (0 * 64 + (c - hh * 64)) * 4), a0v = *(const LAS f32x4*)(wl + RW_PAR + (1 * 64 + (c - hh * 64)) * 4);
                float av[4];
#pragma unroll
                for (int i = 0; i < 4; ++i) {
                    Lc[4 * q + i] = scan32(-0.60653065971f * __builtin_amdgcn_rcpf(1.f + __expf(-(w0v[i] + lw[ct][4 * q + i]))), l31); av[i] = __builtin_amdgcn_rcpf(1.f + __expf(-(a0v[i] + la[ct][4 * q + i]))); }
                apk[2 * q] = cvtpk(av[0], av[1]); apk[2 * q + 1] = cvtpk(av[2], av[3]); } }
            { LL(); const int lane = ln_;
#pragma unroll
            for (int q = 0; q < 4; ++q) { const int c = hh * 64 + 32 * ct + 8 * q + 4 * h;
                const f32x4 kkc = *(const LAS f32x4*)(wl + RW_PAR + (2 * 64 + (c - hh * 64)) * 4), kac = *(const LAS f32x4*)(wl + RW_PAR + (3 * 64 + (c - hh * 64)) * 4);
                const f32x4 kv = UNPK4(kraw[4 * ct + q]);
                f32x4 rv = {0.f, 0.f, 0.f, 0.f}, rkc = rv;
                if (MODE == 2) { rv = UNPK4(rraw[4 * ct + q]); rkc = *(const LAS f32x4*)(wl + RW_PAR + (4 * 64 + (c - hh * 64)) * 4); }
                float At[4], Bt[4], Kt[4], Rt[4];
#pragma unroll
                for (int i = 0; i < 4; ++i) { const int ix = 4 * q + i; const float Lci = Lc[ix], ai = (i & 1) ? bfhi(apk[ix >> 1]) : bflo(apk[ix >> 1]);
                    const float eL = __expf(Lci), eLm = __builtin_amdgcn_rcpf(eL); float ePrev = __shfl_up(eL, 1, 32); ePrev = (l31 == 0) ? 1.f : ePrev;
                    const float kk = kv[i] * kkc[i] * rinv, kmod = kv[i] * (1.f + (ai - 1.f) * kac[i]), beta = kk * ai;
                    At[i] = -kk * ePrev; Bt[i] = beta * eLm; Kt[i] = kmod * eLm; Rt[i] = rv[i] * eL;
                    if (MODE == 2) bonus += rv[i] * kmod * rkc[i];
                    if (l31 == 31) *(LAS float*)(wl + RW_GAM + (h * 32 + ct * 16 + ix) * 4) = eL; }
                LAS unsigned char* fp = wl + ((ct * 2 + (q >> 1)) * 64 + lane) * 16 + (q & 1) * 8;
                *(LAS v2u*)(fp + FA * 4096) = (v2u){cvtpk(At[0], At[1]), cvtpk(At[2], At[3])};
                *(LAS v2u*)(fp + FBT * 4096) = (v2u){cvtpk(Bt[0], Bt[1]), cvtpk(Bt[2], Bt[3])};
                if (MODE != 1) *(LAS v2u*)(fp + FKT * 4096) = (v2u){cvtpk(Kt[0], Kt[1]), cvtpk(Kt[2], Kt[3])};
                if (MODE == 2) *(LAS v2u*)(fp + FRT * 4096) = (v2u){cvtpk(Rt[0], Rt[1]), cvtpk(Rt[2], Rt[3])};
            } }
        }
        if (MODE == 2) bonus += __shfl_xor(bonus, 32);
        v2u vraw[8];
#pragma unroll
        for (int q8 = 0; q8 < 8; ++q8) vraw[q8] = (MODE != 1) ? *(const v2u*)(curh + C_V + 8 * q8) : (v2u){0u, 0u};
        bf16x8 pT[2];
        { LL(); const int lane = ln_;
            f32x16 X = zero16(), XT = zero16();
#pragma unroll
            for (int ct = 0; ct < 2; ++ct)
#pragma unroll
                for (int ks = 0; ks < 2; ++ks) { const bf16x8 fa = ldfrag(wl, FA, ct, ks, lane), fb = ldfrag(wl, FBT, ct, ks, lane); X = mfma32(fb, fa, X); XT = mfma32(fa, fb, XT); }
            f32x16 Tm;
#pragma unroll
            for (int r = 0; r < 16; ++r) { const int rw = (r & 3) + 8 * (r >> 2) + 4 * h; X[r] = (rw < l31) ? X[r] : 0.f; XT[r] = (l31 < rw) ? XT[r] : 0.f; Tm[r] = X[r] + ((rw == l31) ? 1.f : 0.f); }
#pragma unroll
            for (int it = 0; it < 4; ++it) {
                f32x16 X2 = zero16(), X2T = zero16();
                const bf16x8 px0 = packt(X, 0), px1 = packt(X, 1), pxt0 = packt(XT, 0), pxt1 = packt(XT, 1);
                X2 = mfma32(pxt0, px0, X2); X2 = mfma32(pxt1, px1, X2); X2T = mfma32(px0, pxt0, X2T); X2T = mfma32(px1, pxt1, X2T);
                const bf16x8 p2t0 = packt(X2T, 0), p2t1 = packt(X2T, 1), pt0 = packt(Tm, 0), pt1 = packt(Tm, 1);
                Tm = mfma32(p2t0, pt0, Tm); Tm = mfma32(p2t1, pt1, Tm);
                X = X2; XT = X2T;
            }
            pT[0] = packt(Tm, 0); pT[1] = packt(Tm, 1);
        }
        bf16x8 pW1T[2][2];
        { LL(); const int lane = ln_; MKIP();
#pragma unroll
        for (int ct = 0; ct < 2; ++ct) { f32x16 at = zero16(); at = mfma32(ldfrag(wl, FA, ct, 0, lane), ip[0], at); at = mfma32(ldfrag(wl, FA, ct, 1, lane), ip[1], at);
            f32x16 w1 = zero16(); w1 = mfma32(pT[0], packt(at, 0), w1); w1 = mfma32(pT[1], packt(at, 1), w1); pW1T[ct][0] = packt(w1, 0); pW1T[ct][1] = packt(w1, 1); } }
        bf16x8 pW2T[2];
        if (MODE != 1) { LL(); const int lane = ln_;
            f32x16 nak = zero16();
#pragma unroll
            for (int ct = 0; ct < 2; ++ct)
#pragma unroll
                for (int ks = 0; ks < 2; ++ks) nak = mfma32(ldfrag(wl, FA, ct, ks, lane), ldfrag(wl, FKT, ct, ks, lane), nak);
#pragma unroll
            for (int r = 0; r < 16; ++r) { const int rw = (r & 3) + 8 * (r >> 2) + 4 * h; nak[r] = (l31 < rw) ? nak[r] : 0.f; }
            f32x16 w2 = zero16(); w2 = mfma32(pT[0], packt(nak, 0), w2); w2 = mfma32(pT[1], packt(nak, 1), w2); pW2T[0] = packt(w2, 0); pW2T[1] = packt(w2, 1);
        }
        if (MODE == 2) { LL(); const int lane = ln_;
            f32x16 nbr = zero16(), nkr = zero16();
#pragma unroll
            for (int ct = 0; ct < 2; ++ct)
#pragma unroll
                for (int ks = 0; ks < 2; ++ks) { const bf16x8 fr = ldfrag(wl, FRT, ct, ks, lane); nbr = mfma32(ldfrag(wl, FBT, ct, ks, lane), fr, nbr); nkr = mfma32(ldfrag(wl, FKT, ct, ks, lane), fr, nkr); }
#pragma unroll
            for (int r = 0; r < 16; ++r) { const int rw = (r & 3) + 8 * (r >> 2) + 4 * h; nbr[r] = (rw <= l31) ? nbr[r] : 0.f; nkr[r] = (rw <= l31) ? nkr[r] : 0.f; }
            const bf16x8 pnb0 = packt(nbr, 0), pnb1 = packt(nbr, 1);
#pragma unroll
            for (int ct = 0; ct < 2; ++ct) { f32x16 g;
#pragma unroll
                for (int ks = 0; ks < 2; ++ks) { const v4u w = __builtin_bit_cast(v4u, ldfrag(wl, FRT, ct, ks, lane));
#pragma unroll
                    for (int i = 0; i < 4; ++i) { g[8 * ks + 2 * i] = bflo(w[i]); g[8 * ks + 2 * i + 1] = bfhi(w[i]); } }
                g = mfma32(pW1T[ct][0], pnb0, g); g = mfma32(pW1T[ct][1], pnb1, g);
                *(LAS bf16x8*)(wl + FRT * 4096 + ((ct * 2 + 0) * 64 + lane) * 16) = packt(g, 0); *(LAS bf16x8*)(wl + FRT * 4096 + ((ct * 2 + 1) * 64 + lane) * 16) = packt(g, 1); }
            nkr = mfma32(pW2T[0], pnb0, nkr); nkr = mfma32(pW2T[1], pnb1, nkr);
            *(LAS bf16x8*)(wl + FA * 4096 + (0 * 64 + lane) * 16) = packt(nkr, 0); *(LAS bf16x8*)(wl + FA * 4096 + (1 * 64 + lane) * 16) = packt(nkr, 1);
        }
        bf16x8 pPp[2][2][2], pQ[2][2], pVT[2][2];
        { LL(); const int lane = ln_; MKIP();
            bf16x8 pBhT[2][2]; float gcol[2];
#pragma unroll
            for (int j2 = 0; j2 < 2; ++j2) gcol[j2] = *(const LAS float*)(wl + RW_GAM + ((((l31 >> 2) & 1) * 32) + j2 * 16 + (l31 & 3) + 4 * (l31 >> 3)) * 4);
#pragma unroll
            for (int j2 = 0; j2 < 2; ++j2) { f32x16 t = zero16(); t = mfma32(ldfrag(wl, FBT, j2, 0, lane), ip[0], t); t = mfma32(ldfrag(wl, FBT, j2, 1, lane), ip[1], t); t = t * gcol[j2]; pBhT[j2][0] = packt(t, 0); pBhT[j2][1] = packt(t, 1); }
#pragma unroll
            for (int jt = 0; jt < 2; ++jt)
#pragma unroll
                for (int j2 = 0; j2 < 2; ++j2) { f32x16 p = zero16(); p = mfma32(pW1T[jt][0], pBhT[j2][0], p); p = mfma32(pW1T[jt][1], pBhT[j2][1], p); pPp[jt][j2][0] = packt(p, 0); pPp[jt][j2][1] = packt(p, 1); }
            if (MODE != 1) {
#pragma unroll
                for (int jt = 0; jt < 2; ++jt) { f32x16 qq = zero16(); qq = mfma32(ldfrag(wl, FKT, jt, 0, lane), ip[0], qq); qq = mfma32(ldfrag(wl, FKT, jt, 1, lane), ip[1], qq); qq = qq * gcol[jt];
                    qq = mfma32(pW2T[0], pBhT[jt][0], qq); qq = mfma32(pW2T[1], pBhT[jt][1], qq); pQ[jt][0] = packt(qq, 0); pQ[jt][1] = packt(qq, 1); }
#pragma unroll
                for (int it = 0; it < 2; ++it) { f32x16 t = zero16();
#pragma unroll
                    for (int ks = 0; ks < 2; ++ks) { const v2u lo = vraw[4 * it + 2 * ks], hi = vraw[4 * it + 2 * ks + 1];
                        t = mfma32(__builtin_bit_cast(bf16x8, (v4u){lo.x, lo.y, hi.x, hi.y}), ip[ks], t); }
                    pVT[it][0] = packt(t, 0); pVT[it][1] = packt(t, 1); }
            }
        }
        bf16x8 pST[2][2][2];
#pragma unroll
        for (int jt = 0; jt < 2; ++jt)
#pragma unroll
            for (int it = 0; it < 2; ++it) { pST[jt][it][0] = packt(ST[jt][it], 0); pST[jt][it][1] = packt(ST[jt][it], 1); }
        LL();
        if (MODE == 2) {
#pragma unroll
            for (int it = 0; it < 2; ++it) { f32x16 y = zero16();
#pragma unroll
                for (int ks = 0; ks < 2; ++ks) y = mfma32(pVT[it][ks], ldfrag(wl, FA, 0, ks, ln_), y);
#pragma unroll
                for (int jt = 0; jt < 2; ++jt)
#pragma unroll
                    for (int ks = 0; ks < 2; ++ks) y = mfma32(pST[jt][it][ks], ldfrag(wl, FRT, jt, ks, ln_), y);
                if (isx) {
                    const int kx = (c0 + ci) - CL / 32, kt = d ? 511 - kx : kx, lanep = d ? ((ln_ & 32) | (31 - l31)) : ln_;
                    v4u* ydf = (v4u*)yd + ((size_t)((((d * 2 + b) * 16 + hh) * 512 + kt) * 4 + it * 2)) * 64 + lanep;
                    ydf[0] = __builtin_bit_cast(v4u, packt(y, 0)); ydf[64] = __builtin_bit_cast(v4u, packt(y, 1)); } }
            if (isx && h == 0) { const int kx = (c0 + ci) - CL / 32, kt = d ? 511 - kx : kx; bs[(size_t)((((d * 2 + b) * 16 + hh) * 512 + kt) * 32) + (d ? 31 - l31 : l31)] = bonus; }
        }
#pragma unroll
        for (int j2 = 0; j2 < 2; ++j2) {
            f32x4 gq[4];
#pragma unroll
            for (int q = 0; q < 4; ++q) gq[q] = *(const LAS f32x4*)(wl + RW_GAM + (h * 32 + j2 * 16 + 4 * q) * 4);
#pragma unroll
            for (int it = 0; it < 2; ++it) { f32x16 acc;
#pragma unroll
                for (int r = 0; r < 16; ++r) acc[r] = gq[r >> 2][r & 3] * ST[j2][it][r];
                if (MODE != 1) { acc = mfma32(pQ[j2][0], pVT[it][0], acc); acc = mfma32(pQ[j2][1], pVT[it][1], acc); }
#pragma unroll
                for (int jt = 0; jt < 2; ++jt)
#pragma unroll
                    for (int ks = 0; ks < 2; ++ks) acc = mfma32(pPp[jt][j2][ks], pST[jt][it][ks], acc);
                ST[j2][it] = acc; }
        }
        if (TRACK) { __builtin_amdgcn_sched_barrier(0);
            bf16x8 pU[2][2][2];
            const v4u* uq = (const v4u*)uscr;
#pragma unroll
            for (int jt = 0; jt < 2; ++jt)
#pragma unroll
                for (int it = 0; it < 2; ++it)
#pragma unroll
                    for (int ks = 0; ks < 2; ++ks) pU[jt][it][ks] = __builtin_bit_cast(bf16x8, uq[((jt * 2 + it) * 2 + ks) * 64 + ln_]);
            if (MODE == 2 && isx) {
#pragma unroll
                for (int i2 = 0; i2 < 2; ++i2) { f32x16 w = zero16();
#pragma unroll
                    for (int jt = 0; jt < 2; ++jt)
#pragma unroll
                        for (int ks = 0; ks < 2; ++ks) w = mfma32(pU[jt][i2][ks], ldfrag(wl, FRT, jt, ks, ln_), w);
                    wscr[((ci * 2 + i2) * 2 + 0) * 64 + ln_] = __builtin_bit_cast(v4u, packt(w, 0)); wscr[((ci * 2 + i2) * 2 + 1) * 64 + ln_] = __builtin_bit_cast(v4u, packt(w, 1)); }
            }
#pragma unroll
            for (int j2 = 0; j2 < 2; ++j2) {
                f32x4 gq[4];
#pragma unroll
                for (int q = 0; q < 4; ++q) gq[q] = *(const LAS f32x4*)(wl + RW_GAM + (h * 32 + j2 * 16 + 4 * q) * 4);
#pragma unroll
                for (int it = 0; it < 2; ++it) { f32x16 acc;
#pragma unroll
                    for (int ks = 0; ks < 2; ++ks) { const v4u w = __builtin_bit_cast(v4u, pU[j2][it][ks]);
#pragma unroll
                        for (int i = 0; i < 4; ++i) { const int r0 = 8 * ks + 2 * i; acc[r0] = gq[r0 >> 2][r0 & 3] * bflo(w[i]); acc[r0 + 1] = gq[(r0 + 1) >> 2][(r0 + 1) & 3] * bfhi(w[i]); } }
#pragma unroll
                    for (int jt = 0; jt < 2; ++jt)
#pragma unroll
                        for (int ks = 0; ks < 2; ++ks) acc = mfma32(pPp[jt][j2][ks], pU[jt][it][ks], acc);
                    v4u* us = (v4u*)uscr;
                    us[((j2 * 2 + it) * 2 + 0) * 64 + ln_] = __builtin_bit_cast(v4u, packt(acc, 0)); us[((j2 * 2 + it) * 2 + 1) * 64 + ln_] = __builtin_bit_cast(v4u, packt(acc, 1)); }
            }
        }
    }
}
#undef LL
#undef MKIP
#undef UNPK4

__device__ __forceinline__ void p4_rwkv_passA(KArgP kap, LAS unsigned char* lds, int lane0, int wave, int bid, int G) {
    const Args& a = *(const Args*)kap;
    LAS unsigned char* wl = lds + wave * RW_WLDS;
    f32x4* uscr = (f32x4*)(a.ws + WS_PX + 160 * MiB) + (size_t)(bid * NWAVES + wave) * 1024;
#pragma unroll 1
    for (int item = bid * 8 + wave; item < 2048; item += G * 8) {
        int lane = lane0; asm volatile("" : "+v"(lane)); const int h = lane >> 5, l31 = lane & 31;
        const int seq = item >> 5, sc = item & 31;
        f32x16 ST[2][2];
        float z = 0.f; asm volatile("" : "+v"(z));
#pragma unroll
        for (int r = 0; r < 16; ++r) { ST[0][0][r] = z; ST[0][1][r] = z; ST[1][0][r] = z; ST[1][1][r] = z; }
#pragma unroll
        for (int jt = 0; jt < 2; ++jt)
#pragma unroll
            for (int it = 0; it < 2; ++it)
#pragma unroll
                for (int ks = 0; ks < 2; ++ks) { f32x16 u;
#pragma unroll
                    for (int r = 0; r < 16; ++r) u[r] = (jt == it && ((r & 3) + 8 * (r >> 2) + 4 * h) == l31) ? 1.f : z;
                    ((v4u*)uscr)[((jt * 2 + it) * 2 + ks) * 64 + lane] = __builtin_bit_cast(v4u, packt(u, ks)); }
        rwkv_run<2, true>(kap, wl, lane, seq, sc, ST, uscr, (v4u*)(a.ws + WS_PX) + (size_t)item * (17 * 256));
        asm volatile("" : "+v"(lane));
        const int h2 = lane >> 5, l31b = lane & 31;
        v4u* hs = (v4u*)(a.ws + WS_HSUP) + (size_t)item * 512;
#pragma unroll
        for (int jt = 0; jt < 2; ++jt)
#pragma unroll
            for (int it = 0; it < 2; ++it)
#pragma unroll
                for (int ks = 0; ks < 2; ++ks) hs[((jt * 2 + it) * 2 + ks) * 64 + lane] = __builtin_bit_cast(v4u, packt(ST[jt][it], ks));
        bf16x8 ip[2];
#pragma unroll
        for (int ks = 0; ks < 2; ++ks) { s16x4 lo, hi;
#pragma unroll
            for (int j = 0; j < 4; ++j) { lo[j] = (16 * ks + 4 * h2 + j == l31b) ? (short)0x3F80 : (short)0; hi[j] = (16 * ks + 8 + 4 * h2 + j == l31b) ? (short)0x3F80 : (short)0; }
            ip[ks] = (bf16x8){lo.x, lo.y, lo.z, lo.w, hi.x, hi.y, hi.z, hi.w}; }
        v4u* ps = (v4u*)(a.ws + WS_PSUP) + (size_t)item * 512;
#pragma unroll
        for (int jt = 0; jt < 2; ++jt)
#pragma unroll
            for (int j2 = 0; j2 < 2; ++j2) {
                const bf16x8 u0 = __builtin_bit_cast(bf16x8, ((const v4u*)uscr)[((j2 * 2 + jt) * 2 + 0) * 64 + lane]), u1 = __builtin_bit_cast(bf16x8, ((const v4u*)uscr)[((j2 * 2 + jt) * 2 + 1) * 64 + lane]);
                f32x16 x = zero16(); x = mfma32(u0, ip[0], x); x = mfma32(u1, ip[1], x);
                ps[((jt * 2 + j2) * 2 + 0) * 64 + lane] = __builtin_bit_cast(v4u, packt(x, 0)); ps[((jt * 2 + j2) * 2 + 1) * 64 + lane] = __builtin_bit_cast(v4u, packt(x, 1)); }
    }
}
__device__ __forceinline__ void p5_rwkv_passC(KArgP kap, LAS unsigned char* lds, int lane0, int wave, int bid, int G) {
    const Args& a = *(const Args*)kap; (void)lds;
#pragma unroll 1
    for (int item = bid * 8 + wave; item < 2048; item += G * 8) {
        int lane = lane0; asm volatile("" : "+v"(lane));
        const int seq = item >> 5, sc = item & 31;
        if (sc == 0) continue;
        f32x16 ST[2][2];
        { float z = 0.f; asm volatile("" : "+v"(z));
#pragma unroll
          for (int r = 0; r < 16; ++r) { ST[0][0][r] = z; ST[0][1][r] = z; ST[1][0][r] = z; ST[1][1][r] = z; } }
        const v4u* hs0 = (const v4u*)(a.ws + WS_HSUP) + (size_t)(seq * 32) * 512 + lane; const v4u* ps0 = (const v4u*)(a.ws + WS_PSUP) + (size_t)(seq * 32) * 512 + lane;
#define PF_LOAD(BP, BH, kk) do { _Pragma("unroll") for (int f = 0; f < 8; ++f) { BP[f] = ps0[(size_t)(kk) * 512 + f * 64]; BH[f] = hs0[(size_t)(kk) * 512 + f * 64]; } } while (0)
#define PF_STEP(BP, BH) do { bf16x8 pST[2][2][2]; \
            _Pragma("unroll") for (int jt = 0; jt < 2; ++jt) _Pragma("unroll") for (int it = 0; it < 2; ++it) { pST[jt][it][0] = packt(ST[jt][it], 0); pST[jt][it][1] = packt(ST[jt][it], 1); } \
            _Pragma("unroll") for (int j2 = 0; j2 < 2; ++j2) _Pragma("unroll") for (int it = 0; it < 2; ++it) { f32x16 acc; \
                _Pragma("unroll") for (int ks = 0; ks < 2; ++ks) { const v4u w = BH[(j2 * 2 + it) * 2 + ks]; _Pragma("unroll") for (int i = 0; i < 4; ++i) { acc[8 * ks + 2 * i] = bflo(w[i]); acc[8 * ks + 2 * i + 1] = bfhi(w[i]); } } \
                _Pragma("unroll") for (int jt = 0; jt < 2; ++jt) _Pragma("unroll") for (int ks = 0; ks < 2; ++ks) acc = mfma32(__builtin_bit_cast(bf16x8, BP[(jt * 2 + j2) * 2 + ks]), pST[jt][it][ks], acc); \
                ST[j2][it] = acc; } } while (0)
        v4u aP[8], aH[8], bP[8], bH[8];
        PF_LOAD(aP, aH, 0);
#pragma unroll 1
        for (int k = 0; k < sc; k += 2) {
            if (k + 1 < sc) PF_LOAD(bP, bH, k + 1);
            PF_STEP(aP, aH);
            if (k + 1 < sc) { if (k + 2 < sc) PF_LOAD(aP, aH, k + 2); PF_STEP(bP, bH); }
        }
#undef PF_LOAD
#undef PF_STEP
        v4u* pst = (v4u*)(a.ws + WS_PSTART) + (size_t)item * 512;
#pragma unroll
        for (int jt = 0; jt < 2; ++jt)
#pragma unroll
            for (int it = 0; it < 2; ++it) { pst[((jt * 2 + it) * 2 + 0) * 64 + lane] = __builtin_bit_cast(v4u, packt(ST[jt][it], 0)); pst[((jt * 2 + it) * 2 + 1) * 64 + lane] = __builtin_bit_cast(v4u, packt(ST[jt][it], 1)); }
    }
}
__device__ __forceinline__ void p5_rwkv_finish(const Args& a, LAS unsigned char* lds, int tid, int lane, int wave, int bid, int G) {
    const bf16* px = (const bf16*)a.out; bf16* mix = (bf16*)(a.ws + WS_MIX); const bf16* yd = (const bf16*)(a.ws + WS_YD); const float* bs = (const float*)(a.ws + WS_BS);
    const bf16* g2t = (const bf16*)(a.ws + WS_G2T); LAS bf16* sgl = (LAS bf16*)lds;
    const int h = lane >> 5, l31 = lane & 31;
    for (int tile = bid; tile < M / 32; tile += G) {
        __syncthreads();
        for (int e = tid; e < 32 * 20; e += NTHR) { const int tk = e / 20, i8 = e % 20; const size_t row = (size_t)tile * 32 + tk;
            const v4u w = *(const v4u*)(px + row * LP + C_GD + 8 * i8); v4u o;
#pragma unroll
            for (int i = 0; i < 4; ++i) o[i] = pk2(__builtin_amdgcn_rcpf(1.f + __expf(-bflo(w[i]))), __builtin_amdgcn_rcpf(1.f + __expf(-bfhi(w[i]))));
            *(LAS v4u*)(sgl + tk * 168 + 8 * i8) = o; }
        __syncthreads();
        const size_t row = (size_t)tile * 32 + l31;
#pragma unroll 1
        for (int hi = 0; hi < 2; ++hi) { const int hh = 2 * wave + hi;
            f32x16 gacc[2];
#pragma unroll
            for (int ct = 0; ct < 2; ++ct)
#pragma unroll
                for (int r = 0; r < 16; ++r) gacc[ct][r] = 0.f;
#pragma unroll 5
            for (int s = 0; s < 10; ++s) { const bf16x8 bfr = *(const LAS bf16x8*)(sgl + l31 * 168 + 16 * s + 8 * h);
#pragma unroll
                for (int ct = 0; ct < 2; ++ct) { const bf16x8 afr = *(const bf16x8*)(g2t + ((size_t)(((hh * 2 + ct) * 10 + s) * 64 + lane)) * 8); gacc[ct] = mfma32(afr, bfr, gacc[ct]); } }
            f32x4 yv[2][4]; float sum = 0.f; v2u vraw[2][4]; f32x4 lwv[2][4], lbv[2][4];
            const int bbt = tile >> 9, ktt = tile & 511; const size_t f0 = (size_t)(((0 * 2 + bbt) * 16 + hh) * 512 + ktt), f1 = (size_t)(((1 * 2 + bbt) * 16 + hh) * 512 + ktt);
            const float bsum = bs[f0 * 32 + l31] + bs[f1 * 32 + l31];
            const v4u* y0p = (const v4u*)yd + f0 * 256 + lane; const v4u* y1p = (const v4u*)yd + f1 * 256 + lane;
#pragma unroll
            for (int ct = 0; ct < 2; ++ct)
#pragma unroll
                for (int qp = 0; qp < 2; ++qp) { const v4u w0 = y0p[(ct * 2 + qp) * 64], w1 = y1p[(ct * 2 + qp) * 64];
                    yv[ct][2 * qp] = (f32x4){bflo(w0.x) + bflo(w1.x), bfhi(w0.x) + bfhi(w1.x), bflo(w0.y) + bflo(w1.y), bfhi(w0.y) + bfhi(w1.y)};
                    yv[ct][2 * qp + 1] = (f32x4){bflo(w0.z) + bflo(w1.z), bfhi(w0.z) + bfhi(w1.z), bflo(w0.w) + bflo(w1.w), bfhi(w0.w) + bfhi(w1.w)}; }
#pragma unroll
            for (int ct = 0; ct < 2; ++ct)
#pragma unroll
                for (int rg = 0; rg < 4; ++rg) { const int c = hh * 64 + 32 * ct + 8 * rg + 4 * h;
                    vraw[ct][rg] = *(const v2u*)(px + row * LP + C_V + c); lwv[ct][rg] = *(const f32x4*)(a.in[I_LNW] + c); lbv[ct][rg] = *(const f32x4*)(a.in[I_LNB] + c); }
#pragma unroll
            for (int dd = 0; dd < 2; ++dd) { const int bb = (int)(row >> 14), kt = (tile & 511), cc = 8 + (dd ? (511 - kt) : kt), sc = cc < 136 ? cc / 17 : 8 + (cc - 136) / 16;
                if (sc == 0) continue;
                const int ci = cc - (sc < 8 ? 17 * sc : 136 + 16 * (sc - 8)), item = ((dd * 2 + bb) * 16 + hh) * 32 + sc;
                const v4u* pst = (const v4u*)(a.ws + WS_PSTART) + (size_t)item * 512; const v4u* wsc = (const v4u*)(a.ws + WS_PX) + (size_t)item * (17 * 256);
                bf16x8 pW[2][2];
#pragma unroll
                for (int i2 = 0; i2 < 2; ++i2)
#pragma unroll
                    for (int ks = 0; ks < 2; ++ks) pW[i2][ks] = __builtin_bit_cast(bf16x8, wsc[((ci * 2 + i2) * 2 + ks) * 64 + lane]);
#pragma unroll
                for (int it = 0; it < 2; ++it) { f32x16 cr = zero16();
#pragma unroll
                    for (int i2 = 0; i2 < 2; ++i2)
#pragma unroll
                        for (int ks = 0; ks < 2; ++ks) cr = mfma32(__builtin_bit_cast(bf16x8, pst[((i2 * 2 + it) * 2 + ks) * 64 + lane]), pW[i2][ks], cr);
#pragma unroll
                    for (int rg = 0; rg < 4; ++rg) { f32x4 cv = {cr[4 * rg], cr[4 * rg + 1], cr[4 * rg + 2], cr[4 * rg + 3]};
                        if (dd) { const int src = (lane & 32) | (31 - l31); cv.x = __shfl(cv.x, src); cv.y = __shfl(cv.y, src); cv.z = __shfl(cv.z, src); cv.w = __shfl(cv.w, src); }
                        yv[it][rg] += cv; } }
            }
#pragma unroll
            for (int ct = 0; ct < 2; ++ct)
#pragma unroll
                for (int rg = 0; rg < 4; ++rg) sum += (yv[ct][rg].x + yv[ct][rg].y) + (yv[ct][rg].z + yv[ct][rg].w);
            sum += __shfl_xor(sum, 32); const float mean = sum * (1.f / 64.f); float vs = 0.f;
#pragma unroll
            for (int ct = 0; ct < 2; ++ct)
#pragma unroll
                for (int rg = 0; rg < 4; ++rg) { const f32x4 dlt = yv[ct][rg] - mean; vs += (dlt.x * dlt.x + dlt.y * dlt.y) + (dlt.z * dlt.z + dlt.w * dlt.w); }
            vs += __shfl_xor(vs, 32); const float rstd = 1.f / sqrtf(vs * (1.f / 64.f) + GN_EPS);
#pragma unroll
            for (int ct = 0; ct < 2; ++ct)
#pragma unroll
                for (int rg = 0; rg < 4; ++rg) { const int c = hh * 64 + 32 * ct + 8 * rg + 4 * h;
                    const f32x4 lw = lwv[ct][rg], lb = lbv[ct][rg];
                    const v2u vw = vraw[ct][rg]; const f32x4 vv = {bflo(vw.x), bfhi(vw.x), bflo(vw.y), bfhi(vw.y)};
                    const f32x4 gg = {gacc[ct][4 * rg], gacc[ct][4 * rg + 1], gacc[ct][4 * rg + 2], gacc[ct][4 * rg + 3]};
                    const f32x4 o = ((yv[ct][rg] - mean) * rstd * lw + lb + vv * bsum) * gg;
                    v2u w; w.x = pk2(o.x, o.y); w.y = pk2(o.z, o.w); *(LAS v2u*)(lds + 16384 + wave * 4608 + l31 * 144 + (32 * ct + 8 * rg + 4 * h) * 2) = w; }
            LDS_WAIT(); asm volatile("" ::: "memory");
#pragma unroll
            for (int j = 0; j < 4; ++j) { const int rr = (lane >> 3) + 8 * j; const v4u x = *(const LAS v4u*)(lds + 16384 + wave * 4608 + rr * 144 + (lane & 7) * 16);
                *(v4u*)(mix + ((size_t)tile * 32 + rr) * D + hh * 64 + (lane & 7) * 8) = x; }
            LDS_WAIT(); asm volatile("" ::: "memory");
        }
    }
}

__device__ __forceinline__ float wave_sum_dpp(float v) {
#define DPP_ADD(ctrl, rmask) v += __builtin_bit_cast(float, __builtin_amdgcn_update_dpp(0, __builtin_bit_cast(int, v), ctrl, rmask, 0xF, false))
    DPP_ADD(0xB1, 0xF); DPP_ADD(0x4E, 0xF); DPP_ADD(0x141, 0xF); DPP_ADD(0x140, 0xF); DPP_ADD(0x142, 0xA); DPP_ADD(0x143, 0xC);
#undef DPP_ADD
    return rdlane(v, 63);
}
__device__ __forceinline__ void moe_norm_router(const Args& a, int l, const bf16* xin, LAS unsigned char* lds, int tid, int lane, int wave, int bid, int G) {
    LAS float* rw = (LAS float*)lds;
    __syncthreads();
    for (int i = tid; i < 2048 * 16; i += NTHR) rw[(i & 15) * 2052 + (i >> 4)] = a.in[I_ROUTER][(size_t)l * 32768 + i];
    __syncthreads();
    const int gw = bid * NWAVES + wave, NGW = G * NWAVES; bf16* h1 = (bf16*)(a.ws + WS_H); float* aff = (float*)(a.ws + WS_AFF);
    LAS float* affl = (LAS float*)(lds + 16 * 2052 * 4) + wave * 256;
    f32x4 A[8], B[8];
    for (int ch = gw; ch < M / 16; ch += NGW) {
        const int b = ch / (T / 16);
        load_coef(a.in[I_NFFN] + l * D, modp(a.ws, l, b, 4), modp(a.ws, l, b, 3), lane, A, B);
        v2u raw[4][8];
#pragma unroll
        for (int u = 0; u < 4; ++u) { const v2u* p = (const v2u*)(xin + ((size_t)ch * 16 + u) * D) + lane;
#pragma unroll
            for (int j = 0; j < 8; ++j) raw[u][j] = p[64 * j]; }
#pragma unroll 1
        for (int rr = 0; rr < 16; rr += 2) { const size_t row = (size_t)ch * 16 + rr; f32x4 v0[8], v1[8];
#pragma unroll
            for (int j = 0; j < 8; ++j) { v0[j] = (f32x4){bflo(raw[0][j].x), bfhi(raw[0][j].x), bflo(raw[0][j].y), bfhi(raw[0][j].y)}; v1[j] = (f32x4){bflo(raw[1][j].x), bfhi(raw[1][j].x), bflo(raw[1][j].y), bfhi(raw[1][j].y)};
                raw[0][j] = raw[2][j]; raw[1][j] = raw[3][j]; }
            if (rr + 4 < 16) {
#pragma unroll
                for (int u = 0; u < 2; ++u) { const v2u* p = (const v2u*)(xin + (row + 4 + u) * D) + lane;
#pragma unroll
                    for (int j = 0; j < 8; ++j) raw[2 + u][j] = p[64 * j]; } }
            const float rs0 = row_rstd(v0), rs1 = row_rstd(v1);
#pragma unroll
            for (int j = 0; j < 8; ++j) { v0[j] = v0[j] * rs0 * A[j] + B[j]; v1[j] = v1[j] * rs1 * A[j] + B[j]; }
            store_row_bf16(h1 + row * D, v0, lane); store_row_bf16(h1 + (row + 1) * D, v1, lane);
            float lg0 = -__builtin_inff(), lg1 = lg0;
#pragma unroll 1
            for (int e = 0; e < 16; ++e) { f32x4 q0 = {0.f, 0.f, 0.f, 0.f}, q1 = q0;
#pragma unroll
                for (int j = 0; j < 8; ++j) { const f32x4 w = *(const LAS f32x4*)(rw + e * 2052 + 4 * lane + 256 * j); q0 += v0[j] * w; q1 += v1[j] * w; }
                float p0 = (q0.x + q0.y) + (q0.z + q0.w), p1 = (q1.x + q1.y) + (q1.z + q1.w);
                p0 = wave_sum_dpp(p0); p1 = wave_sum_dpp(p1); lg0 = (lane == e) ? p0 : lg0; lg1 = (lane == e) ? p1 : lg1; }
            float m0 = lg0, m1 = lg1;
#pragma unroll
            for (int o = 1; o < 16; o <<= 1) { m0 = fmaxf(m0, __shfl_xor(m0, o)); m1 = fmaxf(m1, __shfl_xor(m1, o)); }
            const float e0 = (lane < 16) ? __expf(lg0 - m0) : 0.f, e1 = (lane < 16) ? __expf(lg1 - m1) : 0.f; float s0 = e0, s1 = e1;
#pragma unroll
            for (int o = 1; o < 16; o <<= 1) { s0 += __shfl_xor(s0, o); s1 += __shfl_xor(s1, o); }
            if (lane < 16) { affl[lane * 16 + rr] = e0 / s0; affl[lane * 16 + rr + 1] = e1 / s1; } }
        LDS_WAIT(); asm volatile("" ::: "memory");
        { const f32x4 av = *(const LAS f32x4*)(affl + (lane >> 2) * 16 + (lane & 3) * 4);
          *(f32x4*)(aff + ((size_t)(b * 16 + (lane >> 2))) * T + (((size_t)ch * 16) & (T - 1)) + (lane & 3) * 4) = av; }
        LDS_WAIT(); asm volatile("" ::: "memory");
    }
}
__device__ __forceinline__ int block_excl_scan(int v, int& total, LAS int* wtot, int lane, int wave) {
    int inc = v;
#pragma unroll
    for (int o = 1; o < 64; o <<= 1) { const int t = __shfl_up(inc, o); if (lane >= o) inc += t; }
    __syncthreads();
    if (lane == 63) wtot[wave] = inc;
    __syncthreads();
    int off = 0, tot = 0;
#pragma unroll
    for (int w = 0; w < NWAVES; ++w) { const int t = wtot[w]; if (w < wave) off += t; tot += t; }
    total = tot; return off + inc - v;
}
__device__ __forceinline__ void moe_topk(const Args& a, LAS unsigned char* lds, int tid, int lane, int wave, int bid, int G) {
    LAS unsigned* vals = (LAS unsigned*)lds;
    LAS int* hist = (LAS int*)(lds + 69632); LAS int* misc = hist + 4096; LAS int* wtot = misc + 8; LAS int* wtot2 = wtot + 8;
    const float* aff = (const float*)(a.ws + WS_AFF); int* idx = (int*)(a.ws + WS_IDX); float* gate = (float*)(a.ws + WS_GATE); int* slot_of = (int*)(a.ws + WS_SLOT);
    for (int be = bid; be < NB * NE; be += G) {
        __syncthreads();
        for (int i = tid; i < T; i += NTHR) vals[i + (i >> 5)] = __builtin_bit_cast(unsigned, aff[(size_t)be * T + i]) << 2;
        unsigned p0 = 0u, p1 = 0u, p2 = 0u; int kr = CAP;
#pragma unroll 1
        for (int pass = 0; pass < 3; ++pass) {
            const int nb = (pass == 2) ? 256 : 4096;
            for (int i = tid; i < nb; i += NTHR) hist[i] = 0;
            __syncthreads();
            for (int i = tid; i < T; i += NTHR) { const unsigned v = vals[i + (i >> 5)]; unsigned dgt; bool m;
                if (pass == 0) { dgt = v >> 20; m = true; } else if (pass == 1) { dgt = (v >> 8) & 4095u; m = (v >> 20) == p0; } else { dgt = v & 255u; m = (v >> 8) == ((p0 << 12) | p1); }
                if (m) __hip_atomic_fetch_add(&hist[dgt], 1, __ATOMIC_RELAXED, __HIP_MEMORY_SCOPE_WORKGROUP); }
            __syncthreads();
            int c8[8], s = 0; const bool own = 8 * tid < nb;
#pragma unroll
            for (int j = 0; j < 8; ++j) { c8[j] = own ? hist[nb - 1 - (8 * tid + j)] : 0; s += c8[j]; }
            int tot; const int ex = block_excl_scan(s, tot, wtot, lane, wave);
            if (own && ex < kr && kr <= ex + s) { int cum = ex;
#pragma unroll
                for (int j = 0; j < 8; ++j) { if (cum < kr && kr <= cum + c8[j]) { misc[0] = nb - 1 - (8 * tid + j); misc[1] = kr - cum; } cum += c8[j]; } }
            __syncthreads();
            const unsigned dsel = (unsigned)misc[0]; kr = misc[1];
            if (pass == 0) p0 = dsel; else if (pass == 1) p1 = dsel; else p2 = dsel;
            __syncthreads();
        }
        const unsigned thr = (p0 << 20) | (p1 << 8) | p2;
        int cg = 0, ce = 0;
#pragma unroll 8
        for (int i = 0; i < 32; ++i) { const unsigned v = vals[33 * tid + i]; cg += (v > thr); ce += (v == thr); }
        int ngt, neq; const int pg0 = block_excl_scan(cg, ngt, wtot, lane, wave); const int pe0 = block_excl_scan(ce, neq, wtot2, lane, wave);
        int pg = pg0, pe = pe0;
#pragma unroll 8
        for (int i = 0; i < 32; ++i) { const int t = 32 * tid + i; const unsigned v = vals[33 * tid + i]; int slot = -1;
            if (v > thr) slot = pg++; else if (v == thr) { if (pe < kr) slot = ngt + pe; ++pe; }
            slot_of[(size_t)be * T + t] = slot;
            if (slot >= 0) { idx[be * CAP + slot] = t; gate[be * CAP + slot] = __builtin_bit_cast(float, v >> 2); } }
    }
}
__device__ __forceinline__ void moe_gather(const Args& a, int lane, int wave, int bid, int G) {
    const int gw = bid * NWAVES + wave, NGW = G * NWAVES; const bf16* h1 = (const bf16*)(a.ws + WS_H); bf16* xs = (bf16*)(a.ws + WS_PX); const int* idx = (const int*)(a.ws + WS_IDX);
    for (int r = gw; r < NSLOT; r += NGW) { const int b = r >> 15; const int t = idx[r];
        const v4u* src = (const v4u*)(h1 + ((size_t)b * T + t) * D) + lane; v4u* dst = (v4u*)(xs + (size_t)r * D) + lane;
        v4u v0 = src[0], v1 = src[64], v2 = src[128], v3 = src[192]; dst[0] = v0; dst[64] = v1; dst[128] = v2; dst[192] = v3; }
}
template <int MODE>
__device__ __forceinline__ void moe_combine(const Args& a, int l, bf16* xio, int lane, int wave, int bid, int G) {
    const int gw = bid * NWAVES + wave, NGW = G * NWAVES; const bf16* y = (const bf16*)(a.ws + WS_PX); const int* slot_of = (const int*)(a.ws + WS_SLOT); bf16* hx = (bf16*)(a.ws + WS_H);
    f32x4 A[8], B[8], GT[8];
    for (int ch = gw; ch < M / 16; ch += NGW) {
        const int b = ch / (T / 16);
        if (MODE == 0) load_coef(a.in[I_NMIX] + D, modp(a.ws, 1, b, 1), modp(a.ws, 1, b, 0), lane, A, B);
        else {
#pragma unroll
            for (int j = 0; j < 8; ++j) A[j] = *(const f32x4*)(a.in[I_NFIN] + 4 * lane + 256 * j); }
#pragma unroll
        for (int j = 0; j < 8; ++j) GT[j] = *(const f32x4*)(modp(a.ws, l, b, 5) + 4 * lane + 256 * j);
        const int t0 = (int)(((size_t)ch * 16) & (T - 1)); const int* sp = slot_of + ((size_t)(b * 16 + (lane & 15))) * T + t0 + (lane >> 4);
        int slq = sp[0];
#pragma unroll 1
        for (int q = 0; q < 4; ++q) { const int cur = slq; if (q < 3) slq = sp[4 * (q + 1)];
            const unsigned long long bal = __ballot(cur >= 0);
#pragma unroll
            for (int rs = 0; rs < 4; ++rs) { const size_t row = (size_t)ch * 16 + 4 * q + rs;
                unsigned m = (unsigned)(bal >> (16 * rs)) & 0xffffu;
                const v2u* xp = (const v2u*)(xio + row * D) + lane; v2u xr[8];
#pragma unroll
                for (int j = 0; j < 8; ++j) xr[j] = xp[64 * j];
                f32x4 v[8]; bool first = true;
                do { const v2u* yp[4]; float wg[4]; v2u yv[4][8];
#pragma unroll
                    for (int k = 0; k < 4; ++k) { const bool ok = (m != 0u); const int ee = ok ? __builtin_ctz(m) : 0; m = ok ? (m & (m - 1u)) : 0u; const int s = __builtin_amdgcn_readlane(cur, 16 * rs + ee);
                        yp[k] = ok ? ((const v2u*)(y + ((size_t)(b * 16 + ee) * CAP + s) * D) + lane) : xp; wg[k] = ok ? 1.f : 0.f; }
#pragma unroll
                    for (int k = 0; k < 4; ++k)
#pragma unroll
                        for (int j = 0; j < 8; ++j) yv[k][j] = yp[k][64 * j];
                    if (first) {
#pragma unroll
                        for (int j = 0; j < 8; ++j) v[j] = (f32x4){bflo(xr[j].x), bfhi(xr[j].x), bflo(xr[j].y), bfhi(xr[j].y)};
                        first = false; }
#pragma unroll
                    for (int k = 0; k < 4; ++k)
#pragma unroll
                        for (int j = 0; j < 8; ++j) { const v2u w = yv[k][j]; v[j] += (f32x4){bflo(w.x), bfhi(w.x), bflo(w.y), bfhi(w.y)} * (GT[j] * wg[k]); }
                } while (m != 0u);
                const float rstd = row_rstd(v);
                if (MODE == 0) {
                    store_row_bf16(xio + row * D, v, lane);
#pragma unroll
                    for (int j = 0; j < 8; ++j) v[j] = v[j] * rstd * A[j] + B[j];
                    store_row_bf16(hx + row * D, v, lane);
                } else { f32x4* xr2 = (f32x4*)(a.out + row * D) + lane;
#pragma unroll
                    for (int j = 0; j < 8; ++j) xr2[64 * j] = v[j] * rstd * A[j];
                } } }
    }
}
template <int HALF, int RPT>
__device__ __forceinline__ void pool_rows(const bf16* hx, bf16* pooled, int g, int cg, int row0) {
    constexpr int NR = RPT + 2 * HALF;
    const int t0 = row0 & (T - 1), rowb = row0 - t0;
    v4u x[NR];
#pragma unroll
    for (int j = 0; j < NR; ++j) { const int u = t0 - HALF + j; const bool ok = (u >= 0) && (u < T);
        x[j] = *(const v4u*)(hx + (size_t)(rowb + (ok ? u : t0)) * D + 8 * cg); if (!ok) x[j] = (v4u){0u, 0u, 0u, 0u}; }
    float S[8];
#pragma unroll
    for (int i = 0; i < 8; ++i) S[i] = 0.f;
#pragma unroll
    for (int j = 0; j < 2 * HALF; ++j)
#pragma unroll
        for (int w = 0; w < 4; ++w) { S[2 * w] += bflo(x[j][w]); S[2 * w + 1] += bfhi(x[j][w]); }
#pragma unroll
    for (int r = 0; r < RPT; ++r) { const int t = t0 + r, lo = (t - HALF) > 0 ? (t - HALF) : 0, hi = (t + HALF) < T ? (t + HALF) : T; const float inv = 1.f / (float)(hi - lo);
        const v4u xc = x[r + HALF]; v4u o;
#pragma unroll
        for (int w = 0; w < 4; ++w) o[w] = pk2(S[2 * w] * inv - bflo(xc[w]), S[2 * w + 1] * inv - bfhi(xc[w]));
        *(v4u*)(pooled + ((size_t)g * M + row0 + r) * 512 + (8 * cg - 512 * g)) = o;
        if (r < RPT - 1) {
#pragma unroll
            for (int w = 0; w < 4; ++w) { S[2 * w] += bflo(x[r + 2 * HALF][w]) - bflo(x[r][w]); S[2 * w + 1] += bfhi(x[r + 2 * HALF][w]) - bfhi(x[r][w]); } }
        __builtin_amdgcn_sched_barrier(0); }
}
__device__ __forceinline__ void pool_phase(const Args& a, int tid, int bid, int G) {
    const bf16* hx = (const bf16*)(a.ws + WS_H); bf16* pooled = (bf16*)(a.ws + WS_MIX);
    const int cg = tid & 255, rsel = __builtin_amdgcn_readfirstlane(tid >> 8), g = __builtin_amdgcn_readfirstlane(cg >> 6);
    for (int chunk = bid; chunk < M / 32; chunk += G) { const int row0 = chunk * 32 + rsel * 16;
        if (g == 0) pool_rows<1, 16>(hx, pooled, 0, cg, row0); else if (g == 1) pool_rows<2, 16>(hx, pooled, 1, cg, row0); else if (g == 2) pool_rows<4, 16>(hx, pooled, 2, cg, row0);
        else { pool_rows<8, 8>(hx, pooled, 3, cg, row0); pool_rows<8, 8>(hx, pooled, 3, cg, row0 + 8); } }
}


constexpr int N_PHASES = 22;
template <int LO, int HI>
__global__ void __launch_bounds__(NTHR, 2) mega_fwd(Args args) {
    extern __shared__ __attribute__((aligned(16))) unsigned char lds_raw[];
    LAS unsigned char* lds = (LAS unsigned char*)lds_raw;
    const int tid = threadIdx.x, lane = tid & 63, wave = __builtin_amdgcn_readfirstlane(tid >> 6), bid = blockIdx.x, G = gridDim.x;
    unsigned char* ws = args.ws;
    for (int u = tid; u < (LDS_BYTES - LDSCTL_OFF) / 4; u += NTHR) ((LAS unsigned*)(lds + LDSCTL_OFF))[u] = 0u;
    __syncthreads();
    XcdBarrier bar = xcd_barrier_post((unsigned*)(ws + WS_CTL) + CW_BAR, (volatile LAS unsigned*)(lds + MISC_OFF) + 8);
#ifndef PH_EN
#define PH_EN 0xffffffffu
#endif
#define IN(k) (((PH_EN >> ((k) > 15 ? (k) - 8 : (k))) & 1u) && LO <= (k) && (k) < HI)
#define REP(k) ((REP_MASK >> (k)) & 1u)
#define SEAM(k) do { if (IN(k) && IN((k) + 1)) xcd_barrier(bar); } while (0)
    const KArgP kap0 = (KArgP)__builtin_amdgcn_kernarg_segment_ptr();
#define PH_BEGIN KArgP kap_ = kap0; asm volatile("; PHASE_BEGIN line %1" : "+s"(kap_) : "n"(__LINE__)); const Args& A_ = *(const Args*)kap_; int tid_ = tid; asm volatile("" : "+v"(tid_)); \
    const int lane_ = tid_ & 63, wave_ = __builtin_amdgcn_readfirstlane(tid_ >> 6); unsigned char* const ws_ = A_.ws; (void)lane_; (void)wave_; (void)ws_;

    if (IN(0)) { PH_BEGIN p0_prologue(A_, lds, tid_, lane_, wave_, bid, G); } if (REP(0) && IN(0)) { xcd_barrier(bar); { PH_BEGIN p0_prologue(A_, lds, tid_, lane_, wave_, bid, G); } } SEAM(0);
    if (IN(1)) { PH_BEGIN p1_norm0(A_, lane_, wave_, bid, G); } if (REP(1) && IN(1)) { xcd_barrier(bar); { PH_BEGIN p1_norm0(A_, lane_, wave_, bid, G); } } SEAM(1);
    if (IN(2)) { _Pragma("unroll") for (int rep_ = 0; rep_ < (REP(2) ? 2 : 1); ++rep_) { if (rep_) xcd_barrier(bar);
        PH_BEGIN
        pg8::Gemm g{(const bf16*)(ws_ + WS_H), (const bf16*)(ws_ + WS_WIN), MT, NPAD, D}; pg8::StaticOrder S; S.init(MT, NPAD, G, bid);
        pg8::EpiStoreBf16 E{(bf16*)(ws_ + WS_PX), NPAD};
        pg8::gemm_phase<pg8::EpiStoreBf16, pg8::StaticOrder, true, true>(lds, g, S, E, tid_);
        { PH_BEGIN const int tb = conv_tail_blocks(G); if (tb && bid >= tb) { asm volatile("s_waitcnt vmcnt(0)" ::: "memory"); __syncthreads(); conv_experts(A_, 0, lds, lane_, wave_, bid - tb, G - tb, 0, conv_tail_items(G)); conv_experts(A_, 1, lds, lane_, wave_, bid - tb, G - tb, 0, conv_tail_items(G)); } }
    } } SEAM(2);
    if (IN(3)) { PH_BEGIN if ((bid >> 3) & 1) lerp_phase(A_, tid_, bid, G); p3_attention(A_, lds, tid_, lane_, wave_, bid, G); if (!((bid >> 3) & 1)) lerp_phase(A_, tid_, bid, G); }        if (REP(3) && IN(3)) { xcd_barrier(bar); { PH_BEGIN p3_attention(A_, lds, tid_, lane_, wave_, bid, G); lerp_phase(A_, tid_, bid, G); } } SEAM(3);
    if (IN(4)) { PH_BEGIN p4_rwkv_passA(kap_, lds, lane_, wave_, bid, G); } if (REP(4) && IN(4)) { xcd_barrier(bar); { PH_BEGIN p4_rwkv_passA(kap_, lds, lane_, wave_, bid, G); } } SEAM(4);
    if (IN(5)) { PH_BEGIN p5_rwkv_passC(kap_, lds, lane_, wave_, bid, G); } if (REP(5) && IN(5)) { xcd_barrier(bar); { PH_BEGIN p5_rwkv_passC(kap_, lds, lane_, wave_, bid, G); } } SEAM(5);
    if (IN(6)) { PH_BEGIN p5_rwkv_finish(A_, lds, tid_, lane_, wave_, bid, G); } if (REP(6) && IN(6)) { xcd_barrier(bar); { PH_BEGIN p5_rwkv_finish(A_, lds, tid_, lane_, wave_, bid, G); } } SEAM(6);
    if (IN(7)) { _Pragma("unroll") for (int rep_ = 0; rep_ < (REP(7) ? 2 : 1); ++rep_) { if (rep_) xcd_barrier(bar);
        PH_BEGIN
        pg8::Gemm g{(const bf16*)(ws_ + WS_MIX), (const bf16*)(ws_ + WS_WOUT), M, D, D}; pg8::StaticOrder S; S.init(M, D, G, bid);
        pg8::EpiResBf16<true> E{A_.in[I_X], (bf16*)(ws_ + WS_YD), D, modp(ws_, 0, 0, 2), modp(ws_, 0, 1, 2), nullptr, T, 0x7fffffff};
        pg8::gemm_phase<pg8::EpiResBf16<true>, pg8::StaticOrder, true, true>(lds, g, S, E, tid_);
    } } SEAM(7);
#define LAYER_PHASES(l) do { \
        const int pb = 8 + 8 * l; \
        if (IN(pb + 0)) { PH_BEGIN moe_norm_router(A_, l, (const bf16*)(ws_ + WS_YD), lds, tid_, lane_, wave_, bid, G); } if (REP(pb + 0) && IN(pb + 0)) { xcd_barrier(bar); { PH_BEGIN moe_norm_router(A_, l, (const bf16*)(ws_ + WS_YD), lds, tid_, lane_, wave_, bid, G); } } SEAM(pb + 0); \
        if (IN(pb + 1)) { PH_BEGIN if (G > 32 && bid >= 32) conv_experts(A_, l, lds, lane_, wave_, bid - 32, G - 32, conv_tail_items(G), CONV_NIT); else { moe_topk(A_, lds, tid_, lane_, wave_, bid, G); if (G <= 32) conv_experts(A_, l, lds, lane_, wave_, bid, G, conv_tail_items(G), CONV_NIT); } } if (REP(pb + 1) && IN(pb + 1)) { xcd_barrier(bar); { PH_BEGIN if (G > 32 && bid >= 32) conv_experts(A_, l, lds, lane_, wave_, bid - 32, G - 32, conv_tail_items(G), CONV_NIT); else { moe_topk(A_, lds, tid_, lane_, wave_, bid, G); if (G <= 32) conv_experts(A_, l, lds, lane_, wave_, bid, G, conv_tail_items(G), CONV_NIT); } } } SEAM(pb + 1); \
        if (IN(pb + 3)) { _Pragma("unroll") for (int rep_ = 0; rep_ < (REP(pb + 3) ? 2 : 1); ++rep_) { if (rep_) xcd_barrier(bar); \
            PH_BEGIN \
            pg8::Gemm g{(const bf16*)(ws_ + WS_H), (const bf16*)(ws_ + WS_WGU) + (size_t)l * 16 * 2048 * 2048, NSLOT, 2048, D, (const int*)(ws_ + WS_IDX), 15, T}; pg8::ExpertOrder S{G, bid}; \
            pg8::EpiSwiglu E{(bf16*)(ws_ + WS_MIX), FF}; \
            pg8::gemm_phase<pg8::EpiSwiglu, pg8::ExpertOrder, true, true, true>(lds, g, S, E, tid_); \
        } } SEAM(pb + 3); \
        if (IN(pb + 4)) { _Pragma("unroll") for (int rep_ = 0; rep_ < (REP(pb + 4) ? 2 : 1); ++rep_) { if (rep_) xcd_barrier(bar); \
            PH_BEGIN \
            pg8::Gemm g{(const bf16*)(ws_ + WS_MIX), (const bf16*)(ws_ + WS_WD) + (size_t)l * 16 * 2048 * 1024, NSLOT, 2048, FF}; pg8::ExpertOrder S{G, bid}; \
            pg8::EpiRowScaleBf16 E{(bf16*)(ws_ + WS_PX), D, (const float*)(ws_ + WS_GATE)}; \
            pg8::gemm_phase<pg8::EpiRowScaleBf16, pg8::ExpertOrder, true, true>(lds, g, S, E, tid_); \
        } } SEAM(pb + 4); \
        if (l == 0) { \
            if (IN(pb + 5)) { PH_BEGIN moe_combine<0>(A_, 0, (bf16*)(ws_ + WS_YD), lane_, wave_, bid, G); } if (REP(pb + 5) && IN(pb + 5)) { xcd_barrier(bar); { PH_BEGIN moe_combine<0>(A_, 0, (bf16*)(ws_ + WS_YD), lane_, wave_, bid, G); } } SEAM(pb + 5); \
            if (IN(pb + 6)) { PH_BEGIN pool_phase(A_, tid_, bid, G); } if (REP(pb + 6) && IN(pb + 6)) { xcd_barrier(bar); { PH_BEGIN pool_phase(A_, tid_, bid, G); } } SEAM(pb + 6); \
            if (IN(pb + 7)) { _Pragma("unroll") for (int rep_ = 0; rep_ < (REP(pb + 7) ? 2 : 1); ++rep_) { if (rep_) xcd_barrier(bar); \
                PH_BEGIN \
                pg8::Gemm g{(const bf16*)(ws_ + WS_MIX), (const bf16*)(ws_ + WS_WPOOL), 4 * M, 512, 512}; pg8::PoolOrder S{G, bid}; \
                pg8::EpiResBf16<false> E{(const bf16*)(ws_ + WS_YD), (bf16*)(ws_ + WS_YD), D, modp(ws_, 1, 0, 2), modp(ws_, 1, 1, 2), A_.in[I_POOLS], T, 127}; \
                pg8::gemm_phase<pg8::EpiResBf16<false>, pg8::PoolOrder, true, true>(lds, g, S, E, tid_); \
            } } SEAM(pb + 7); \
        } else { \
            if (IN(pb + 5)) { PH_BEGIN moe_combine<1>(A_, 1, (bf16*)(ws_ + WS_YD), lane_, wave_, bid, G); } if (REP(pb + 5) && IN(pb + 5)) { xcd_barrier(bar); { PH_BEGIN moe_combine<1>(A_, 1, (bf16*)(ws_ + WS_YD), lane_, wave_, bid, G); } } \
        } \
    } while (0)
    LAYER_PHASES(0);
    LAYER_PHASES(1);
#undef LAYER_PHASES
#undef IN
#undef SEAM
#undef PH_BEGIN
}

template <int LO, int HI> static void launch_range(const Args& a, int grid, hipStream_t stream) {
    static bool attr = false;
    if (!attr) { (void)hipFuncSetAttribute((const void*)mega_fwd<LO, HI>, hipFuncAttributeMaxDynamicSharedMemorySize, LDS_BYTES); attr = true; }
    hipLaunchKernelGGL((mega_fwd<LO, HI>), dim3(grid), dim3(NTHR), LDS_BYTES, stream, a);
}
#if MK_SPLIT
template <int K> struct SplitLaunch { static void run(const Args& a, int grid, hipStream_t s) { SplitLaunch<K - 1>::run(a, grid, s); launch_range<K, K + 1>(a, grid, s); } };
template <> struct SplitLaunch<-1> { static void run(const Args&, int, hipStream_t) {} };
#endif
extern "C" void kernel_launch(void* const* d_in, const int* in_sizes, int n_in, void* d_out, int out_size, void* d_ws, size_t ws_size, hipStream_t stream) {
    static int grid = 0;
    if (grid == 0) {
        if (n_in != N_IN || out_size != M * D || ws_size < WS_END) { fprintf(stderr, "kernel_launch: unexpected shapes (n_in %d out %d ws %zu, need %zu)\n", n_in, out_size, ws_size, (size_t)WS_END); grid = -1; return; }
        int dev = 0, cus = 0;
        if (hipGetDevice(&dev) != hipSuccess || hipDeviceGetAttribute(&cus, hipDeviceAttributeMultiprocessorCount, dev) != hipSuccess) { grid = -1; return; }
        grid = cus;
    }
    if (grid < 0) return;
    (void)in_sizes;
    (void)hipMemsetAsync((char*)d_ws + WS_CTL, 0, CTL_ZERO_BYTES, stream);
    Args a{};
    for (int i = 0; i < N_IN; ++i) a.in[i] = (const float*)d_in[i];
    a.out = (float*)d_out; a.ws = (unsigned char*)d_ws; a.ph_lo = 0; a.ph_hi = N_PHASES;
#if MK_SPLIT
    SplitLaunch<N_PHASES - 1>::run(a, grid, stream);
#else
    launch_range<0, N_PHASES>(a, grid, stream);
#endif
    const hipError_t le = hipPeekAtLastError();
    if (le != hipSuccess) fprintf(stderr, "kernel_launch: launch failed: %s\n", hipGetErrorName(le));
}
```
